# Optimizing an MI355X kernel written in HIP

```python
import math
import jax, jax.numpy as jnp
from jax import lax
import numpy as np

D_MODEL = 1024
BATCH = 16
SEQ = 2048
DEPTH = 4
DEC_BATCH = 16
DEC_SEQ = 16
PAST_LEN = 4096

CHUNK = 64
N_MIXERS = 3
N_A = (DEPTH + 2) // 3
N_B = (DEPTH + 1) // 3
N_C = DEPTH // 3

A_HEAD_DIM = 64
A_HEADS = D_MODEL // (2 * A_HEAD_DIM)
A_Q_BLOCK = 128
ROPE_THETA = 10000.0

B_WIDTH = D_MODEL
B_BLOCKS = 4
B_BLOCK_W = B_WIDTH // B_BLOCKS
B_CONV_W = 4
B_C = 8.0

C_HEADS = 16
C_HEAD_DIM = D_MODEL // C_HEADS
C_LEFT_CHUNKS = 8
C_BAND_PAST = C_LEFT_CHUNKS * CHUNK
C_REL_CLIP = 128

D_FF = 4 * D_MODEL
EPS = 1e-6

kernel_name = "hybrid_streaming_encoder_step"


def rms_norm(x, g):
    xf = x.astype(jnp.float32)
    y = xf * lax.rsqrt(jnp.mean(xf * xf, axis=-1, keepdims=True) + EPS)
    return (y * g.astype(jnp.float32)).astype(x.dtype)


def rope(x, pos):
    half = x.shape[-1] // 2
    inv = ROPE_THETA ** (-jnp.arange(half, dtype=jnp.float32) / half)
    ang = pos.astype(jnp.float32)[:, None] * inv[None, :]
    shape = (1, pos.shape[0]) + (1,) * (x.ndim - 3) + (half,)
    cos = jnp.cos(ang).reshape(shape)
    sin = jnp.sin(ang).reshape(shape)
    x1 = x[..., :half].astype(jnp.float32)
    x2 = x[..., half:].astype(jnp.float32)
    return jnp.concatenate([x1 * cos - x2 * sin, x2 * cos + x1 * sin], axis=-1).astype(x.dtype)


def diff_core(q, k, v, lam, mask):
    s = jnp.einsum("bqhcd,bkhcd->bhcqk", q, k).astype(jnp.float32) * (A_HEAD_DIM ** -0.5)
    if mask is not None:
        s = jnp.where(mask, s, -jnp.inf)
    p = jax.nn.softmax(s, axis=-1)
    w = p[:, :, 0] - lam * p[:, :, 1]
    return jnp.einsum("bhqk,bkhe->bqhe", w.astype(v.dtype), v)


def diff_attn_prompt(q, k, v, lam):
    B, T = q.shape[:2]
    nb = T // A_Q_BLOCK
    qb = jnp.moveaxis(q.reshape(B, nb, A_Q_BLOCK, A_HEADS, 2, A_HEAD_DIM), 1, 0)
    k_chunk = jnp.arange(T) // CHUNK

    def block(args):
        q_blk, b = args
        q_chunk = (b * A_Q_BLOCK + jnp.arange(A_Q_BLOCK)) // CHUNK
        return diff_core(q_blk, k, v, lam, k_chunk[None, :] <= q_chunk[:, None])

    o = lax.map(block, (qb, jnp.arange(nb)))
    return jnp.moveaxis(o, 0, 1).reshape(B, T, A_HEADS, 2 * A_HEAD_DIM)


def diff_project(h, pos, w_in, q_g, k_g):
    B, T, _ = h.shape
    q, k, v = jnp.split(h @ w_in, 3, axis=-1)
    q = rope(rms_norm(q.reshape(B, T, A_HEADS, 2, A_HEAD_DIM), q_g), pos)
    k = rope(rms_norm(k.reshape(B, T, A_HEADS, 2, A_HEAD_DIM), k_g), pos)
    return q, k, v.reshape(B, T, A_HEADS, 2 * A_HEAD_DIM)


def diff_output(o, subln_g, lam_init, w_out):
    B, T = o.shape[:2]
    o = rms_norm(o, subln_g) * (1.0 - lam_init)
    return o.reshape(B, T, -1) @ w_out


def diff_mixer(hp, hs, cache_k, cache_v, w_in, q_g, k_g, lam_p, subln_g, w_out, lam_init):
    past = cache_k.shape[1]
    lp = lam_p.astype(jnp.float32)
    lam = jnp.exp(jnp.sum(lp[0] * lp[1])) - jnp.exp(jnp.sum(lp[2] * lp[3])) + lam_init
    qp, kp, vp = diff_project(hp, jnp.arange(hp.shape[1]), w_in, q_g, k_g)
    yp = diff_output(diff_attn_prompt(qp, kp, vp, lam), subln_g, lam_init, w_out)
    qs, ks, vs = diff_project(hs, past + jnp.arange(hs.shape[1]), w_in, q_g, k_g)
    k_all = jnp.concatenate([cache_k, ks], axis=1)
    v_all = jnp.concatenate([cache_v, vs], axis=1)
    ys = diff_output(diff_core(qs, k_all, v_all, lam, None), subln_g, lam_init, w_out)
    return yp, ys, kp, vp, ks, vs


def linear_scan(a, b, h0):
    b = b.at[:, 0].add(a[:, 0] * h0)

    def combine(l, r):
        return l[0] * r[0], r[0] * l[1] + r[1]

    return lax.associative_scan(combine, (a, b), axis=1)[1]


def rglru_block(h, conv_hist, h0, w_in, b_in, conv_w, conv_b, ga_w, ga_b, gx_w, gx_b, lam, w_out):
    B, T, _ = h.shape
    gate, u = jnp.split(h @ w_in + b_in, 2, axis=-1)
    gate = jax.nn.gelu(gate)
    u_ext = jnp.concatenate([conv_hist.astype(u.dtype), u], axis=1)
    xc = sum((u_ext[:, j:j + T] * conv_w[j] for j in range(B_CONV_W)), conv_b)
    xb = xc.reshape(B, T, B_BLOCKS, B_BLOCK_W)
    r = jax.nn.sigmoid(jnp.einsum("btnc,ncd->btnd", xb, ga_w).reshape(B, T, B_WIDTH) + ga_b).astype(jnp.float32)
    i = jax.nn.sigmoid(jnp.einsum("btnc,ncd->btnd", xb, gx_w).reshape(B, T, B_WIDTH) + gx_b).astype(jnp.float32)
    log_a = -B_C * r * jax.nn.softplus(-lam.astype(jnp.float32))
    a = jnp.exp(log_a)
    b = jnp.sqrt(-jnp.expm1(2.0 * log_a)) * (i * xc.astype(jnp.float32))
    hs = linear_scan(a, b, h0.astype(jnp.float32))
    y = (hs.astype(h.dtype) * gate) @ w_out
    return y, u_ext[:, -(B_CONV_W - 1):], hs[:, -1].astype(h0.dtype)


def rel_bias(table, rel):
    idx = jnp.clip(rel, -C_REL_CLIP, C_REL_CLIP) + C_REL_CLIP
    return jnp.moveaxis(table[idx], -1, 0).astype(jnp.float32)


def band_core(q, k, v, bias, valid):
    s = jnp.einsum("bqhd,bkhd->bhqk", q, k).astype(jnp.float32) * (C_HEAD_DIM ** -0.5) + bias
    if valid is not None:
        s = jnp.where(valid, s, -jnp.inf)
    p = jax.nn.softmax(s, axis=-1)
    return jnp.einsum("bhqk,bkhd->bqhd", p.astype(v.dtype), v)


def band_attn_prompt(q, k, v, table):
    B, T = q.shape[:2]
    nc = T // CHUNK
    band = C_BAND_PAST + CHUNK
    pad = ((0, 0), (C_BAND_PAST, 0), (0, 0), (0, 0))
    kp = jnp.pad(k, pad)
    vp = jnp.pad(v, pad)
    qc = jnp.moveaxis(q.reshape(B, nc, CHUNK, C_HEADS, C_HEAD_DIM), 1, 0)
    key_off = jnp.arange(band) - C_BAND_PAST
    bias = rel_bias(table, jnp.arange(CHUNK)[:, None] - key_off[None, :])

    def one_chunk(args):
        q_c, c = args
        start = c * CHUNK
        kb = lax.dynamic_slice_in_dim(kp, start, band, axis=1)
        vb = lax.dynamic_slice_in_dim(vp, start, band, axis=1)
        valid = (start + key_off) >= 0
        return band_core(q_c, kb, vb, bias, valid)

    o = lax.map(one_chunk, (qc, jnp.arange(nc)))
    return jnp.moveaxis(o, 0, 1).reshape(B, T, C_HEADS * C_HEAD_DIM)


def band_mixer(hp, hs, cache_k, cache_v, w_in, q_g, k_g, table, w_out):
    def project(h):
        B, T, _ = h.shape
        q, k, v = jnp.split(h @ w_in, 3, axis=-1)
        shp = (B, T, C_HEADS, C_HEAD_DIM)
        return rms_norm(q.reshape(shp), q_g), rms_norm(k.reshape(shp), k_g), v.reshape(shp)

    qp, kp, vp = project(hp)
    yp = band_attn_prompt(qp, kp, vp, table) @ w_out
    qs, ks, vs = project(hs)
    Bs, Ts = hs.shape[:2]
    W = cache_k.shape[1]
    key_pos = jnp.concatenate([jnp.arange(W) - W, jnp.arange(Ts)])
    bias = rel_bias(table, jnp.arange(Ts)[:, None] - key_pos[None, :])
    o_s = band_core(qs, jnp.concatenate([cache_k, ks], axis=1),
                    jnp.concatenate([cache_v, vs], axis=1), bias, None)
    ys = o_s.reshape(Bs, Ts, -1) @ w_out
    keep = min(C_BAND_PAST, hp.shape[1])
    return yp, ys, kp[:, -keep:], vp[:, -keep:], ks, vs


def sq_relu_mlp(h, w1, w2):
    return jnp.square(jax.nn.relu(h @ w1)) @ w2


def setup_inputs(seed: int = 0) -> dict:
    key = jax.random.key(seed)
    keys = jax.random.split(key, 40)
    counter = iter(range(40))

    def nrm(shape, scale):
        return jax.random.normal(keys[next(counter)], shape, jnp.float32) * scale

    def gain(shape):
        return 1.0 + nrm(shape, 0.02)

    c_win = min(C_BAND_PAST, PAST_LEN)
    d = D_MODEL
    lam_u = jax.random.uniform(keys[next(counter)], (N_B, B_WIDTH), jnp.float32, 0.9, 0.999)
    sig = lam_u ** (1.0 / B_C)
    b_lambda = jnp.log(sig) - jnp.log1p(-sig)
    return {
        "x_prompt": nrm((BATCH, SEQ, d), 1.0),
        "x_sample": nrm((DEC_BATCH, DEC_SEQ, d), 1.0),
        "cache_a_k": nrm((N_A, DEC_BATCH, PAST_LEN, A_HEADS, 2, A_HEAD_DIM), 1.0),
        "cache_a_v": nrm((N_A, DEC_BATCH, PAST_LEN, A_HEADS, 2 * A_HEAD_DIM), 1.0),
        "state_b_conv": nrm((N_B, DEC_BATCH, B_CONV_W - 1, B_WIDTH), 1.0),
        "state_b_h": nrm((N_B, DEC_BATCH, B_WIDTH), 0.5),
        "cache_c_k": nrm((N_C, DEC_BATCH, c_win, C_HEADS, C_HEAD_DIM), 1.0),
        "cache_c_v": nrm((N_C, DEC_BATCH, c_win, C_HEADS, C_HEAD_DIM), 1.0),
        "norm_mix_g": gain((DEPTH, d)),
        "norm_mlp_g": gain((DEPTH, d)),
        "norm_final_g": gain((d,)),
        "a_w_in": nrm((N_A, d, 3 * d), d ** -0.5),
        "a_q_norm_g": gain((N_A, A_HEAD_DIM)),
        "a_k_norm_g": gain((N_A, A_HEAD_DIM)),
        "a_lambda": nrm((N_A, 4, A_HEAD_DIM), 0.1),
        "a_subln_g": gain((N_A, 2 * A_HEAD_DIM)),
        "a_w_out": nrm((N_A, d, d), d ** -0.5),
        "b_w_in": nrm((N_B, d, 2 * B_WIDTH), d ** -0.5),
        "b_b_in": nrm((N_B, 2 * B_WIDTH), 0.02),
        "b_conv_w": nrm((N_B, B_CONV_W, B_WIDTH), B_CONV_W ** -0.5),
        "b_conv_b": nrm((N_B, B_WIDTH), 0.02),
        "b_gate_a_w": nrm((N_B, B_BLOCKS, B_BLOCK_W, B_BLOCK_W), B_BLOCK_W ** -0.5),
        "b_gate_a_b": nrm((N_B, B_WIDTH), 0.02),
        "b_gate_x_w": nrm((N_B, B_BLOCKS, B_BLOCK_W, B_BLOCK_W), B_BLOCK_W ** -0.5),
        "b_gate_x_b": nrm((N_B, B_WIDTH), 0.02),
        "b_lambda": b_lambda,
        "b_w_out": nrm((N_B, B_WIDTH, d), B_WIDTH ** -0.5),
        "c_w_in": nrm((N_C, d, 3 * d), d ** -0.5),
        "c_q_norm_g": gain((N_C, C_HEAD_DIM)),
        "c_k_norm_g": gain((N_C, C_HEAD_DIM)),
        "c_rel_bias": nrm((N_C, 2 * C_REL_CLIP + 1, C_HEADS), 0.2),
        "c_w_out": nrm((N_C, d, d), d ** -0.5),
        "mlp_w1": nrm((DEPTH, d, D_FF), d ** -0.5),
        "mlp_w2": nrm((DEPTH, D_FF, d), 0.5 * D_FF ** -0.5),
    }


def reference(x_prompt, x_sample, cache_a_k, cache_a_v, state_b_conv, state_b_h, cache_c_k, cache_c_v,
              norm_mix_g, norm_mlp_g, norm_final_g,
              a_w_in, a_q_norm_g, a_k_norm_g, a_lambda, a_subln_g, a_w_out,
              b_w_in, b_b_in, b_conv_w, b_conv_b, b_gate_a_w, b_gate_a_b, b_gate_x_w, b_gate_x_b,
              b_lambda, b_w_out,
              c_w_in, c_q_norm_g, c_k_norm_g, c_rel_bias, c_w_out,
              mlp_w1, mlp_w2):
    xp, xs = x_prompt, x_sample
    a_kp, a_vp, a_ks, a_vs = [], [], [], []
    b_cp, b_hp, b_cs, b_hs = [], [], [], []
    c_kp, c_vp, c_ks, c_vs = [], [], [], []
    for layer in range(DEPTH):
        kind = layer % N_MIXERS
        idx = layer // N_MIXERS
        hp = rms_norm(xp, norm_mix_g[layer])
        hs = rms_norm(xs, norm_mix_g[layer])
        if kind == 0:
            lam_init = 0.8 - 0.6 * math.exp(-0.3 * layer)
            yp, ys, kp, vp, ks, vs = diff_mixer(
                hp, hs, cache_a_k[idx], cache_a_v[idx], a_w_in[idx], a_q_norm_g[idx], a_k_norm_g[idx],
                a_lambda[idx], a_subln_g[idx], a_w_out[idx], lam_init)
            a_kp.append(kp); a_vp.append(vp); a_ks.append(ks); a_vs.append(vs)
        elif kind == 1:
            blk = (b_w_in[idx], b_b_in[idx], b_conv_w[idx], b_conv_b[idx], b_gate_a_w[idx], b_gate_a_b[idx],
                   b_gate_x_w[idx], b_gate_x_b[idx], b_lambda[idx], b_w_out[idx])
            Bp = hp.shape[0]
            yp, cp, h_p = rglru_block(hp, jnp.zeros((Bp, B_CONV_W - 1, B_WIDTH), hp.dtype),
                                      jnp.zeros((Bp, B_WIDTH), state_b_h.dtype), *blk)
            ys, cs, h_s = rglru_block(hs, state_b_conv[idx], state_b_h[idx], *blk)
            b_cp.append(cp); b_hp.append(h_p); b_cs.append(cs); b_hs.append(h_s)
        else:
            yp, ys, kp, vp, ks, vs = band_mixer(
                hp, hs, cache_c_k[idx], cache_c_v[idx], c_w_in[idx], c_q_norm_g[idx], c_k_norm_g[idx],
                c_rel_bias[idx], c_w_out[idx])
            c_kp.append(kp); c_vp.append(vp); c_ks.append(ks); c_vs.append(vs)
        xp = xp + yp
        xs = xs + ys
        xp = xp + sq_relu_mlp(rms_norm(xp, norm_mlp_g[layer]), mlp_w1[layer], mlp_w2[layer])
        xs = xs + sq_relu_mlp(rms_norm(xs, norm_mlp_g[layer]), mlp_w1[layer], mlp_w2[layer])
    y_prompt = rms_norm(xp, norm_final_g)
    y_sample = rms_norm(xs, norm_final_g)
    return (y_prompt, y_sample,
            jnp.stack(a_kp), jnp.stack(a_vp), jnp.stack(a_ks), jnp.stack(a_vs),
            jnp.stack(b_cp), jnp.stack(b_hp), jnp.stack(b_cs), jnp.stack(b_hs),
            jnp.stack(c_kp), jnp.stack(c_vp), jnp.stack(c_ks), jnp.stack(c_vs))
```

```cpp
#include <hip/hip_runtime.h>
#include <cstdio>
#include <cstdint>
#include <cmath>

constexpr int D = 1024, NB = 16, SEQ = 2048, MP = NB * SEQ  , DSEQ = 16, MS = NB * DSEQ  , MT = MP + MS  ;
constexpr int PAST = 4096, FF = 4096, CWIN = 512, NTAB = 257;
constexpr float EPS = 1e-6f;
constexpr float LOG2E = 1.4426950408889634f;
constexpr float QSCALE = 0.125f * LOG2E;

namespace pg8 {
#define PG8_LAS __attribute__((address_space(3)))
typedef unsigned short bf16_t;
typedef short bf16x8 __attribute__((ext_vector_type(8)));
typedef float f32x4 __attribute__((ext_vector_type(4)));
typedef float f32x2 __attribute__((ext_vector_type(2)));
typedef unsigned u32x4 __attribute__((ext_vector_type(4)));
typedef unsigned u32x2 __attribute__((ext_vector_type(2)));
constexpr int BM = 256, BK = 64, HALF = 128, HTB = HALF * BK * 2  , STAGE_BYTES = 8 * HTB, NXCD = 8, WGM = 8;

__host__ __device__ __forceinline__ int lds_byte(int r, int c) { const int st = (r >> 4) * 2 + (c >> 5), rr = r & 15, cc = c & 31, ob = rr * 64 + cc * 2; return st * 1024 + (ob ^ (((ob >> 9) & 1) << 5)); }
__host__ __device__ __forceinline__ void stage_rc(int b, int& R, int& C) { const int st = b / 1024, sb = b % 1024, swz = sb ^ (((sb >> 9) & 1) << 5); R = (st >> 1) * 16 + swz / 64; C = (st & 1) * 32 + (swz % 64) / 2; }
__host__ __device__ __forceinline__ int perm32(int rho) { const int n = rho >> 4, i = rho & 15; return 8 * (i >> 2) + 4 * n + (i & 3); }

struct Unit { int pm, pn; };
struct Gemm { const bf16_t* A; const bf16_t* Bt; int M, N, K; int a_shift; size_t a_blk;
    __device__ __forceinline__ size_t a_off(int pn) const { return (size_t)(pn >> a_shift) * a_blk; } };

struct StaticOrder {
    int nM, nN, nwg, G, c;
    __host__ __device__ void init(int M, int N, int G_, int c_) { nM = M / BM; nN = N / BM; nwg = nM * nN; G = G_; c = c_; }
    __host__ __device__ bool next(int i, Unit& u) const {
        const long L = (long)i * G + c; if (L >= nwg) return false;
        int wgid = (int)L; { const int q = nwg / NXCD, r = nwg % NXCD, xcd = wgid % NXCD, off = wgid / NXCD; wgid = (xcd < r ? xcd * (q + 1) : r * (q + 1) + (xcd - r) * q) + off; }
        const int nig = WGM * nN, gid = wgid / nig, fm = gid * WGM, gsz = (nM - fm) < WGM ? (nM - fm) : WGM;
        u.pm = fm + ((wgid % nig) % gsz); u.pn = (wgid % nig) / gsz; return true;
    }
    __device__ __forceinline__ void a_ready(const Unit&) const {}
    __device__ __forceinline__ void done(const Unit&) const {}
};

__device__ __forceinline__ unsigned cvt_pk_bf16(float lo, float hi) { typedef __bf16 bf2 __attribute__((ext_vector_type(2))); f32x2 v = {lo, hi}; bf2 b = __builtin_convertvector(v, bf2); return __builtin_bit_cast(unsigned, b); }
__device__ __forceinline__ u32x4 pack8(const float (&x)[8]) { u32x4 w; w.x = cvt_pk_bf16(x[0], x[1]); w.y = cvt_pk_bf16(x[2], x[3]); w.z = cvt_pk_bf16(x[4], x[5]); w.w = cvt_pk_bf16(x[6], x[7]); return w; }
__device__ __forceinline__ float bf2f(unsigned short h) { return __builtin_bit_cast(float, (unsigned)h << 16); }

template <bool ROPE> struct EpiQKV {
    static constexpr bool PERM = true, AFTER_DRAIN = false;
    bf16_t* Q; size_t qkv_stride  ; const float *qg, *kg, *rope; float *okp, *oks; size_t kvp_stride, kvs_stride  ; int t0;
    __device__ __forceinline__ void operator()(const f32x4 (&acc)[2][2][4][2], const Unit& u, int wr, int wc, int fr, int fq) const {
        const int kind = u.pn >> 2, hc = (u.pn & 3) * 4 + wc, j0 = 8 * fq, colb = hc * 64 + j0;
        bf16_t* dst = Q + (size_t)kind * qkv_stride;
        float g1[8], g2[8];
        if (kind < 2) { const float* gp = kind == 0 ? qg : kg;
#pragma unroll
            for (int i = 0; i < 8; ++i) { g1[i] = gp[j0 + i]; g2[i] = gp[32 + j0 + i]; } }
#pragma unroll
        for (int ai = 0; ai < 2; ++ai)
#pragma unroll
            for (int m = 0; m < 4; ++m) {
                const int row = u.pm * BM + ai * HALF + wr * 64 + m * 16 + fr;
                float x1[8], x2[8];
#pragma unroll
                for (int n = 0; n < 2; ++n)
#pragma unroll
                    for (int i = 0; i < 4; ++i) { x1[4 * n + i] = acc[ai][0][m][n][i]; x2[4 * n + i] = acc[ai][1][m][n][i]; }
                if (kind < 2) {
                    float ss = 0.f;
#pragma unroll
                    for (int i = 0; i < 8; ++i) ss += x1[i] * x1[i] + x2[i] * x2[i];
                    ss += __shfl_xor(ss, 16); ss += __shfl_xor(ss, 32);
                    const float rs = 1.0f / sqrtf(ss * (1.0f / 64.0f) + EPS);
#pragma unroll
                    for (int i = 0; i < 8; ++i) { x1[i] *= rs * g1[i]; x2[i] *= rs * g2[i]; }
                    if (ROPE) {
                        const int tpos = row < MP ? (row & (SEQ - 1)) : SEQ + ((row - MP) & (DSEQ - 1));
                        const float* rp = rope + (size_t)tpos * 64 + j0;
                        const f32x4 c0 = *(const f32x4*)rp, c1 = *(const f32x4*)(rp + 4), s0 = *(const f32x4*)(rp + 32), s1 = *(const f32x4*)(rp + 36);
#pragma unroll
                        for (int i = 0; i < 8; ++i) { const float c = i < 4 ? c0[i & 3] : c1[i & 3], s = i < 4 ? s0[i & 3] : s1[i & 3];
                            const float a = x1[i], b = x2[i]; x1[i] = a * c - b * s; x2[i] = b * c + a * s; }
                    }
                }
                if (kind >= 1) {
                    float* p = nullptr;
                    if (row < MP) { const int t = row & (SEQ - 1), b = row >> 11; if (t >= t0) p = okp + (size_t)(kind - 1) * kvp_stride + ((size_t)(b * (SEQ - t0) + (t - t0))) * D + colb; }
                    else p = oks + (size_t)(kind - 1) * kvs_stride + (size_t)(row - MP) * D + colb;
                    if (p) { *(f32x4*)p = (f32x4){x1[0], x1[1], x1[2], x1[3]}; *(f32x4*)(p + 4) = (f32x4){x1[4], x1[5], x1[6], x1[7]};
                             *(f32x4*)(p + 32) = (f32x4){x2[0], x2[1], x2[2], x2[3]}; *(f32x4*)(p + 36) = (f32x4){x2[4], x2[5], x2[6], x2[7]}; }
                }
                if (kind == 0) {
#pragma unroll
                    for (int i = 0; i < 8; ++i) { x1[i] *= QSCALE; x2[i] *= QSCALE; } }
                bf16_t* o = dst + (size_t)row * D + colb;
                *(u32x4*)o = pack8(x1); *(u32x4*)(o + 32) = pack8(x2);
            }
    }
};

struct EpiResAdd {
    static constexpr bool PERM = true, AFTER_DRAIN = false;
    float* X;
    __device__ __forceinline__ void operator()(const f32x4 (&acc)[2][2][4][2], const Unit& u, int wr, int wc, int fr, int fq) const {
        const int col0 = u.pn * BM + wc * 32 + 8 * fq;
#pragma unroll
        for (int ai = 0; ai < 2; ++ai)
#pragma unroll
            for (int m = 0; m < 4; ++m) { float* rowp = X + (size_t)(u.pm * BM + ai * HALF + wr * 64 + m * 16 + fr) * D + col0;
#pragma unroll
                for (int bj = 0; bj < 2; ++bj)
#pragma unroll
                    for (int n = 0; n < 2; ++n) { f32x4* p = (f32x4*)(rowp + bj * HALF + 4 * n); *p = *p + acc[ai][bj][m][n]; } }
    }
};

struct EpiRelu2 {
    static constexpr bool PERM = true, AFTER_DRAIN = false;
    bf16_t* O; int ldc;
    __device__ __forceinline__ void operator()(const f32x4 (&acc)[2][2][4][2], const Unit& u, int wr, int wc, int fr, int fq) const {
        const int col0 = u.pn * BM + wc * 32 + 8 * fq;
#pragma unroll
        for (int ai = 0; ai < 2; ++ai)
#pragma unroll
            for (int m = 0; m < 4; ++m) { bf16_t* rowp = O + (size_t)(u.pm * BM + ai * HALF + wr * 64 + m * 16 + fr) * ldc + col0;
#pragma unroll
                for (int bj = 0; bj < 2; ++bj) { float x[8];
#pragma unroll
                    for (int n = 0; n < 2; ++n)
#pragma unroll
                        for (int i = 0; i < 4; ++i) { const float v = fmaxf(acc[ai][bj][m][n][i], 0.f); x[4 * n + i] = v * v; }
                    *(u32x4*)(rowp + bj * HALF) = pack8(x); } }
    }
};

__device__ __forceinline__ float gelu_tanh(float x) {
    const float y = 0.7978845608028654f * (x + 0.044715f * x * x * x);
    const float e = __expf(2.0f * y);
    const float th = 1.0f - 2.0f / (1.0f + e);
    return 0.5f * x * (1.0f + th);
}
struct EpiBin {
    static constexpr bool PERM = true, AFTER_DRAIN = false;
    bf16_t *G, *U; const float* bias; float *ocp, *ocs;
    __device__ __forceinline__ void operator()(const f32x4 (&acc)[2][2][4][2], const Unit& u, int wr, int wc, int fr, int fq) const {
        const int col0 = u.pn * BM + wc * 32 + 8 * fq; const bool isu = u.pn >= 4;
        float bv[2][8];
#pragma unroll
        for (int bj = 0; bj < 2; ++bj)
#pragma unroll
            for (int i = 0; i < 8; ++i) bv[bj][i] = bias[col0 + bj * HALF + i];
#pragma unroll
        for (int ai = 0; ai < 2; ++ai)
#pragma unroll
            for (int m = 0; m < 4; ++m) { const int row = u.pm * BM + ai * HALF + wr * 64 + m * 16 + fr;
#pragma unroll
                for (int bj = 0; bj < 2; ++bj) { float x[8];
#pragma unroll
                    for (int n = 0; n < 2; ++n)
#pragma unroll
                        for (int i = 0; i < 4; ++i) x[4 * n + i] = acc[ai][bj][m][n][i] + bv[bj][4 * n + i];
                    if (!isu) {
#pragma unroll
                        for (int i = 0; i < 8; ++i) x[i] = gelu_tanh(x[i]);
                        *(u32x4*)(G + (size_t)row * D + col0 + bj * HALF) = pack8(x);
                    } else {
                        const int uc = col0 + bj * HALF - D;
                        *(u32x4*)(U + (size_t)row * D + uc) = pack8(x);
                        float* p = nullptr;
                        if (row < MP) { const int t = row & (SEQ - 1), b = row >> 11; if (t >= SEQ - 3) p = ocp + (size_t)(b * 3 + (t - (SEQ - 3))) * D + uc; }
                        else { const int s = row - MP, t = s & (DSEQ - 1), b = s >> 4; if (t >= DSEQ - 3) p = ocs + (size_t)(b * 3 + (t - (DSEQ - 3))) * D + uc; }
                        if (p) { *(f32x4*)p = (f32x4){x[0], x[1], x[2], x[3]}; *(f32x4*)(p + 4) = (f32x4){x[4], x[5], x[6], x[7]}; }
                    } } }
    }
};

struct EpiGates {
    static constexpr bool PERM = true, AFTER_DRAIN = false;
    const bf16_t* XCB; const float *gab, *gxb, *sp8  ; float *AA, *BB;
    __device__ __forceinline__ void operator()(const f32x4 (&acc)[2][2][4][2], const Unit& u, int wr, int wc, int fr, int fq) const {
        const int nb = u.pn >> 1, cin = 128 * (u.pn & 1) + wc * 32 + 8 * fq, ch0 = 256 * nb + cin;
        const unsigned row0 = (unsigned)(u.pm * BM + wr * 64 + fr);
        const unsigned xoff0 = ((unsigned)nb * MT + row0) * 256u + (unsigned)cin, ooff0 = row0 * (unsigned)D + (unsigned)ch0;
#pragma unroll
        for (int n = 0; n < 2; ++n) {
            const f32x4 ba = *(const f32x4*)(gab + ch0 + 4 * n), bx = *(const f32x4*)(gxb + ch0 + 4 * n), sp = *(const f32x4*)(sp8 + ch0 + 4 * n);
#pragma unroll
            for (int ai = 0; ai < 2; ++ai)
#pragma unroll
                for (int m = 0; m < 4; ++m) {
                    const unsigned dr = (unsigned)(ai * HALF + m * 16);
                    const u32x2 xw = *(const u32x2*)(XCB + (xoff0 + dr * 256u + 4u * n));
                    f32x4 a, b;
#pragma unroll
                    for (int i = 0; i < 4; ++i) {
                        const unsigned w = i < 2 ? xw.x : xw.y;
                        const float xc = bf2f((unsigned short)((i & 1) ? (w >> 16) : (w & 0xffffu)));
                        const float r = 1.0f / (1.0f + __expf(-(acc[ai][0][m][n][i] + ba[i])));
                        const float ig = 1.0f / (1.0f + __expf(-(acc[ai][1][m][n][i] + bx[i])));
                        const float la = -r * sp[i], t2 = 2.0f * la;
                        a[i] = __expf(la);
                        const float poly = -t2 * (1.0f + t2 * (0.5f + t2 * (0.16666667f + t2 * (0.041666668f + t2 * (0.0083333338f + t2 * 0.0013888889f)))));
                        const float em = t2 > -0.25f ? poly : 1.0f - __expf(t2);
                        b[i] = sqrtf(em) * (ig * xc); }
                    *(f32x4*)(AA + (ooff0 + dr * (unsigned)D + 4u * n)) = a; *(f32x4*)(BB + (ooff0 + dr * (unsigned)D + 4u * n)) = b;
                    asm volatile("" ::: "memory"); }
        }
    }
};

template <class Epi, class Sched, bool ALIGN_EPI = false, bool SP2 = false>
__device__ __forceinline__ void gemm_phase(PG8_LAS unsigned char* lds, const Gemm g, const Sched& S, const Epi& E, const int tid_in) {
    const int tid = tid_in; const int wid = __builtin_amdgcn_readfirstlane(tid >> 6), lane = tid & 63, wr = wid >> 2, wc = wid & 3, fr = lane & 15, fq = lane >> 4;
    int K = g.K; asm volatile("" : "+s"(K)); const int nt = K / BK;
    unsigned voffA[2], voffB[2];
#pragma unroll
    for (int i = 0; i < 2; ++i) { int R, C; stage_rc(tid * 16 + i * 8192, R, C); const int Rb = Epi::PERM ? ((R & ~31) + perm32(R & 31)) : R;
        voffA[i] = (unsigned)(R * K + C) * 2u; voffB[i] = (unsigned)(Rb * K + C) * 2u; }
    const size_t kstep = (size_t)(BK * 2);
    const size_t hstep = (size_t)HALF * K * 2;
    const size_t tstep = 2 * hstep;
    const unsigned ldsw = (unsigned)wid * 1024u;
    const int aoff = lds_byte(wr * 64 + fr, fq * 8), boff = lds_byte(wc * 32 + fr, fq * 8);
#define PG8_SA(b, h) (((b) * 2 + (h)) * HTB)
#define PG8_SB(b, h) ((4 + (b) * 2 + (h)) * HTB)
#define PG8_STAGE(bufoff, gbase, voff) do { _Pragma("unroll") for (int _i = 0; _i < 2; ++_i) \
        __builtin_amdgcn_global_load_lds((const unsigned*)((const char*)(gbase) + (voff)[_i]), (PG8_LAS unsigned*)(lds + (bufoff) + ldsw + _i * 8192), 16, 0, 0); } while (0)
#define PG8_LDA(dst, b, h) do { _Pragma("unroll") for (int m = 0; m < 4; ++m) _Pragma("unroll") for (int k = 0; k < 2; ++k) dst[m][k] = *(const PG8_LAS bf16x8*)(lds + PG8_SA(b, h) + aoff + m * 2048 + k * 1024); } while (0)
#define PG8_LDB(dst, b, h) do { _Pragma("unroll") for (int n = 0; n < 2; ++n) _Pragma("unroll") for (int k = 0; k < 2; ++k) dst[n][k] = *(const PG8_LAS bf16x8*)(lds + PG8_SB(b, h) + boff + n * 2048 + k * 1024); } while (0)
#define PG8_MMA(ai, bj, At, Bt) do { __builtin_amdgcn_s_setprio(1); _Pragma("unroll") for (int m = 0; m < 4; ++m) _Pragma("unroll") for (int n = 0; n < 2; ++n) _Pragma("unroll") for (int k = 0; k < 2; ++k) \
        acc[ai][bj][m][n] = __builtin_amdgcn_mfma_f32_16x16x32_bf16(Bt[n][k], At[m][k], acc[ai][bj][m][n], 0, 0, 0); __builtin_amdgcn_s_setprio(0); } while (0)
#define PG8_WAIT_V(n) asm volatile("s_waitcnt vmcnt(" #n ")" ::: "memory")
#define PG8_WAIT_L(n) asm volatile("s_waitcnt lgkmcnt(" #n ")" ::: "memory")
#define PG8_BAR __builtin_amdgcn_s_barrier()
#define PG8_SCHED __builtin_amdgcn_sched_barrier(0)
    Unit cur, nxt; int ui = 0;
    if (!S.next(0, cur)) return;
    f32x4 acc[2][2][4][2];
#pragma unroll
    for (int a = 0; a < 2; ++a)
#pragma unroll
        for (int b = 0; b < 2; ++b)
#pragma unroll
            for (int m = 0; m < 4; ++m)
#pragma unroll
                for (int n = 0; n < 2; ++n) acc[a][b][m][n] = (f32x4){0.f, 0.f, 0.f, 0.f};
    bf16x8 At[4][2], B0[2][2], B1[2][2];
    const char* cA = (const char*)g.A + (size_t)cur.pm * tstep + g.a_off(cur.pn); const char* cB = (const char*)g.Bt + (size_t)cur.pn * tstep;
    S.a_ready(cur);
    if constexpr (SP2) {
        PG8_STAGE(PG8_SB(0, 0), cB, voffB); PG8_STAGE(PG8_SB(0, 1), cB + hstep, voffB); PG8_STAGE(PG8_SA(0, 0), cA, voffA); PG8_STAGE(PG8_SA(0, 1), cA + hstep, voffA);
        if (wr == 1) PG8_BAR;
        PG8_WAIT_V(2); PG8_BAR;
        PG8_STAGE(PG8_SB(1, 0), cB + kstep, voffB); PG8_STAGE(PG8_SA(1, 0), cA + kstep, voffA); PG8_STAGE(PG8_SB(1, 1), cB + hstep + kstep, voffB);
        PG8_WAIT_V(6); PG8_BAR;
    } else {
        PG8_STAGE(PG8_SB(0, 0), cB, voffB); PG8_STAGE(PG8_SA(0, 0), cA, voffA); PG8_STAGE(PG8_SB(0, 1), cB + hstep, voffB); PG8_STAGE(PG8_SA(0, 1), cA + hstep, voffA);
        if (wr == 1) PG8_BAR;
        PG8_WAIT_V(4); PG8_BAR;
        PG8_STAGE(PG8_SB(1, 0), cB + kstep, voffB); PG8_STAGE(PG8_SA(1, 0), cA + kstep, voffA); PG8_STAGE(PG8_SB(1, 1), cB + hstep + kstep, voffB);
        PG8_WAIT_V(6); PG8_BAR;
    }
    for (;;) {
        const bool has_next = S.next(ui + 1, nxt);
        const char* nA = has_next ? (const char*)g.A + (size_t)nxt.pm * tstep + g.a_off(nxt.pn) : cA; const char* nB = has_next ? (const char*)g.Bt + (size_t)nxt.pn * tstep : cB;
        for (int t = 0; t < nt; t += 2) {
            const bool last = (t == nt - 2);
            const char* a1 = cA + (size_t)(t + 1) * kstep;
            const char* a2 = last ? nA : cA + (size_t)(t + 2) * kstep; const char* b2 = last ? nB : cB + (size_t)(t + 2) * kstep;
            const char* a3 = a2 + kstep; const char* b3 = b2 + kstep;
            if (last && has_next) S.a_ready(nxt);
            if constexpr (SP2) {
            PG8_LDB(B0, 0, 0); PG8_LDB(B1, 0, 1); PG8_SCHED; PG8_LDA(At, 0, 0); PG8_STAGE(PG8_SA(1, 1), a1 + hstep, voffA);
            PG8_WAIT_V(8); PG8_WAIT_L(0); PG8_BAR; PG8_MMA(0, 0, At, B0); PG8_MMA(0, 1, At, B1); PG8_BAR; PG8_SCHED;
            PG8_LDA(At, 0, 1); PG8_STAGE(PG8_SB(0, 0), b2, voffB); PG8_STAGE(PG8_SB(0, 1), b2 + hstep, voffB); PG8_STAGE(PG8_SA(0, 0), a2, voffA);
            PG8_WAIT_V(8); PG8_WAIT_L(0); PG8_BAR; PG8_MMA(1, 0, At, B0); PG8_MMA(1, 1, At, B1); PG8_BAR; PG8_SCHED;
            PG8_LDB(B0, 1, 0); PG8_LDB(B1, 1, 1); PG8_SCHED; PG8_LDA(At, 1, 0); PG8_STAGE(PG8_SA(0, 1), a2 + hstep, voffA);
            PG8_WAIT_V(8); PG8_WAIT_L(0); PG8_BAR; PG8_MMA(0, 0, At, B0); PG8_MMA(0, 1, At, B1); PG8_BAR; PG8_SCHED;
            PG8_LDA(At, 1, 1); PG8_STAGE(PG8_SB(1, 0), b3, voffB); PG8_STAGE(PG8_SB(1, 1), b3 + hstep, voffB); PG8_STAGE(PG8_SA(1, 0), a3, voffA);
            PG8_WAIT_V(8); PG8_WAIT_L(0); PG8_BAR; PG8_MMA(1, 0, At, B0); PG8_MMA(1, 1, At, B1); PG8_BAR; PG8_SCHED;
            } else {
            PG8_LDB(B0, 0, 0); PG8_SCHED; PG8_LDA(At, 0, 0); PG8_STAGE(PG8_SA(1, 1), a1 + hstep, voffA);
            PG8_WAIT_L(8); PG8_BAR; PG8_WAIT_L(0); PG8_MMA(0, 0, At, B0); PG8_BAR; PG8_SCHED;
            PG8_LDB(B1, 0, 1); PG8_STAGE(PG8_SB(0, 0), b2, voffB);
            PG8_BAR; PG8_WAIT_L(0); PG8_MMA(0, 1, At, B1); PG8_BAR;
            PG8_LDA(At, 0, 1); PG8_STAGE(PG8_SA(0, 0), a2, voffA);
            PG8_BAR; PG8_WAIT_L(0); PG8_MMA(1, 0, At, B0); PG8_BAR; PG8_SCHED;
            PG8_STAGE(PG8_SB(0, 1), b2 + hstep, voffB);
            PG8_WAIT_V(6); PG8_BAR; PG8_MMA(1, 1, At, B1); PG8_BAR;
            PG8_LDB(B0, 1, 0); PG8_SCHED; PG8_LDA(At, 1, 0); PG8_STAGE(PG8_SA(0, 1), a2 + hstep, voffA);
            PG8_WAIT_L(8); PG8_BAR; PG8_WAIT_L(0); PG8_MMA(0, 0, At, B0); PG8_BAR; PG8_SCHED;
            PG8_LDB(B1, 1, 1); PG8_STAGE(PG8_SB(1, 0), b3, voffB);
            PG8_BAR; PG8_WAIT_L(0); PG8_MMA(0, 1, At, B1); PG8_BAR;
            PG8_LDA(At, 1, 1); PG8_STAGE(PG8_SA(1, 0), a3, voffA);
            PG8_BAR; PG8_WAIT_L(0); PG8_MMA(1, 0, At, B0); PG8_BAR; PG8_SCHED;
            PG8_STAGE(PG8_SB(1, 1), b3 + hstep, voffB);
            PG8_WAIT_V(6); PG8_BAR; PG8_MMA(1, 1, At, B1); PG8_BAR;
            }
        }
        if constexpr (ALIGN_EPI) { if (wr == 0) PG8_BAR; }
        if constexpr (!Epi::AFTER_DRAIN) { E(acc, cur, wr, wc, fr, fq); S.done(cur); }
        if (!has_next) break;
#pragma unroll
        for (int a = 0; a < 2; ++a)
#pragma unroll
            for (int b = 0; b < 2; ++b)
#pragma unroll
                for (int m = 0; m < 4; ++m)
#pragma unroll
                    for (int n = 0; n < 2; ++n) acc[a][b][m][n] = (f32x4){0.f, 0.f, 0.f, 0.f};
        cur = nxt; cA = nA; cB = nB; ++ui;
        if constexpr (ALIGN_EPI) { if (wr == 1) PG8_BAR; }
    }
    PG8_WAIT_V(0);
    if constexpr (!ALIGN_EPI) { if (wr == 0) PG8_BAR; }
    PG8_BAR;
    if constexpr (Epi::AFTER_DRAIN) { E.fused(acc, cur, wr, wc, fr, fq, lds, wid, lane); S.done(cur); }
#undef PG8_SA
#undef PG8_SB
#undef PG8_STAGE
#undef PG8_LDA
#undef PG8_LDB
#undef PG8_MMA
#undef PG8_WAIT_V
#undef PG8_WAIT_L
#undef PG8_BAR
#undef PG8_SCHED
}
}

using pg8::bf16_t; using pg8::bf16x8; using pg8::f32x4; using pg8::f32x2; using pg8::u32x4; using pg8::u32x2; using pg8::cvt_pk_bf16; using pg8::bf2f;

enum { IN_XP = 0, IN_XS, IN_CAK, IN_CAV, IN_SBC, IN_SBH, IN_CCK, IN_CCV, IN_GMIX, IN_GMLP, IN_GFIN, IN_AWIN, IN_AQG, IN_AKG, IN_ALAM, IN_ASUB, IN_AWOUT,
       IN_BWIN, IN_BBIN, IN_BCW, IN_BCB, IN_BGAW, IN_BGAB, IN_BGXW, IN_BGXB, IN_BLAM, IN_BWOUT, IN_CWIN, IN_CQG, IN_CKG, IN_CBIAS, IN_CWOUT, IN_W1, IN_W2, N_IN };
constexpr size_t OUT_YP = 0, OUT_YS = OUT_YP + (size_t)MP * D, OUT_AKP = OUT_YS + (size_t)MS * D, OUT_AVP = OUT_AKP + 2 * (size_t)MP * D, OUT_AKS = OUT_AVP + 2 * (size_t)MP * D,
    OUT_AVS = OUT_AKS + 2 * (size_t)MS * D, OUT_BCP = OUT_AVS + 2 * (size_t)MS * D, OUT_BHP = OUT_BCP + (size_t)NB * 3 * D, OUT_BCS = OUT_BHP + (size_t)NB * D, OUT_BHS = OUT_BCS + (size_t)NB * 3 * D,
    OUT_CKP = OUT_BHS + (size_t)NB * D, OUT_CVP = OUT_CKP + (size_t)NB * CWIN * D, OUT_CKS = OUT_CVP + (size_t)NB * CWIN * D, OUT_CVS = OUT_CKS + (size_t)MS * D, OUT_TOTAL = OUT_CVS + (size_t)MS * D;
static_assert(OUT_TOTAL == 186515456ull, "output map");

constexpr size_t MiB = 1u << 20;
constexpr size_t ACT_BF = (size_t)MT * D * 2;
constexpr size_t WS_CTL = 0, CTL_ZERO_BYTES = 1 * MiB;
constexpr size_t WS_ROPE = 1 * MiB;
constexpr size_t WS_SP8 = WS_ROPE + 1 * MiB;
constexpr size_t WS_CP = 3 * MiB, WS_CH = 5 * MiB;
constexpr size_t WS_W = 8 * MiB;
constexpr size_t W_AIN = 0, W_AOUT = W_AIN + 2ull * 3072 * 1024, W_BIN = W_AOUT + 2ull * 1024 * 1024, W_BG = W_BIN + 2048ull * 1024, W_BOUT = W_BG + 2048ull * 256,
    W_CIN = W_BOUT + 1024ull * 1024, W_COUT = W_CIN + 3072ull * 1024, W_1 = W_COUT + 1024ull * 1024, W_2 = W_1 + 4ull * 4096 * 1024, W_END = W_2 + 4ull * 4096 * 1024;
constexpr size_t WS_X = WS_W + ((W_END * 2 + MiB - 1) / MiB) * MiB;
constexpr size_t WS_XN = WS_X + (size_t)MT * D * 4;
constexpr size_t WS_Q = WS_XN + ACT_BF, WS_K = WS_Q + ACT_BF, WS_V = WS_K + ACT_BF, WS_ON = WS_V + ACT_BF;
constexpr size_t WS_H = WS_ON + ACT_BF;
constexpr size_t WS_AA = WS_H + (size_t)MT * FF * 2, WS_BB = WS_AA + (size_t)MT * D * 4;
constexpr size_t WS_PO = WS_BB + (size_t)MT * D * 4;
constexpr int NSPLIT = 16;
constexpr size_t WS_PML = WS_PO + 128ull * NSPLIT * 2 * 16 * 128 * 4;
constexpr size_t WS_END = WS_PML + 1 * MiB;

constexpr int RING_OFF = 0, RING_BYTES = 131072;
constexpr int LDSCTL_OFF = RING_BYTES, MISC_OFF = LDSCTL_OFF + 320;
constexpr int LDS_BYTES = 147456;
constexpr int NWAVES = 8;

#define GAS __attribute__((address_space(1)))
#define LAS __attribute__((address_space(3)))
typedef GAS unsigned gu32;
#define RLX_AGENT __ATOMIC_RELAXED, __HIP_MEMORY_SCOPE_AGENT
#define LDS_WAIT() asm volatile("s_waitcnt lgkmcnt(0)" ::: "memory")
#define VM_WAIT() asm volatile("s_waitcnt vmcnt(0)" ::: "memory")

#define XB_TMO      128
#define XB_XCNT(j)  (256  + 64 * (j))
#define XB_XSUB(j)  (1280 + 64 * (j))
#define XB_XGEN(j)  (2304 + 64 * (j))
#define XB_TOP      3328
#define XB_TOPGEN   3392
#define XCD_BAR_WORDS 3456
#define XB_SPIN_CAP (1u << 22)
constexpr int CW_BAR = 4096;

__device__ __forceinline__ unsigned xb_ld(unsigned* p)              { return __hip_atomic_load(p, __ATOMIC_RELAXED, __HIP_MEMORY_SCOPE_AGENT); }
__device__ __forceinline__ unsigned xb_add(unsigned* p, unsigned v) { return __hip_atomic_fetch_add(p, v, __ATOMIC_RELAXED, __HIP_MEMORY_SCOPE_AGENT); }
__device__ __forceinline__ unsigned xb_xcc_id() { return (unsigned)__builtin_amdgcn_s_getreg((3 << 11) | 20) & 0xFu; }
#define XB_SPIN(cond, bar) do { unsigned _sp = 0; while (cond) { __builtin_amdgcn_s_sleep(1); \
    if ((++_sp & 255u) == 0u) { if (xb_ld(&(bar)[XB_TMO])) break; if (_sp > XB_SPIN_CAP) { atomicAdd(&(bar)[XB_TMO], 1u); break; } } } } while (0)

struct XcdBarrier { unsigned* bar; unsigned x; volatile LAS unsigned* st; };

__device__ __forceinline__ XcdBarrier xcd_barrier_post(unsigned* bar, volatile LAS unsigned* st) {
    XcdBarrier b; b.bar = bar; b.x = xb_xcc_id(); b.st = st;
    if (threadIdx.x == 0) (void)xb_add(&bar[XB_XCNT(b.x)], 1u);
    return b;
}
__device__ __forceinline__ void xcd_barrier_complete(unsigned* bar, unsigned x, unsigned& nloc, unsigned& nx) {
    const unsigned G = gridDim.x * gridDim.y * gridDim.z;
    unsigned sum, cnt, mine, sp = 0u;
    for (;;) {
        sum = 0u; cnt = 0u; mine = 0u;
#pragma unroll
        for (unsigned j = 0; j < 16; ++j) { const unsigned c = xb_ld(&bar[XB_XCNT(j)]); sum += c; cnt += (c > 0u) ? 1u : 0u; mine = (j == x) ? c : mine; }
        if (sum == G) break;
        __builtin_amdgcn_s_sleep(1);
        if ((++sp & 255u) == 0u) { if (xb_ld(&bar[XB_TMO])) break; if (sp > XB_SPIN_CAP) { atomicAdd(&bar[XB_TMO], 1u); break; } }
    }
    nloc = mine > 0u ? mine : 1u; nx = cnt > 0u ? cnt : 1u;
}
__device__ __forceinline__ void xcd_barrier(const XcdBarrier& b) {
    asm volatile("s_waitcnt vmcnt(0)" ::: "memory");
    __syncthreads();
    if (threadIdx.x == 0) {
        unsigned* bar = b.bar;
        __builtin_amdgcn_s_waitcnt(0);
        unsigned nloc = b.st[0], nx = b.st[1];
        if (nloc == 0u) { xcd_barrier_complete(bar, b.x, nloc, nx); b.st[0] = nloc; b.st[1] = nx; }
        const unsigned old = xb_add(&bar[XB_XSUB(b.x)], 1u);
        const unsigned gen = old / nloc;
        if (old + 1u == (gen + 1u) * nloc) {
            __builtin_amdgcn_fence(__ATOMIC_RELEASE, "agent");
            asm volatile("s_waitcnt vmcnt(0)" ::: "memory");
            const unsigned og = xb_add(&bar[XB_TOP], 1u);
            const unsigned tg = og / nx;
            if (og + 1u == (tg + 1u) * nx) xb_add(&bar[XB_TOPGEN], 1u);
            else XB_SPIN(xb_ld(&bar[XB_TOPGEN]) == tg, bar);
            __builtin_amdgcn_fence(__ATOMIC_ACQUIRE, "agent");
            xb_add(&bar[XB_XGEN(b.x)], 1u);
            asm volatile("s_waitcnt vmcnt(0)" ::: "memory");
        } else {
            XB_SPIN(xb_ld(&bar[XB_XGEN(b.x)]) == gen, bar);
            __builtin_amdgcn_fence(__ATOMIC_ACQUIRE, "agent");
            asm volatile("s_waitcnt vmcnt(0)" ::: "memory");
        }
    }
    __syncthreads();
}

__device__ __forceinline__ float wave_sum(float v) {
#pragma unroll
    for (int o = 1; o < 64; o <<= 1) v += __shfl_xor(v, o);
    return v;
}
__device__ __forceinline__ unsigned f2bf(float f) { unsigned u = __builtin_bit_cast(unsigned, f); return (u + 0x7fffu + ((u >> 16) & 1u)) >> 16; }
__device__ __forceinline__ unsigned pk2(float lo, float hi) { return f2bf(lo) | (f2bf(hi) << 16); }

__device__ __forceinline__ void tr_item(const float* W, int N, int k0, int n0, bf16_t* WT, int K, int dst_row0, LAS float* scr, int lane) {
#pragma unroll 8
    for (int i = 0; i < 32; ++i) { const int kk = 2 * i + (lane >> 5); scr[kk * 33 + (lane & 31)] = W[(size_t)(k0 + kk) * N + n0 + (lane & 31)]; }
    LDS_WAIT(); asm volatile("" ::: "memory");
    const int c = lane & 7;
#pragma unroll
    for (int j = 0; j < 4; ++j) { const int n = (lane >> 3) + 8 * j; const LAS float* s = scr + (8 * c) * 33 + n;
        u32x4 o; o.x = pk2(s[0 * 33], s[1 * 33]); o.y = pk2(s[2 * 33], s[3 * 33]); o.z = pk2(s[4 * 33], s[5 * 33]); o.w = pk2(s[6 * 33], s[7 * 33]);
        *(u32x4*)(WT + (size_t)(dst_row0 + n) * K + k0 + 8 * c) = o; }
    LDS_WAIT(); asm volatile("" ::: "memory");
}
__device__ __forceinline__ int qkv_phys_row(int n0) { const int lb = (n0 & 255) >> 5, wc = lb >> 1, bjh = lb & 1; return (n0 & ~255) + (bjh * 4 + wc) * 32; }

__device__ __forceinline__ void norm_row(const float* xrow, const float* g, bf16_t* orow, float* copyrow, float* f32out, int lane) {
    const f32x4* xr = (const f32x4*)xrow + lane; const f32x4* gr = (const f32x4*)g + lane;
    f32x4 v[4]; float s = 0.f;
#pragma unroll
    for (int j = 0; j < 4; ++j) { v[j] = xr[64 * j]; s += (v[j].x * v[j].x + v[j].y * v[j].y) + (v[j].z * v[j].z + v[j].w * v[j].w); }
    if (copyrow) {
#pragma unroll
        for (int j = 0; j < 4; ++j) ((f32x4*)copyrow + lane)[64 * j] = v[j]; }
    const float rs = 1.0f / sqrtf(wave_sum(s) * (1.0f / D) + EPS);
#pragma unroll
    for (int j = 0; j < 4; ++j) { const f32x4 gg = gr[64 * j]; v[j] = v[j] * rs * gg; }
    if (orow) { unsigned long long* o8 = (unsigned long long*)orow + lane;
#pragma unroll
        for (int j = 0; j < 4; ++j) o8[64 * j] = (unsigned long long)cvt_pk_bf16(v[j].x, v[j].y) | ((unsigned long long)cvt_pk_bf16(v[j].z, v[j].w) << 32); }
    if (f32out) {
#pragma unroll
        for (int j = 0; j < 4; ++j) ((f32x4*)f32out + lane)[64 * j] = v[j]; }
}

struct AttnItem { const bf16_t* q; const float* kc; const float* vc; const bf16_t* kn; const bf16_t* vn; const float* btab; int cstride, n_cache, k_lo, k_hi, n_total, rel0, head; };

template <int NC, int DV>
__device__ __forceinline__ void attn16_core(const AttnItem& it, int lane, float (&m)[NC], float (&l)[NC], f32x4 (&o)[NC][DV / 16]) {
    const int g = lane >> 4, c16 = lane & 15;
    bf16x8 qop[NC][2];
#pragma unroll
    for (int c = 0; c < NC; ++c)
#pragma unroll
        for (int s = 0; s < 2; ++s) qop[c][s] = *(const bf16x8*)(it.q + (size_t)c16 * D + c * 64 + 32 * s + 8 * g);
#pragma unroll
    for (int c = 0; c < NC; ++c) { m[c] = -1e30f; l[c] = 0.f;
#pragma unroll
        for (int e = 0; e < DV / 16; ++e) o[c][e] = (f32x4){0.f, 0.f, 0.f, 0.f}; }
    for (int k0 = it.k_lo; k0 < it.k_hi; k0 += 32) {
        const bool cache = k0 < it.n_cache;
        f32x4 sacc[NC][2];
#pragma unroll
        for (int t = 0; t < 2; ++t) {
            int key = k0 + 16 * t + c16; key = key < it.n_total ? key : it.n_total - 1;
#pragma unroll
            for (int c = 0; c < NC; ++c) {
                f32x4 acc = (f32x4){0.f, 0.f, 0.f, 0.f};
#pragma unroll
                for (int s = 0; s < 2; ++s) {
                    bf16x8 a;
                    if (cache) { const float* p = it.kc + (size_t)key * it.cstride + c * 64 + 32 * s + 8 * g; const f32x4 v0 = *(const f32x4*)p, v1 = *(const f32x4*)(p + 4);
                        u32x4 w; w.x = cvt_pk_bf16(v0.x, v0.y); w.y = cvt_pk_bf16(v0.z, v0.w); w.z = cvt_pk_bf16(v1.x, v1.y); w.w = cvt_pk_bf16(v1.z, v1.w); a = __builtin_bit_cast(bf16x8, w); }
                    else a = *(const bf16x8*)(it.kn + (size_t)(key - it.n_cache) * D + c * 64 + 32 * s + 8 * g);
                    acc = __builtin_amdgcn_mfma_f32_16x16x32_bf16(a, qop[c][s], acc, 0, 0, 0);
                }
                sacc[c][t] = acc;
            }
        }
#pragma unroll
        for (int t = 0; t < 2; ++t)
#pragma unroll
            for (int r = 0; r < 4; ++r) { const int kidx = k0 + 16 * t + 4 * g + r;
                if (it.btab) { int rel = it.rel0 + c16 - kidx; rel = rel < -128 ? -128 : (rel > 128 ? 128 : rel); const float bv = it.btab[(rel + 128) * 16 + it.head] * LOG2E;
#pragma unroll
                    for (int c = 0; c < NC; ++c) sacc[c][t][r] += bv; }
                if (kidx >= it.n_total) {
#pragma unroll
                    for (int c = 0; c < NC; ++c) sacc[c][t][r] = -1e30f; } }
        bf16x8 pop[NC];
#pragma unroll
        for (int c = 0; c < NC; ++c) {
            float bm = fmaxf(fmaxf(fmaxf(sacc[c][0][0], sacc[c][0][1]), fmaxf(sacc[c][0][2], sacc[c][0][3])), fmaxf(fmaxf(sacc[c][1][0], sacc[c][1][1]), fmaxf(sacc[c][1][2], sacc[c][1][3])));
            bm = fmaxf(bm, __shfl_xor(bm, 16)); bm = fmaxf(bm, __shfl_xor(bm, 32));
            const float mn = fmaxf(m[c], bm), alpha = __builtin_amdgcn_exp2f(m[c] - mn); m[c] = mn;
            float p[8], ps = 0.f;
#pragma unroll
            for (int t = 0; t < 2; ++t)
#pragma unroll
                for (int r = 0; r < 4; ++r) { p[4 * t + r] = __builtin_amdgcn_exp2f(sacc[c][t][r] - mn); ps += p[4 * t + r]; }
            l[c] = l[c] * alpha + ps;
#pragma unroll
            for (int e = 0; e < DV / 16; ++e) o[c][e] = o[c][e] * alpha;
            u32x4 w; w.x = cvt_pk_bf16(p[0], p[1]); w.y = cvt_pk_bf16(p[2], p[3]); w.z = cvt_pk_bf16(p[4], p[5]); w.w = cvt_pk_bf16(p[6], p[7]); pop[c] = __builtin_bit_cast(bf16x8, w);
        }
        int vkey[8];
#pragma unroll
        for (int j = 0; j < 8; ++j) { int key = k0 + 16 * (j >> 2) + 4 * g + (j & 3); vkey[j] = key < it.n_total ? key : it.n_total - 1; }
#pragma unroll
        for (int e = 0; e < DV / 16; ++e) {
            bf16x8 av;
            if (cache) { float v[8];
#pragma unroll
                for (int j = 0; j < 8; ++j) v[j] = it.vc[(size_t)vkey[j] * it.cstride + e * 16 + c16];
                u32x4 w; w.x = cvt_pk_bf16(v[0], v[1]); w.y = cvt_pk_bf16(v[2], v[3]); w.z = cvt_pk_bf16(v[4], v[5]); w.w = cvt_pk_bf16(v[6], v[7]); av = __builtin_bit_cast(bf16x8, w); }
            else { unsigned short v[8];
#pragma unroll
                for (int j = 0; j < 8; ++j) v[j] = it.vn[(size_t)(vkey[j] - it.n_cache) * D + e * 16 + c16];
                u32x4 w; w.x = v[0] | ((unsigned)v[1] << 16); w.y = v[2] | ((unsigned)v[3] << 16); w.z = v[4] | ((unsigned)v[5] << 16); w.w = v[6] | ((unsigned)v[7] << 16); av = __builtin_bit_cast(bf16x8, w); }
#pragma unroll
            for (int c = 0; c < NC; ++c) o[c][e] = __builtin_amdgcn_mfma_f32_16x16x32_bf16(av, pop[c], o[c][e], 0, 0, 0);
        }
    }
#pragma unroll
    for (int c = 0; c < NC; ++c) { l[c] += __shfl_xor(l[c], 16); l[c] += __shfl_xor(l[c], 32); }
}

struct Args;
struct Args { const float* in[N_IN]; float* out; unsigned char* ws; int ph_lo, ph_hi, single, pad; float lam_init[2]; float rope_inv[32]; };

typedef const __attribute__((address_space(4))) Args* KArgs;
__device__ __forceinline__ KArgs kargs() { KArgs p = (KArgs)__builtin_amdgcn_kernarg_segment_ptr(); asm volatile("" : "+s"(p)); return p; }
__global__ void __launch_bounds__(NWAVES * 64, 2) fwd_kernel(Args args) {
    extern __shared__ __attribute__((aligned(16))) unsigned char lds[];
    LAS unsigned char* const ldsp = (LAS unsigned char*)lds;
    volatile LAS unsigned* const MISC = (volatile LAS unsigned*)(ldsp + MISC_OFF);
    const int tid = threadIdx.x; const int wave = __builtin_amdgcn_readfirstlane(tid >> 6);
    const int G = gridDim.x; const int bx = blockIdx.x; const int vcu = (G % 8 == 0) ? (bx % 8) * (G / 8) + bx / 8 : bx;
    const int gw = vcu * NWAVES + wave, NGW = G * NWAVES;
    const int NGT = NGW * 64;
    gu32* const ctl = (gu32*)(args.ws + WS_CTL);
    for (int u = tid; u < (LDS_BYTES - LDSCTL_OFF) / 4; u += NWAVES * 64) ((LAS unsigned*)(ldsp + LDSCTL_OFF))[u] = 0u;
    __syncthreads();
    XcdBarrier bar; bar.bar = (unsigned*)(ctl + CW_BAR); bar.x = 0; bar.st = nullptr;
    if (args.single) bar = xcd_barrier_post((unsigned*)(ctl + CW_BAR), MISC + 8);
    const int lo = args.ph_lo, hi = args.ph_hi;
#ifndef PHM
#define PHM 0xFFFFFFFFu
#endif
#define EN(b) (((PHM) >> (b)) & 1u)
#define RUN(k) (lo <= (k) && (k) < hi)
#define SEAM() do { if (args.single) xcd_barrier(bar); } while (0)

#define PHASE_PTRS \
    int lane = (int)__builtin_amdgcn_mbcnt_hi(~0u, __builtin_amdgcn_mbcnt_lo(~0u, 0u)); asm volatile("" : "+v"(lane)); const int gt = gw * 64 + lane; (void)gt; const int ptid = wave * 64 + lane; (void)ptid; int pG = G, pbx = bx; asm volatile("" : "+s"(pG), "+s"(pbx));   \
    const KArgs ap = kargs(); unsigned char* const ws = ap->ws; float* const out = ap->out; (void)out; \
    float* const X = (float*)(ws + WS_X); (void)X; bf16_t* const XN = (bf16_t*)(ws + WS_XN); (void)XN; \
    bf16_t* const Qb = (bf16_t*)(ws + WS_Q); (void)Qb; bf16_t* const Kb = (bf16_t*)(ws + WS_K); (void)Kb; bf16_t* const Vb = (bf16_t*)(ws + WS_V); (void)Vb; bf16_t* const ON = (bf16_t*)(ws + WS_ON); (void)ON; \
    bf16_t* const Hb = (bf16_t*)(ws + WS_H); (void)Hb; float* const AA = (float*)(ws + WS_AA); (void)AA; float* const BB = (float*)(ws + WS_BB); (void)BB; \
    float* const ROPE = (float*)(ws + WS_ROPE); (void)ROPE; float* const SP8 = (float*)(ws + WS_SP8); (void)SP8; \
    float* const CP = (float*)(ws + WS_CP); (void)CP; float* const CH = (float*)(ws + WS_CH); (void)CH; \
    float* const PO = (float*)(ws + WS_PO); (void)PO; float* const PML = (float*)(ws + WS_PML); (void)PML; \
    bf16_t* const Wb = (bf16_t*)(ws + WS_W); (void)Wb; \
    bf16_t* const Gb = Qb; (void)Gb; bf16_t* const Ub = Kb; (void)Ub; bf16_t* const XCB = Vb; (void)XCB; bf16_t* const HG = ON; (void)HG;

    if (EN(0) && RUN(0)) {
            PHASE_PTRS
        LAS float* scr = (LAS float*)(ldsp + RING_OFF + wave * 16384);
        constexpr int I_AIN = 16 * 96, I_SQ = 16 * 32, I_BIN = 16 * 64, I_G = 4 * 8, I_1 = 16 * 128, I_2 = 64 * 32;
        constexpr int NITEMS = 2 * I_AIN + 2 * I_SQ + I_BIN + 8 * I_G + I_SQ + I_AIN + I_SQ + 4 * I_1 + 4 * I_2;
        for (int it = gw; it < NITEMS; it += NGW) {
            int r = it;
            if (r < 2 * I_AIN) { const int li = r / I_AIN, q = r % I_AIN, kb = q / 96, nb = q % 96;
                tr_item(ap->in[IN_AWIN] + (size_t)li * 1024 * 3072, 3072, 64 * kb, 32 * nb, Wb + W_AIN + (size_t)li * 3072 * 1024, 1024, qkv_phys_row(32 * nb), scr, lane); continue; } r -= 2 * I_AIN;
            if (r < 2 * I_SQ) { const int li = r / I_SQ, q = r % I_SQ, kb = q / 32, nb = q % 32;
                tr_item(ap->in[IN_AWOUT] + (size_t)li * 1024 * 1024, 1024, 64 * kb, 32 * nb, Wb + W_AOUT + (size_t)li * 1024 * 1024, 1024, 32 * nb, scr, lane); continue; } r -= 2 * I_SQ;
            if (r < I_BIN) { const int kb = r / 64, nb = r % 64;
                tr_item(ap->in[IN_BWIN], 2048, 64 * kb, 32 * nb, Wb + W_BIN, 1024, 32 * nb, scr, lane); continue; } r -= I_BIN;
            if (r < 8 * I_G) { const int mi = r / I_G, q = r % I_G, gk = mi >> 2, blk = mi & 3, kb = q / 8, d0 = q % 8;
                const float* src = (gk == 0 ? ap->in[IN_BGAW] : ap->in[IN_BGXW]) + (size_t)blk * 256 * 256;
                tr_item(src, 256, 64 * kb, 32 * d0, Wb + W_BG, 256, (blk * 2 + (d0 >> 2)) * 256 + gk * 128 + (d0 & 3) * 32, scr, lane); continue; } r -= 8 * I_G;
            if (r < I_SQ) { const int kb = r / 32, nb = r % 32; tr_item(ap->in[IN_BWOUT], 1024, 64 * kb, 32 * nb, Wb + W_BOUT, 1024, 32 * nb, scr, lane); continue; } r -= I_SQ;
            if (r < I_AIN) { const int kb = r / 96, nb = r % 96; tr_item(ap->in[IN_CWIN], 3072, 64 * kb, 32 * nb, Wb + W_CIN, 1024, qkv_phys_row(32 * nb), scr, lane); continue; } r -= I_AIN;
            if (r < I_SQ) { const int kb = r / 32, nb = r % 32; tr_item(ap->in[IN_CWOUT], 1024, 64 * kb, 32 * nb, Wb + W_COUT, 1024, 32 * nb, scr, lane); continue; } r -= I_SQ;
            if (r < 4 * I_1) { const int li = r / I_1, q = r % I_1, kb = q / 128, nb = q % 128;
                tr_item(ap->in[IN_W1] + (size_t)li * 1024 * 4096, 4096, 64 * kb, 32 * nb, Wb + W_1 + (size_t)li * 4096 * 1024, 1024, 32 * nb, scr, lane); continue; } r -= 4 * I_1;
            { const int li = r / I_2, q = r % I_2, kb = q / 32, nb = q % 32;
                tr_item(ap->in[IN_W2] + (size_t)li * 4096 * 1024, 1024, 64 * kb, 32 * nb, Wb + W_2 + (size_t)li * 1024 * 4096, 4096, 32 * nb, scr, lane); }
        }
        for (int i = gt; i < (SEQ + DSEQ) * 32; i += NGT) { const int tp = i >> 5, d = i & 31; const int pos = tp < SEQ ? tp : PAST + (tp - SEQ);
            const float ang = (float)pos * ap->rope_inv[d];
            ROPE[(size_t)tp * 64 + d] = cosf(ang); ROPE[(size_t)tp * 64 + 32 + d] = sinf(ang); }
        for (int i = gt; i < D; i += NGT) { const float lm = ap->in[IN_BLAM][i]; SP8[i] = 8.0f * (fmaxf(-lm, 0.f) + log1pf(expf(-fabsf(lm)))); }
        for (int mrow = gw; mrow < MT; mrow += NGW) { const float* src = mrow < MP ? ap->in[IN_XP] + (size_t)mrow * D : ap->in[IN_XS] + (size_t)(mrow - MP) * D;
            norm_row(src, ap->in[IN_GMIX], XN + (size_t)mrow * D, X + (size_t)mrow * D, nullptr, lane); }
        SEAM();
    }

    for (int L = 0; L < 4; ++L) {
        const int kind = L % 3, idx = L / 3, base = 1 + 16 * L;
        if (kind == 0) {
            if (EN(1) && RUN(base + 0)) {
            PHASE_PTRS
                pg8::Gemm g{XN, Wb + W_AIN + (size_t)idx * 3072 * 1024, MT, 3072, 1024, 0, 0}; pg8::StaticOrder S; S.init(MT, 3072, pG, pbx);
                pg8::EpiQKV<true> E{Qb, ACT_BF / 2, ap->in[IN_AQG] + idx * 64, ap->in[IN_AKG] + idx * 64, ROPE,
                    out + OUT_AKP + (size_t)idx * MP * D, out + OUT_AKS + (size_t)idx * MS * D, OUT_AVP - OUT_AKP, OUT_AVS - OUT_AKS, 0};
                pg8::gemm_phase<pg8::EpiQKV<true>, pg8::StaticOrder, true, true>(ldsp + RING_OFF, g, S, E, ptid);
                SEAM();
            }
            if (EN(2) && RUN(base + 1)) {
            PHASE_PTRS
                const float* lp = ap->in[IN_ALAM] + idx * 256;
                const float s1 = wave_sum(lp[lane] * lp[64 + lane]), s2 = wave_sum(lp[128 + lane] * lp[192 + lane]);
                const float lam_init = ap->lam_init[idx], lam = expf(s1) - expf(s2) + lam_init;
                const int g4 = lane >> 4, c16 = lane & 15;
                for (int item = gw; item < 128 * NSPLIT; item += NGW) {
                    const int bh = item / NSPLIT, sp = item % NSPLIT, b = bh >> 3, h = bh & 7;
                    AttnItem it; it.q = Qb + (size_t)(MP + b * 16) * D + h * 128;
                    it.kc = ap->in[IN_CAK] + ((size_t)(idx * NB + b) * PAST) * D + h * 128; it.vc = ap->in[IN_CAV] + ((size_t)(idx * NB + b) * PAST) * D + h * 128;
                    it.kn = Kb + (size_t)(MP + b * 16) * D + h * 128; it.vn = Vb + (size_t)(MP + b * 16) * D + h * 128; it.btab = nullptr;
                    it.cstride = D; it.n_cache = PAST; it.k_lo = sp * 256; it.k_hi = (sp == NSPLIT - 1) ? PAST + 32 : (sp + 1) * 256; it.n_total = PAST + DSEQ; it.rel0 = 0; it.head = 0;
                    float m[2], l[2]; f32x4 o[2][8];
                    attn16_core<2, 128>(it, lane, m, l, o);
#pragma unroll
                    for (int c = 0; c < 2; ++c) { float* po = PO + (((size_t)item * 2 + c) * 16 + c16) * 128 + 4 * g4;
#pragma unroll
                        for (int e = 0; e < 8; ++e) *(f32x4*)(po + e * 16) = o[c][e];
                        if (g4 == 0) { float* pm = PML + (((size_t)item * 2 + c) * 16 + c16) * 2; pm[0] = m[c]; pm[1] = l[c]; } }
                }
                const float* sg = ap->in[IN_ASUB] + idx * 128;
                for (int k = 0; gw + k * NGW < NB * 8 * 128; ++k) {
                    const int id = gw + k * NGW, bh = id & 127, qr = id >> 7, qt = qr ^ (((qr >> 4) & 1) ? 15 : 0), b = bh >> 3, h = bh & 7;
                    AttnItem it; it.q = Qb + (size_t)(b * SEQ + qt * 16) * D + h * 128; it.kc = nullptr; it.vc = nullptr;
                    it.kn = Kb + (size_t)(b * SEQ) * D + h * 128; it.vn = Vb + (size_t)(b * SEQ) * D + h * 128; it.btab = nullptr;
                    it.cstride = 0; it.n_cache = 0; it.k_lo = 0; it.k_hi = 64 * ((qt >> 2) + 1); it.n_total = it.k_hi; it.rel0 = 0; it.head = 0;
                    float m[2], l[2]; f32x4 o[2][8];
                    attn16_core<2, 128>(it, lane, m, l, o);
                    const float i0 = 1.0f / l[0], i1 = lam / l[1]; float ss = 0.f;
#pragma unroll
                    for (int e = 0; e < 8; ++e) { o[0][e] = o[0][e] * i0 - o[1][e] * i1; ss += (o[0][e].x * o[0][e].x + o[0][e].y * o[0][e].y) + (o[0][e].z * o[0][e].z + o[0][e].w * o[0][e].w); }
                    ss += __shfl_xor(ss, 16); ss += __shfl_xor(ss, 32);
                    const float rs = (1.0f - lam_init) / sqrtf(ss * (1.0f / 128.0f) + EPS);
                    bf16_t* orow = ON + (size_t)(b * SEQ + qt * 16 + c16) * D + h * 128 + 4 * g4;
#pragma unroll
                    for (int e = 0; e < 8; ++e) { const f32x4 gg = *(const f32x4*)(sg + e * 16 + 4 * g4); const f32x4 v = o[0][e] * rs * gg;
                        u32x2 w; w.x = cvt_pk_bf16(v.x, v.y); w.y = cvt_pk_bf16(v.z, v.w); *(u32x2*)(orow + e * 16) = w; }
                }
                SEAM();
            }
            if (EN(3) && RUN(base + 2)) {
            PHASE_PTRS
                const float* lp = ap->in[IN_ALAM] + idx * 256;
                const float s1 = wave_sum(lp[lane] * lp[64 + lane]), s2 = wave_sum(lp[128 + lane] * lp[192 + lane]);
                const float lam_init = ap->lam_init[idx], lam = expf(s1) - expf(s2) + lam_init;
                const float* sg = ap->in[IN_ASUB] + idx * 128;
                for (int id = gw; id < MS * 8; id += NGW) {
                    const int s = id >> 3, h = id & 7, b = s >> 4, q = s & 15, bh = b * 8 + h;
                    f32x2 oc[2];
#pragma unroll
                    for (int c = 0; c < 2; ++c) {
                        float mx = -1e30f;
                        for (int sp = 0; sp < NSPLIT; ++sp) mx = fmaxf(mx, PML[((((size_t)bh * NSPLIT + sp) * 2 + c) * 16 + q) * 2]);
                        float lt = 0.f; f32x2 acc = (f32x2){0.f, 0.f};
                        for (int sp = 0; sp < NSPLIT; ++sp) { const size_t pi = (((size_t)bh * NSPLIT + sp) * 2 + c) * 16 + q; const float w = __builtin_amdgcn_exp2f(PML[pi * 2] - mx);
                            lt += PML[pi * 2 + 1] * w; const f32x2 v = *(const f32x2*)(PO + pi * 128 + 2 * lane); acc = acc + v * w; }
                        oc[c] = acc * (1.0f / lt);
                    }
                    const f32x2 ov = oc[0] - oc[1] * lam;
                    const float ss = wave_sum(ov.x * ov.x + ov.y * ov.y);
                    const float rs = (1.0f - lam_init) / sqrtf(ss * (1.0f / 128.0f) + EPS);
                    const f32x2 gg = *(const f32x2*)(sg + 2 * lane);
                    *(unsigned*)(ON + (size_t)(MP + s) * D + h * 128 + 2 * lane) = cvt_pk_bf16(ov.x * rs * gg.x, ov.y * rs * gg.y);
                }
                SEAM();
            }
            if (EN(4) && RUN(base + 3)) {
            PHASE_PTRS
                pg8::Gemm g{ON, Wb + W_AOUT + (size_t)idx * 1024 * 1024, MT, 1024, 1024, 0, 0}; pg8::StaticOrder S; S.init(MT, 1024, pG, pbx);
                pg8::EpiResAdd E{X};
                pg8::gemm_phase<pg8::EpiResAdd, pg8::StaticOrder, true, true>(ldsp + RING_OFF, g, S, E, ptid);
                SEAM();
            }
        } else if (kind == 1) {
            if (EN(5) && RUN(base + 0)) {
            PHASE_PTRS
                pg8::Gemm g{XN, Wb + W_BIN, MT, 2048, 1024, 0, 0}; pg8::StaticOrder S; S.init(MT, 2048, pG, pbx);
                pg8::EpiBin E{Gb, Ub, ap->in[IN_BBIN], out + OUT_BCP, out + OUT_BCS};
                pg8::gemm_phase<pg8::EpiBin, pg8::StaticOrder, true, true>(ldsp + RING_OFF, g, S, E, ptid);
                SEAM();
            }
            if (EN(6) && RUN(base + 1)) {
            PHASE_PTRS
                const float* cw = ap->in[IN_BCW]; const float* cb = ap->in[IN_BCB]; const float* hist = ap->in[IN_SBC];
                for (int i = gt; i < MT * 128; i += NGT) {
                    const int row = i >> 7, ch0 = (i & 127) * 8;
                    const bool pr = row < MP; const int t = pr ? (row & (SEQ - 1)) : ((row - MP) & (DSEQ - 1)); const int b = pr ? (row >> 11) : ((row - MP) >> 4);
                    float acc[8];
#pragma unroll
                    for (int c = 0; c < 8; ++c) acc[c] = cb[ch0 + c];
#pragma unroll
                    for (int j = 0; j < 4; ++j) { const int tt = t - 3 + j; float uv[8];
                        if (tt >= 0) { const u32x4 w = *(const u32x4*)(Ub + (size_t)(row - 3 + j) * D + ch0);
                            uv[0] = bf2f(w.x & 0xffff); uv[1] = bf2f(w.x >> 16); uv[2] = bf2f(w.y & 0xffff); uv[3] = bf2f(w.y >> 16); uv[4] = bf2f(w.z & 0xffff); uv[5] = bf2f(w.z >> 16); uv[6] = bf2f(w.w & 0xffff); uv[7] = bf2f(w.w >> 16); }
                        else if (!pr) { const float* hp = hist + (size_t)(b * 3 + (3 + tt)) * D + ch0;
#pragma unroll
                            for (int c = 0; c < 8; ++c) uv[c] = hp[c]; }
                        else {
#pragma unroll
                            for (int c = 0; c < 8; ++c) uv[c] = 0.f; }
#pragma unroll
                        for (int c = 0; c < 8; ++c) acc[c] += uv[c] * cw[j * D + ch0 + c]; }
                    *(u32x4*)(XCB + ((size_t)(ch0 >> 8) * MT + row) * 256 + (ch0 & 255)) = pg8::pack8(acc);
                }
                SEAM();
            }
            if (EN(7) && RUN(base + 2)) {
            PHASE_PTRS
                pg8::Gemm g{XCB, Wb + W_BG, MT, 2048, 256, 1, (size_t)MT * 256 * 2}; pg8::StaticOrder S; S.init(MT, 2048, pG, pbx);
                pg8::EpiGates E{XCB, ap->in[IN_BGAB], ap->in[IN_BGXB], SP8, AA, BB};
                pg8::gemm_phase<pg8::EpiGates, pg8::StaticOrder, true, true>(ldsp + RING_OFF, g, S, E, ptid);
                SEAM();
            }
            if (EN(8) && RUN(base + 3)) {
            PHASE_PTRS
                for (int id = gw; id < NB * 32 * 16; id += NGW) {
                    const int cg = id & 15, ck = (id >> 4) & 31, b = id >> 9, ch = cg * 64 + lane; const size_t r0 = (size_t)(b * SEQ + ck * 64) * D + ch;
                    float P = 1.f, Hc = 0.f;
                    for (int t0 = 0; t0 < 64; t0 += 8) { float a[8], bb[8];
#pragma unroll
                        for (int j = 0; j < 8; ++j) { a[j] = AA[r0 + (size_t)(t0 + j) * D]; bb[j] = BB[r0 + (size_t)(t0 + j) * D]; }
#pragma unroll
                        for (int j = 0; j < 8; ++j) { P *= a[j]; Hc = a[j] * Hc + bb[j]; } }
                    CP[(size_t)(b * 32 + ck) * D + ch] = P; CH[(size_t)(b * 32 + ck) * D + ch] = Hc;
                }
                SEAM();
            }
            if (EN(9) && RUN(base + 4)) {
            PHASE_PTRS
                for (int id = gw; id < NB * 32 * 16; id += NGW) {
                    const int cg = id & 15, ck = (id >> 4) & 31, b = id >> 9, ch = cg * 64 + lane; const size_t r0 = (size_t)(b * SEQ + ck * 64) * D + ch;
                    float h = 0.f;
                    for (int k = 0; k < ck; ++k) h = CP[(size_t)(b * 32 + k) * D + ch] * h + CH[(size_t)(b * 32 + k) * D + ch];
                    for (int t0 = 0; t0 < 64; t0 += 8) { float a[8], bb[8], gg[8];
#pragma unroll
                        for (int j = 0; j < 8; ++j) { a[j] = AA[r0 + (size_t)(t0 + j) * D]; bb[j] = BB[r0 + (size_t)(t0 + j) * D]; gg[j] = bf2f(Gb[r0 + (size_t)(t0 + j) * D]); }
#pragma unroll
                        for (int j = 0; j < 8; ++j) { h = a[j] * h + bb[j]; HG[r0 + (size_t)(t0 + j) * D] = (bf16_t)f2bf(h * gg[j]); } }
                    if (ck == 31) out[OUT_BHP + (size_t)b * D + ch] = h;
                }
                for (int id = gw; id < NB * 16; id += NGW) {
                    const int cg = id & 15, b = id >> 4, ch = cg * 64 + lane; const size_t r0 = (size_t)(MP + b * DSEQ) * D + ch;
                    float h = ap->in[IN_SBH][(size_t)b * D + ch];
#pragma unroll
                    for (int j = 0; j < DSEQ; ++j) { h = AA[r0 + (size_t)j * D] * h + BB[r0 + (size_t)j * D]; HG[r0 + (size_t)j * D] = (bf16_t)f2bf(h * bf2f(Gb[r0 + (size_t)j * D])); }
                    out[OUT_BHS + (size_t)b * D + ch] = h;
                }
                SEAM();
            }
            if (EN(10) && RUN(base + 5)) {
            PHASE_PTRS
                pg8::Gemm g{HG, Wb + W_BOUT, MT, 1024, 1024, 0, 0}; pg8::StaticOrder S; S.init(MT, 1024, pG, pbx);
                pg8::EpiResAdd E{X};
                pg8::gemm_phase<pg8::EpiResAdd, pg8::StaticOrder, true, true>(ldsp + RING_OFF, g, S, E, ptid);
                SEAM();
            }
        } else {
            if (EN(11) && RUN(base + 0)) {
            PHASE_PTRS
                pg8::Gemm g{XN, Wb + W_CIN, MT, 3072, 1024, 0, 0}; pg8::StaticOrder S; S.init(MT, 3072, pG, pbx);
                pg8::EpiQKV<false> E{Qb, ACT_BF / 2, ap->in[IN_CQG], ap->in[IN_CKG], ROPE, out + OUT_CKP, out + OUT_CKS, OUT_CVP - OUT_CKP, OUT_CVS - OUT_CKS, SEQ - CWIN};
                pg8::gemm_phase<pg8::EpiQKV<false>, pg8::StaticOrder, true, true>(ldsp + RING_OFF, g, S, E, ptid);
                SEAM();
            }
            if (EN(12) && RUN(base + 1)) {
            PHASE_PTRS
                const int g4 = lane >> 4, c16 = lane & 15; const float* tab = ap->in[IN_CBIAS];
                if (wave == 0 && vcu < NB * 16) {
                    const int b = vcu >> 4, h = vcu & 15;
                    AttnItem it; it.q = Qb + (size_t)(MP + b * 16) * D + h * 64;
                    it.kc = ap->in[IN_CCK] + ((size_t)b * CWIN) * D + h * 64; it.vc = ap->in[IN_CCV] + ((size_t)b * CWIN) * D + h * 64;
                    it.kn = Kb + (size_t)(MP + b * 16) * D + h * 64; it.vn = Vb + (size_t)(MP + b * 16) * D + h * 64; it.btab = tab;
                    it.cstride = D; it.n_cache = CWIN; it.k_lo = 0; it.k_hi = CWIN + 32; it.n_total = CWIN + DSEQ; it.rel0 = CWIN; it.head = h;
                    float m[1], l[1]; f32x4 o[1][4];
                    attn16_core<1, 64>(it, lane, m, l, o);
                    const float il = 1.0f / l[0]; bf16_t* orow = ON + (size_t)(MP + b * 16 + c16) * D + h * 64 + 4 * g4;
#pragma unroll
                    for (int e = 0; e < 4; ++e) { const f32x4 v = o[0][e] * il; u32x2 w; w.x = cvt_pk_bf16(v.x, v.y); w.y = cvt_pk_bf16(v.z, v.w); *(u32x2*)(orow + e * 16) = w; }
                }
                for (int id = gw; id < NB * 16 * 128; id += NGW) {
                    const int bh = id & 255, qt = id >> 8, b = bh >> 4, h = bh & 15, ck = qt >> 2;
                    AttnItem it; it.q = Qb + (size_t)(b * SEQ + qt * 16) * D + h * 64; it.kc = nullptr; it.vc = nullptr;
                    it.kn = Kb + (size_t)(b * SEQ) * D + h * 64; it.vn = Vb + (size_t)(b * SEQ) * D + h * 64; it.btab = tab;
                    it.cstride = 0; it.n_cache = 0; it.k_lo = ck >= 8 ? 64 * (ck - 8) : 0; it.k_hi = 64 * (ck + 1); it.n_total = it.k_hi; it.rel0 = qt * 16; it.head = h;
                    float m[1], l[1]; f32x4 o[1][4];
                    attn16_core<1, 64>(it, lane, m, l, o);
                    const float il = 1.0f / l[0]; bf16_t* orow = ON + (size_t)(b * SEQ + qt * 16 + c16) * D + h * 64 + 4 * g4;
#pragma unroll
                    for (int e = 0; e < 4; ++e) { const f32x4 v = o[0][e] * il; u32x2 w; w.x = cvt_pk_bf16(v.x, v.y); w.y = cvt_pk_bf16(v.z, v.w); *(u32x2*)(orow + e * 16) = w; }
                }
                SEAM();
            }
            if (EN(13) && RUN(base + 2)) {
            PHASE_PTRS
                pg8::Gemm g{ON, Wb + W_COUT, MT, 1024, 1024, 0, 0}; pg8::StaticOrder S; S.init(MT, 1024, pG, pbx);
                pg8::EpiResAdd E{X};
                pg8::gemm_phase<pg8::EpiResAdd, pg8::StaticOrder, true, true>(ldsp + RING_OFF, g, S, E, ptid);
                SEAM();
            }
        }
        if (EN(14) && RUN(base + 8)) {
            PHASE_PTRS
            for (int mrow = gw; mrow < MT; mrow += NGW) norm_row(X + (size_t)mrow * D, ap->in[IN_GMLP] + L * D, XN + (size_t)mrow * D, nullptr, nullptr, lane);
            SEAM();
        }
        if (EN(15) && RUN(base + 9)) {
            PHASE_PTRS
            pg8::Gemm g{XN, Wb + W_1 + (size_t)L * 4096 * 1024, MT, FF, 1024, 0, 0}; pg8::StaticOrder S; S.init(MT, FF, pG, pbx);
            pg8::EpiRelu2 E{Hb, FF};
            pg8::gemm_phase<pg8::EpiRelu2, pg8::StaticOrder, true, true>(ldsp + RING_OFF, g, S, E, ptid);
            SEAM();
        }
        if (EN(16) && RUN(base + 10)) {
            PHASE_PTRS
            pg8::Gemm g{Hb, Wb + W_2 + (size_t)L * 1024 * 4096, MT, 1024, FF, 0, 0}; pg8::StaticOrder S; S.init(MT, 1024, pG, pbx);
            pg8::EpiResAdd E{X};
            pg8::gemm_phase<pg8::EpiResAdd, pg8::StaticOrder, true, true>(ldsp + RING_OFF, g, S, E, ptid);
            SEAM();
        }
        if (EN(17) && RUN(base + 11)) {
            PHASE_PTRS
            if (L < 3) { for (int mrow = gw; mrow < MT; mrow += NGW) norm_row(X + (size_t)mrow * D, ap->in[IN_GMIX] + (L + 1) * D, XN + (size_t)mrow * D, nullptr, nullptr, lane); SEAM(); }
            else { for (int mrow = gw; mrow < MT; mrow += NGW) norm_row(X + (size_t)mrow * D, ap->in[IN_GFIN], nullptr, nullptr, out + (mrow < MP ? OUT_YP + (size_t)mrow * D : OUT_YS + (size_t)(mrow - MP) * D), lane); }
        }
    }
#undef RUN
#undef SEAM
}

#ifndef MK_SINGLE
#define MK_SINGLE 0
#endif
static bool phase_valid(int id) {
    if (id == 0) return true;
    const int L = (id - 1) / 16, sub = (id - 1) % 16, kind = L % 3;
    if (L > 3) return false;
    if (sub >= 8) return sub <= 11;
    return sub < (kind == 0 ? 4 : (kind == 1 ? 6 : 3));
}
extern "C" void kernel_launch(void* const* d_in, const int* in_sizes, int n_in, void* d_out, int out_size, void* d_ws, size_t ws_size, hipStream_t stream) {
    static int grid = 0;
    if (grid == 0) {
        if (n_in != N_IN || (size_t)out_size != OUT_TOTAL || ws_size < WS_END || in_sizes[IN_XP] != MP * D || in_sizes[IN_CAK] != 2 * NB * PAST * D) {
            fprintf(stderr, "kernel_launch: unexpected shapes: n_in %d out %d ws %zu (need %zu)\n", n_in, out_size, ws_size, (size_t)WS_END); grid = -1; return; }
        int dev = 0, cus = 0, per_cu = 0;
        if (hipGetDevice(&dev) != hipSuccess || hipDeviceGetAttribute(&cus, hipDeviceAttributeMultiprocessorCount, dev) != hipSuccess) { fprintf(stderr, "kernel_launch: device query failed\n"); grid = -1; return; }
        if (hipFuncSetAttribute((const void*)fwd_kernel, hipFuncAttributeMaxDynamicSharedMemorySize, LDS_BYTES) != hipSuccess) { fprintf(stderr, "kernel_launch: hipFuncSetAttribute failed\n"); grid = -1; return; }
        if (hipOccupancyMaxActiveBlocksPerMultiprocessor(&per_cu, (const void*)fwd_kernel, NWAVES * 64, LDS_BYTES) != hipSuccess || per_cu < 1)
            fprintf(stderr, "kernel_launch: note: occupancy query reports %d workgroups per CU\n", per_cu);
        (void)hipGetLastError();
        grid = cus;
    }
    if (grid < 0) return;
    if (hipMemsetAsync((char*)d_ws + WS_CTL, 0, CTL_ZERO_BYTES, stream) != hipSuccess) { fprintf(stderr, "kernel_launch: memset failed\n"); return; }
    Args a{};
    for (int i = 0; i < N_IN; ++i) a.in[i] = (const float*)d_in[i];
    a.out = (float*)d_out; a.ws = (unsigned char*)d_ws; a.pad = 0;
    for (int d = 0; d < 32; ++d) a.rope_inv[d] = (float)pow(10000.0, -(double)d / 32.0);
    a.lam_init[0] = (float)(0.8 - 0.6 * exp(-0.3 * 0.0)); a.lam_init[1] = (float)(0.8 - 0.6 * exp(-0.3 * 3.0));
    if (MK_SINGLE) {
        a.ph_lo = 0; a.ph_hi = 1 << 20; a.single = 1;
        hipLaunchKernelGGL(fwd_kernel, dim3(grid), dim3(NWAVES * 64), LDS_BYTES, stream, a);
    } else {
        for (int id = 0; id < 1 + 16 * 4; ++id) { if (!phase_valid(id)) continue;
            a.ph_lo = id; a.ph_hi = id + 1; a.single = 0;
            hipLaunchKernelGGL(fwd_kernel, dim3(grid), dim3(NWAVES * 64), LDS_BYTES, stream, a); }
    }
    const hipError_t le = hipPeekAtLastError();
    if (le != hipSuccess) fprintf(stderr, "kernel_launch: launch failed: %s\n", hipGetErrorName(le));
}
```

```cpp
#include <hip/hip_runtime.h>
#include <cstdio>
#include <cstdint>
#include <cmath>

constexpr int D = 1024, NB = 16, SEQ = 2048, MP = NB * SEQ  , DSEQ = 16, MS = NB * DSEQ  , MT = MP + MS  ;
constexpr int PAST = 4096, FF = 4096, CWIN = 512, NTAB = 257;
constexpr float EPS = 1e-6f;
constexpr float LOG2E = 1.4426950408889634f;
constexpr float QSCALE = 0.125f * LOG2E;

namespace pg8 {
#define PG8_LAS __attribute__((address_space(3)))
typedef unsigned short bf16_t;
typedef short bf16x8 __attribute__((ext_vector_type(8)));
typedef float f32x4 __attribute__((ext_vector_type(4)));
typedef float f32x2 __attribute__((ext_vector_type(2)));
typedef unsigned u32x4 __attribute__((ext_vector_type(4)));
typedef unsigned u32x2 __attribute__((ext_vector_type(2)));
constexpr int BM = 256, BK = 64, HALF = 128, HTB = HALF * BK * 2  , STAGE_BYTES = 8 * HTB, NXCD = 8, WGM = 8;

__host__ __device__ __forceinline__ int lds_byte(int r, int c) { const int st = (r >> 4) * 2 + (c >> 5), rr = r & 15, cc = c & 31, ob = rr * 64 + cc * 2; return st * 1024 + (ob ^ (((ob >> 9) & 1) << 5)); }
__host__ __device__ __forceinline__ void stage_rc(int b, int& R, int& C) { const int st = b / 1024, sb = b % 1024, swz = sb ^ (((sb >> 9) & 1) << 5); R = (st >> 1) * 16 + swz / 64; C = (st & 1) * 32 + (swz % 64) / 2; }
__host__ __device__ __forceinline__ int perm32(int rho) { const int n = rho >> 4, i = rho & 15; return 8 * (i >> 2) + 4 * n + (i & 3); }

struct Unit { int pm, pn, ui; };
struct Gemm { const bf16_t* A; const bf16_t* Bt; int M, N, K; int a_shift; size_t a_blk;
    __device__ __forceinline__ size_t a_off(int pn) const { return (size_t)(pn >> a_shift) * a_blk; } };

struct StaticOrder {
    int nM, nN, nwg, G, c;
    __host__ __device__ void init(int M, int N, int G_, int c_) { nM = M / BM; nN = N / BM; nwg = nM * nN; G = G_; c = c_; }
    __host__ __device__ bool next(int i, Unit& u) const {
        const long L = (long)i * G + c; if (L >= nwg) return false;
        int wgid = (int)L; { const int q = nwg / NXCD, r = nwg % NXCD, xcd = wgid % NXCD, off = wgid / NXCD; wgid = (xcd < r ? xcd * (q + 1) : r * (q + 1) + (xcd - r) * q) + off; }
        const int nig = WGM * nN, gid = wgid / nig, fm = gid * WGM, gsz = (nM - fm) < WGM ? (nM - fm) : WGM;
        u.pm = fm + ((wgid % nig) % gsz); u.pn = (wgid % nig) / gsz; return true;
    }
    __device__ __forceinline__ void a_ready(const Unit&) const {}
    __device__ __forceinline__ void done(const Unit&) const {}
};

__device__ __forceinline__ unsigned cvt_pk_bf16(float lo, float hi) { typedef __bf16 bf2 __attribute__((ext_vector_type(2))); f32x2 v = {lo, hi}; bf2 b = __builtin_convertvector(v, bf2); return __builtin_bit_cast(unsigned, b); }
__device__ __forceinline__ u32x4 pack8(const float (&x)[8]) { u32x4 w; w.x = cvt_pk_bf16(x[0], x[1]); w.y = cvt_pk_bf16(x[2], x[3]); w.z = cvt_pk_bf16(x[4], x[5]); w.w = cvt_pk_bf16(x[6], x[7]); return w; }
template <int X> __device__ __forceinline__ float swz_xor(float v) { return __builtin_bit_cast(float, __builtin_amdgcn_ds_swizzle(__builtin_bit_cast(int, v), (X << 10) | 0x1F)); }
__device__ __forceinline__ float xadd32(float v) { const unsigned u = __builtin_bit_cast(unsigned, v); auto r = __builtin_amdgcn_permlane32_swap(u, u, false, false); return __builtin_bit_cast(float, (unsigned)r[0]) + __builtin_bit_cast(float, (unsigned)r[1]); }
__device__ __forceinline__ float xmax32(float v) { const unsigned u = __builtin_bit_cast(unsigned, v); auto r = __builtin_amdgcn_permlane32_swap(u, u, false, false); return fmaxf(__builtin_bit_cast(float, (unsigned)r[0]), __builtin_bit_cast(float, (unsigned)r[1])); }
__device__ __forceinline__ float bf2f(unsigned short h) { return __builtin_bit_cast(float, (unsigned)h << 16); }

__device__ __forceinline__ float row_rstd(const float* SSQ, int row) {
    const f32x4* p = (const f32x4*)(SSQ + (size_t)row * 16); const f32x4 a = (p[0] + p[1]) + (p[2] + p[3]);
    return 1.0f / sqrtf(((a.x + a.y) + (a.z + a.w)) * (1.0f / 1024.0f) + EPS); }

__device__ __forceinline__ void rows_rstd(const float* SSQ, int row0, int fq, float (&rr)[2][4]) {
    f32x4 t[2][4];
#pragma unroll
    for (int ai = 0; ai < 2; ++ai)
#pragma unroll
        for (int m = 0; m < 4; ++m) t[ai][m] = *(const f32x4*)(SSQ + (size_t)(row0 + ai * HALF + m * 16) * 16 + 4 * fq);
#pragma unroll
    for (int ai = 0; ai < 2; ++ai)
#pragma unroll
        for (int m = 0; m < 4; ++m) { float s = (t[ai][m].x + t[ai][m].y) + (t[ai][m].z + t[ai][m].w); s += swz_xor<16>(s); s = xadd32(s); rr[ai][m] = 1.0f / sqrtf(s * (1.0f / 1024.0f) + EPS); }
}
__device__ __forceinline__ void rows_rstd_lds(const PG8_LAS float* RS, const Unit& u, int rowin  , float (&rr)[2][4]) {
#pragma unroll
    for (int ai = 0; ai < 2; ++ai)
#pragma unroll
        for (int m = 0; m < 4; ++m) rr[ai][m] = RS[u.ui * 256 + ai * HALF + m * 16 + rowin];
}
template <bool ROPE> struct EpiQKV {
    static constexpr bool PERM = true, AFTER_DRAIN = false;
    bf16_t* Q; size_t qkv_stride  ; const float *qg, *kg, *rope; float *okp, *oks; size_t kvp_stride, kvs_stride  ; int t0; const PG8_LAS float* RS;
    __device__ __forceinline__ float* f32_dst(int kind, int row, int colb) const {
        float* p = nullptr;
        if (row < MP) { const int t = row & (SEQ - 1), b = row >> 11; if (t >= t0) p = okp + (size_t)(kind - 1) * kvp_stride + ((size_t)(b * (SEQ - t0) + (t - t0))) * D + colb; }
        else p = oks + (size_t)(kind - 1) * kvs_stride + (size_t)(row - MP) * D + colb;
        return p; }
    __device__ __forceinline__ void operator()(const f32x4 (&acc)[2][2][4][2], const Unit& u, int wr, int wc, int fr, int fq) const {
        const int kind = u.pn >> 2, hc = (u.pn & 3) * 4 + wc, j0 = 8 * fq, colb = hc * 64 + j0;
        bf16_t* dst = Q + (size_t)kind * qkv_stride;
        float rrs[2][4]; rows_rstd_lds(RS, u, wr * 64 + fr, rrs);
        const int rowb = u.pm * BM + wr * 64 + fr;
        if (kind < 2) {
            const float* gp = kind == 0 ? qg : kg; const float qs = kind == 0 ? QSCALE : 1.0f;
            float g1[8], g2[8];
            { const f32x4 a = *(const f32x4*)(gp + j0), b = *(const f32x4*)(gp + j0 + 4), c = *(const f32x4*)(gp + 32 + j0), d = *(const f32x4*)(gp + 36 + j0);
#pragma unroll
              for (int i = 0; i < 4; ++i) { g1[i] = a[i] * qs; g1[4 + i] = b[i] * qs; g2[i] = c[i] * qs; g2[4 + i] = d[i] * qs; } }
            f32x4 rc[2][4];
            if (ROPE) { const int row = rowb; const int tpos = row < MP ? (row & (SEQ - 1)) : SEQ + ((row - MP) & (DSEQ - 1)); const float* rp = rope + (size_t)tpos * 64 + j0;
                rc[0][0] = *(const f32x4*)rp; rc[0][1] = *(const f32x4*)(rp + 4); rc[0][2] = *(const f32x4*)(rp + 32); rc[0][3] = *(const f32x4*)(rp + 36); }
#pragma unroll
            for (int rg = 0; rg < 8; ++rg) {
                const int ai = rg >> 2, m = rg & 3, row = rowb + ai * HALF + m * 16;
                if (ROPE && rg < 7) { const int rown = rowb + ((rg + 1) >> 2) * HALF + ((rg + 1) & 3) * 16; const int tpos = rown < MP ? (rown & (SEQ - 1)) : SEQ + ((rown - MP) & (DSEQ - 1));
                    const float* rp = rope + (size_t)tpos * 64 + j0; f32x4 (&rn)[4] = rc[(rg + 1) & 1];
                    rn[0] = *(const f32x4*)rp; rn[1] = *(const f32x4*)(rp + 4); rn[2] = *(const f32x4*)(rp + 32); rn[3] = *(const f32x4*)(rp + 36); }
                float x1[8], x2[8];
                { const float rr = rrs[ai][m];
#pragma unroll
                  for (int n = 0; n < 2; ++n)
#pragma unroll
                    for (int i = 0; i < 4; ++i) { x1[4 * n + i] = acc[ai][0][m][n][i] * rr; x2[4 * n + i] = acc[ai][1][m][n][i] * rr; } }
                float ss = 0.f;
#pragma unroll
                for (int i = 0; i < 8; ++i) ss += x1[i] * x1[i] + x2[i] * x2[i];
                ss += swz_xor<16>(ss); ss = xadd32(ss);
                const float rs = 1.0f / sqrtf(ss * (1.0f / 64.0f) + EPS);
#pragma unroll
                for (int i = 0; i < 8; ++i) { x1[i] *= rs * g1[i]; x2[i] *= rs * g2[i]; }
                if (ROPE) { const f32x4 (&r)[4] = rc[rg & 1];
#pragma unroll
                    for (int i = 0; i < 8; ++i) { const float c = i < 4 ? r[0][i & 3] : r[1][i & 3], sn = i < 4 ? r[2][i & 3] : r[3][i & 3];
                        const float a = x1[i], b = x2[i]; x1[i] = a * c - b * sn; x2[i] = b * c + a * sn; } }
                if (kind == 1) { float* p = f32_dst(1, row, colb);
                    if (p) { __builtin_nontemporal_store((f32x4){x1[0], x1[1], x1[2], x1[3]}, (f32x4*)p); __builtin_nontemporal_store((f32x4){x1[4], x1[5], x1[6], x1[7]}, (f32x4*)(p + 4));
                             __builtin_nontemporal_store((f32x4){x2[0], x2[1], x2[2], x2[3]}, (f32x4*)(p + 32)); __builtin_nontemporal_store((f32x4){x2[4], x2[5], x2[6], x2[7]}, (f32x4*)(p + 36)); } }
                bf16_t* o = dst + (size_t)row * D + colb;
                *(u32x4*)o = pack8(x1); *(u32x4*)(o + 32) = pack8(x2);
            }
        } else {
#pragma unroll
            for (int rg = 0; rg < 8; ++rg) {
                const int ai = rg >> 2, m = rg & 3, row = rowb + ai * HALF + m * 16;
                float x1[8], x2[8];
                { const float rr = rrs[ai][m];
#pragma unroll
                  for (int n = 0; n < 2; ++n)
#pragma unroll
                    for (int i = 0; i < 4; ++i) { x1[4 * n + i] = acc[ai][0][m][n][i] * rr; x2[4 * n + i] = acc[ai][1][m][n][i] * rr; } }
                float* p = f32_dst(2, row, colb);
                if (p) { __builtin_nontemporal_store((f32x4){x1[0], x1[1], x1[2], x1[3]}, (f32x4*)p); __builtin_nontemporal_store((f32x4){x1[4], x1[5], x1[6], x1[7]}, (f32x4*)(p + 4));
                         __builtin_nontemporal_store((f32x4){x2[0], x2[1], x2[2], x2[3]}, (f32x4*)(p + 32)); __builtin_nontemporal_store((f32x4){x2[4], x2[5], x2[6], x2[7]}, (f32x4*)(p + 36)); }
                bf16_t* o = dst + (size_t)row * D + colb;
                *(u32x4*)o = pack8(x1); *(u32x4*)(o + 32) = pack8(x2);
            }
        }
    }
};

struct EpiResAdd {
    static constexpr bool PERM = true, AFTER_DRAIN = false;
    bf16_t* Xb; const float* Xr32; float* X32out; float* SSQ;
    __device__ __forceinline__ void operator()(const f32x4 (&acc)[2][2][4][2], const Unit& u, int wr, int wc, int fr, int fq) const {
        const int col0 = u.pn * BM + wc * 32 + 8 * fq;
        const unsigned row0 = (unsigned)(u.pm * BM + wr * 64 + fr);
        float ssv[2][4];
#pragma unroll
        for (int ai = 0; ai < 2; ++ai)
#pragma unroll
        for (int mh = 0; mh < 4; mh += 2) {
            f32x4 xo[2][2][2];
            if (Xr32) {
#pragma unroll
                for (int k = 0; k < 2; ++k)
#pragma unroll
                    for (int bj = 0; bj < 2; ++bj)
#pragma unroll
                        for (int n = 0; n < 2; ++n) xo[k][bj][n] = *(const f32x4*)(Xr32 + ((row0 + (unsigned)(ai * HALF + (mh + k) * 16)) * (unsigned)D + (unsigned)(col0 + bj * HALF + 4 * n)));
            } else {
                u32x4 xb[2][2];
#pragma unroll
                for (int k = 0; k < 2; ++k)
#pragma unroll
                    for (int bj = 0; bj < 2; ++bj) xb[k][bj] = *(const u32x4*)(Xb + ((row0 + (unsigned)(ai * HALF + (mh + k) * 16)) * (unsigned)D + (unsigned)(col0 + bj * HALF)));
#pragma unroll
                for (int k = 0; k < 2; ++k)
#pragma unroll
                    for (int bj = 0; bj < 2; ++bj) { const u32x4 w = xb[k][bj];
                        xo[k][bj][0] = (f32x4){bf2f(w.x & 0xffff), bf2f(w.x >> 16), bf2f(w.y & 0xffff), bf2f(w.y >> 16)};
                        xo[k][bj][1] = (f32x4){bf2f(w.z & 0xffff), bf2f(w.z >> 16), bf2f(w.w & 0xffff), bf2f(w.w >> 16)}; }
            }
#pragma unroll
            for (int k = 0; k < 2; ++k) { const int m = mh + k; const unsigned ro = (row0 + (unsigned)(ai * HALF + m * 16)) * (unsigned)D + (unsigned)col0;
                float ss = 0.f;
#pragma unroll
                for (int bj = 0; bj < 2; ++bj) { const f32x4 v0 = xo[k][bj][0] + acc[ai][bj][m][0], v1 = xo[k][bj][1] + acc[ai][bj][m][1];
                    ss += ((v0.x * v0.x + v0.y * v0.y) + (v0.z * v0.z + v0.w * v0.w)) + ((v1.x * v1.x + v1.y * v1.y) + (v1.z * v1.z + v1.w * v1.w));
                    if (X32out) { *(f32x4*)(X32out + (ro + (unsigned)(bj * HALF))) = v0; *(f32x4*)(X32out + (ro + (unsigned)(bj * HALF + 4))) = v1; }
                    else { u32x4 w; w.x = cvt_pk_bf16(v0.x, v0.y); w.y = cvt_pk_bf16(v0.z, v0.w); w.z = cvt_pk_bf16(v1.x, v1.y); w.w = cvt_pk_bf16(v1.z, v1.w);
                        *(u32x4*)(Xb + (ro + (unsigned)(bj * HALF))) = w; } }
                ssv[ai][m] = ss; }
        }
        if (!X32out) {
#pragma unroll
            for (int ai = 0; ai < 2; ++ai)
#pragma unroll
                for (int m = 0; m < 4; ++m) { float ss = ssv[ai][m]; ss += swz_xor<16>(ss); ss = xadd32(ss); if (fq == 0) SSQ[(size_t)(row0 + (unsigned)(ai * HALF + m * 16)) * 16 + u.pn * 4 + wc] = ss; } }
    }
};

struct EpiRelu2 {
    static constexpr bool PERM = true, AFTER_DRAIN = false;
    bf16_t* O; int ldc; const PG8_LAS float* RS;
    __device__ __forceinline__ void operator()(const f32x4 (&acc)[2][2][4][2], const Unit& u, int wr, int wc, int fr, int fq) const {
        const int col0 = u.pn * BM + wc * 32 + 8 * fq;
        float rrs[2][4]; rows_rstd_lds(RS, u, wr * 64 + fr, rrs);
#pragma unroll
        for (int ai = 0; ai < 2; ++ai)
#pragma unroll
            for (int m = 0; m < 4; ++m) { const int row = u.pm * BM + ai * HALF + wr * 64 + m * 16 + fr; bf16_t* rowp = O + (size_t)row * ldc + col0; const float rr = rrs[ai][m];
#pragma unroll
                for (int bj = 0; bj < 2; ++bj) { float x[8];
#pragma unroll
                    for (int n = 0; n < 2; ++n)
#pragma unroll
                        for (int i = 0; i < 4; ++i) { const float v = fmaxf(acc[ai][bj][m][n][i] * rr, 0.f); x[4 * n + i] = v * v; }
                    *(u32x4*)(rowp + bj * HALF) = pack8(x); } }
    }
};

__device__ __forceinline__ float gelu_tanh(float x) {
    const float y = 0.7978845608028654f * (x + 0.044715f * x * x * x);
    const float e = __expf(2.0f * y);
    const float th = 1.0f - 2.0f / (1.0f + e);
    return 0.5f * x * (1.0f + th);
}
struct EpiBin {
    static constexpr bool PERM = true, AFTER_DRAIN = false;
    bf16_t *G, *U; const float* bias; float *ocp, *ocs; const PG8_LAS float* RS;
    __device__ __forceinline__ void operator()(const f32x4 (&acc)[2][2][4][2], const Unit& u, int wr, int wc, int fr, int fq) const {
        const int col0 = u.pn * BM + wc * 32 + 8 * fq; const bool isu = u.pn >= 4;
        float bv[2][8];
#pragma unroll
        for (int bj = 0; bj < 2; ++bj)
#pragma unroll
            for (int i = 0; i < 8; ++i) bv[bj][i] = bias[col0 + bj * HALF + i];
        float rrs[2][4]; rows_rstd_lds(RS, u, wr * 64 + fr, rrs);
#pragma unroll
        for (int ai = 0; ai < 2; ++ai)
#pragma unroll
            for (int m = 0; m < 4; ++m) { const int row = u.pm * BM + ai * HALF + wr * 64 + m * 16 + fr; const float rr = rrs[ai][m];
#pragma unroll
                for (int bj = 0; bj < 2; ++bj) { float x[8];
#pragma unroll
                    for (int n = 0; n < 2; ++n)
#pragma unroll
                        for (int i = 0; i < 4; ++i) x[4 * n + i] = acc[ai][bj][m][n][i] * rr + bv[bj][4 * n + i];
                    if (!isu) {
#pragma unroll
                        for (int i = 0; i < 8; ++i) x[i] = gelu_tanh(x[i]);
                        *(u32x4*)(G + (size_t)row * D + col0 + bj * HALF) = pack8(x);
                    } else {
                        const int uc = col0 + bj * HALF - D;
                        *(u32x4*)(U + (size_t)row * D + uc) = pack8(x);
                        float* p = nullptr;
                        if (row < MP) { const int t = row & (SEQ - 1), b = row >> 11; if (t >= SEQ - 3) p = ocp + (size_t)(b * 3 + (t - (SEQ - 3))) * D + uc; }
                        else { const int s = row - MP, t = s & (DSEQ - 1), b = s >> 4; if (t >= DSEQ - 3) p = ocs + (size_t)(b * 3 + (t - (DSEQ - 3))) * D + uc; }
                        if (p) { *(f32x4*)p = (f32x4){x[0], x[1], x[2], x[3]}; *(f32x4*)(p + 4) = (f32x4){x[4], x[5], x[6], x[7]}; }
                    } } }
    }
};

struct EpiGates {
    static constexpr bool PERM = true, AFTER_DRAIN = false;
    const bf16_t* XCB; const float *gab, *gxb, *sp8  ; bf16_t *AA, *BB;
    __device__ __forceinline__ void operator()(const f32x4 (&acc)[2][2][4][2], const Unit& u, int wr, int wc, int fr, int fq) const {
        const int nb = u.pn >> 1, cin = 128 * (u.pn & 1) + wc * 32 + 8 * fq, ch0 = 256 * nb + cin;
        const unsigned row0 = (unsigned)(u.pm * BM + wr * 64 + fr);
        const unsigned xoff0 = ((unsigned)nb * MT + row0) * 256u + (unsigned)cin, ooff0 = row0 * (unsigned)D + (unsigned)ch0;
        u32x4 xw[2][4];
#pragma unroll
        for (int ai = 0; ai < 2; ++ai)
#pragma unroll
            for (int m = 0; m < 4; ++m) xw[ai][m] = *(const u32x4*)(XCB + (xoff0 + (unsigned)(ai * HALF + m * 16) * 256u));
#pragma unroll
        for (int n = 0; n < 2; ++n) {
            const f32x4 ba = *(const f32x4*)(gab + ch0 + 4 * n), bx = *(const f32x4*)(gxb + ch0 + 4 * n), sp = *(const f32x4*)(sp8 + ch0 + 4 * n);
#pragma unroll
            for (int ai = 0; ai < 2; ++ai)
#pragma unroll
                for (int m = 0; m < 4; ++m) {
                    const unsigned dr = (unsigned)(ai * HALF + m * 16);
                    f32x4 a, b;
#pragma unroll
                    for (int i = 0; i < 4; ++i) {
                        const unsigned w = xw[ai][m][2 * n + (i >> 1)];
                        const float xc = bf2f((unsigned short)((i & 1) ? (w >> 16) : (w & 0xffffu)));
                        const float r = __builtin_amdgcn_rcpf(1.0f + __expf(-(acc[ai][0][m][n][i] + ba[i])));
                        const float ig = __builtin_amdgcn_rcpf(1.0f + __expf(-(acc[ai][1][m][n][i] + bx[i])));
                        const float la = -r * sp[i], t2 = 2.0f * la;
                        a[i] = la;
                        const float poly = -t2 * (1.0f + t2 * (0.5f + t2 * (0.16666667f + t2 * (0.041666668f + t2 * (0.0083333338f + t2 * 0.0013888889f)))));
                        const float em = t2 > -0.25f ? poly : 1.0f - __expf(t2);
                        b[i] = __builtin_amdgcn_sqrtf(em) * (ig * xc); }
                    { u32x2 wa, wb; wa.x = cvt_pk_bf16(a[0], a[1]); wa.y = cvt_pk_bf16(a[2], a[3]); wb.x = cvt_pk_bf16(b[0], b[1]); wb.y = cvt_pk_bf16(b[2], b[3]);
                      *(u32x2*)(AA + (ooff0 + dr * (unsigned)D + 4u * n)) = wa; *(u32x2*)(BB + (ooff0 + dr * (unsigned)D + 4u * n)) = wb; }
                }
        }
    }
};

template <class Epi, class Sched, bool ALIGN_EPI = false, bool SP2 = false>
__device__ __forceinline__ void gemm_phase(PG8_LAS unsigned char* lds, const Gemm g, const Sched& S, const Epi& E, const int tid_in) {
    const int tid = tid_in; const int wid = __builtin_amdgcn_readfirstlane(tid >> 6), lane = tid & 63, wr = wid >> 2, wc = wid & 3, fr = lane & 15, fq = lane >> 4;
    int K = g.K; asm volatile("" : "+s"(K)); const int nt = K / BK;
    unsigned voffA[2], voffB[2];
#pragma unroll
    for (int i = 0; i < 2; ++i) { int R, C; stage_rc(tid * 16 + i * 8192, R, C); const int Rb = Epi::PERM ? ((R & ~31) + perm32(R & 31)) : R;
        voffA[i] = (unsigned)(R * K + C) * 2u; voffB[i] = (unsigned)(Rb * K + C) * 2u; }
    const size_t kstep = (size_t)(BK * 2);
    const size_t hstep = (size_t)HALF * K * 2;
    const size_t tstep = 2 * hstep;
    const unsigned ldsw = (unsigned)wid * 1024u;
    const int aoff = lds_byte(wr * 64 + fr, fq * 8), boff = lds_byte(wc * 32 + fr, fq * 8);
#define PG8_SA(b, h) (((b) * 2 + (h)) * HTB)
#define PG8_SB(b, h) ((4 + (b) * 2 + (h)) * HTB)
#define PG8_STAGE(bufoff, gbase, voff) do { _Pragma("unroll") for (int _i = 0; _i < 2; ++_i) \
        __builtin_amdgcn_global_load_lds((const unsigned*)((const char*)(gbase) + (voff)[_i]), (PG8_LAS unsigned*)(lds + (bufoff) + ldsw + _i * 8192), 16, 0, 0); } while (0)
#define PG8_LDA(dst, b, h) do { _Pragma("unroll") for (int m = 0; m < 4; ++m) _Pragma("unroll") for (int k = 0; k < 2; ++k) dst[m][k] = *(const PG8_LAS bf16x8*)(lds + PG8_SA(b, h) + aoff + m * 2048 + k * 1024); } while (0)
#define PG8_LDB(dst, b, h) do { _Pragma("unroll") for (int n = 0; n < 2; ++n) _Pragma("unroll") for (int k = 0; k < 2; ++k) dst[n][k] = *(const PG8_LAS bf16x8*)(lds + PG8_SB(b, h) + boff + n * 2048 + k * 1024); } while (0)
#define PG8_MMA(ai, bj, At, Bt) do { __builtin_amdgcn_s_setprio(1); _Pragma("unroll") for (int m = 0; m < 4; ++m) _Pragma("unroll") for (int n = 0; n < 2; ++n) _Pragma("unroll") for (int k = 0; k < 2; ++k) \
        acc[ai][bj][m][n] = __builtin_amdgcn_mfma_f32_16x16x32_bf16(Bt[n][k], At[m][k], acc[ai][bj][m][n], 0, 0, 0); __builtin_amdgcn_s_setprio(0); } while (0)
#define PG8_WAIT_V(n) asm volatile("s_waitcnt vmcnt(" #n ")" ::: "memory")
#define PG8_WAIT_L(n) asm volatile("s_waitcnt lgkmcnt(" #n ")" ::: "memory")
#define PG8_BAR __builtin_amdgcn_s_barrier()
#define PG8_SCHED __builtin_amdgcn_sched_barrier(0)
    Unit cur, nxt; int ui = 0;
    if (!S.next(0, cur)) return;
    cur.ui = 0;
    f32x4 acc[2][2][4][2];
#pragma unroll
    for (int a = 0; a < 2; ++a)
#pragma unroll
        for (int b = 0; b < 2; ++b)
#pragma unroll
            for (int m = 0; m < 4; ++m)
#pragma unroll
                for (int n = 0; n < 2; ++n) acc[a][b][m][n] = (f32x4){0.f, 0.f, 0.f, 0.f};
    bf16x8 At[4][2], B0[2][2], B1[2][2];
    const char* cA = (const char*)g.A + (size_t)cur.pm * tstep + g.a_off(cur.pn); const char* cB = (const char*)g.Bt + (size_t)cur.pn * tstep;
    S.a_ready(cur);
    if constexpr (SP2) {
        PG8_STAGE(PG8_SB(0, 0), cB, voffB); PG8_STAGE(PG8_SB(0, 1), cB + hstep, voffB); PG8_STAGE(PG8_SA(0, 0), cA, voffA); PG8_STAGE(PG8_SA(0, 1), cA + hstep, voffA);
        if (wr == 1) PG8_BAR;
        PG8_WAIT_V(2); PG8_BAR;
        PG8_STAGE(PG8_SB(1, 0), cB + kstep, voffB); PG8_STAGE(PG8_SA(1, 0), cA + kstep, voffA); PG8_STAGE(PG8_SB(1, 1), cB + hstep + kstep, voffB);
        PG8_WAIT_V(6); PG8_BAR;
    } else {
        PG8_STAGE(PG8_SB(0, 0), cB, voffB); PG8_STAGE(PG8_SA(0, 0), cA, voffA); PG8_STAGE(PG8_SB(0, 1), cB + hstep, voffB); PG8_STAGE(PG8_SA(0, 1), cA + hstep, voffA);
        if (wr == 1) PG8_BAR;
        PG8_WAIT_V(4); PG8_BAR;
        PG8_STAGE(PG8_SB(1, 0), cB + kstep, voffB); PG8_STAGE(PG8_SA(1, 0), cA + kstep, voffA); PG8_STAGE(PG8_SB(1, 1), cB + hstep + kstep, voffB);
        PG8_WAIT_V(6); PG8_BAR;
    }
    for (;;) {
        const bool has_next = S.next(ui + 1, nxt); nxt.ui = ui + 1;
        const char* nA = has_next ? (const char*)g.A + (size_t)nxt.pm * tstep + g.a_off(nxt.pn) : cA; const char* nB = has_next ? (const char*)g.Bt + (size_t)nxt.pn * tstep : cB;
        for (int t = 0; t < nt; t += 2) {
            const bool last = (t == nt - 2);
            const char* a1 = cA + (size_t)(t + 1) * kstep;
            const char* a2 = last ? nA : cA + (size_t)(t + 2) * kstep; const char* b2 = last ? nB : cB + (size_t)(t + 2) * kstep;
            const char* a3 = a2 + kstep; const char* b3 = b2 + kstep;
            if (last && has_next) S.a_ready(nxt);
            if constexpr (SP2) {
            PG8_LDB(B0, 0, 0); PG8_LDB(B1, 0, 1); PG8_SCHED; PG8_LDA(At, 0, 0); PG8_STAGE(PG8_SA(1, 1), a1 + hstep, voffA);
            PG8_WAIT_V(8); PG8_WAIT_L(0); PG8_BAR; PG8_MMA(0, 0, At, B0); PG8_MMA(0, 1, At, B1); PG8_BAR; PG8_SCHED;
            PG8_LDA(At, 0, 1); PG8_STAGE(PG8_SB(0, 0), b2, voffB); PG8_STAGE(PG8_SB(0, 1), b2 + hstep, voffB); PG8_STAGE(PG8_SA(0, 0), a2, voffA);
            PG8_WAIT_V(8); PG8_WAIT_L(0); PG8_BAR; PG8_MMA(1, 0, At, B0); PG8_MMA(1, 1, At, B1); PG8_BAR; PG8_SCHED;
            PG8_LDB(B0, 1, 0); PG8_LDB(B1, 1, 1); PG8_SCHED; PG8_LDA(At, 1, 0); PG8_STAGE(PG8_SA(0, 1), a2 + hstep, voffA);
            PG8_WAIT_V(8); PG8_WAIT_L(0); PG8_BAR; PG8_MMA(0, 0, At, B0); PG8_MMA(0, 1, At, B1); PG8_BAR; PG8_SCHED;
            PG8_LDA(At, 1, 1); PG8_STAGE(PG8_SB(1, 0), b3, voffB); PG8_STAGE(PG8_SB(1, 1), b3 + hstep, voffB); PG8_STAGE(PG8_SA(1, 0), a3, voffA);
            PG8_WAIT_V(8); PG8_WAIT_L(0); PG8_BAR; PG8_MMA(1, 0, At, B0); PG8_MMA(1, 1, At, B1); PG8_BAR; PG8_SCHED;
            } else {
            PG8_LDB(B0, 0, 0); PG8_SCHED; PG8_LDA(At, 0, 0); PG8_STAGE(PG8_SA(1, 1), a1 + hstep, voffA);
            PG8_WAIT_L(8); PG8_BAR; PG8_WAIT_L(0); PG8_MMA(0, 0, At, B0); PG8_BAR; PG8_SCHED;
            PG8_LDB(B1, 0, 1); PG8_STAGE(PG8_SB(0, 0), b2, voffB);
            PG8_BAR; PG8_WAIT_L(0); PG8_MMA(0, 1, At, B1); PG8_BAR;
            PG8_LDA(At, 0, 1); PG8_STAGE(PG8_SA(0, 0), a2, voffA);
            PG8_BAR; PG8_WAIT_L(0); PG8_MMA(1, 0, At, B0); PG8_BAR; PG8_SCHED;
            PG8_STAGE(PG8_SB(0, 1), b2 + hstep, voffB);
            PG8_WAIT_V(6); PG8_BAR; PG8_MMA(1, 1, At, B1); PG8_BAR;
            PG8_LDB(B0, 1, 0); PG8_SCHED; PG8_LDA(At, 1, 0); PG8_STAGE(PG8_SA(0, 1), a2 + hstep, voffA);
            PG8_WAIT_L(8); PG8_BAR; PG8_WAIT_L(0); PG8_MMA(0, 0, At, B0); PG8_BAR; PG8_SCHED;
            PG8_LDB(B1, 1, 1); PG8_STAGE(PG8_SB(1, 0), b3, voffB);
            PG8_BAR; PG8_WAIT_L(0); PG8_MMA(0, 1, At, B1); PG8_BAR;
            PG8_LDA(At, 1, 1); PG8_STAGE(PG8_SA(1, 0), a3, voffA);
            PG8_BAR; PG8_WAIT_L(0); PG8_MMA(1, 0, At, B0); PG8_BAR; PG8_SCHED;
            PG8_STAGE(PG8_SB(1, 1), b3 + hstep, voffB);
            PG8_WAIT_V(6); PG8_BAR; PG8_MMA(1, 1, At, B1); PG8_BAR;
            }
        }
        if constexpr (ALIGN_EPI) { if (wr == 0) PG8_BAR; }
        if constexpr (!Epi::AFTER_DRAIN) { E(acc, cur, wr, wc, fr, fq); S.done(cur); }
        if (!has_next) break;
#pragma unroll
        for (int a = 0; a < 2; ++a)
#pragma unroll
            for (int b = 0; b < 2; ++b)
#pragma unroll
                for (int m = 0; m < 4; ++m)
#pragma unroll
                    for (int n = 0; n < 2; ++n) acc[a][b][m][n] = (f32x4){0.f, 0.f, 0.f, 0.f};
        cur = nxt; cA = nA; cB = nB; ++ui;
        if constexpr (ALIGN_EPI) { if (wr == 1) PG8_BAR; }
    }
    PG8_WAIT_V(0);
    if constexpr (!ALIGN_EPI) { if (wr == 0) PG8_BAR; }
    PG8_BAR;
    if constexpr (Epi::AFTER_DRAIN) { E.fused(acc, cur, wr, wc, fr, fq, lds, wid, lane); S.done(cur); }
#undef PG8_SA
#undef PG8_SB
#undef PG8_STAGE
#undef PG8_LDA
#undef PG8_LDB
#undef PG8_MMA
#undef PG8_WAIT_V
#undef PG8_WAIT_L
#undef PG8_BAR
#undef PG8_SCHED
}
}

#ifndef PROBE_DUP
#define PROBE_DUP 0
#endif
#include <hip/hip_bf16.h>
#include <cmath>
namespace attn_body {
using bf16=__hip_bfloat16;
using bf16x8=__attribute__((ext_vector_type(8)))short;
using s16x4=__attribute__((ext_vector_type(4)))short;
using f32x16=__attribute__((ext_vector_type(16)))float;
using u32x4=__attribute__((ext_vector_type(4)))unsigned;
constexpr int BATCH=16,NHEAD=16,SEQ=2048,D=64,DM=NHEAD*D;
constexpr int NW=8,QBLK=32,QB=QBLK*NW,KVBLK=64,NQB=SEQ/QB;
constexpr int ATTN_PITCH=DM, ATTN_UNIT_ROWS=QB;
__device__ __forceinline__ int crow(int r,int hi){return (r&3)+8*(r>>2)+4*hi;}
#define SBAR() __builtin_amdgcn_sched_barrier(0)
__device__ __forceinline__ void cmask(f32x16&p0,f32x16&p1,int jb,int qrel,int hi){
  const float NEG=-INFINITY; int kb=64*jb+4*hi;
  #pragma unroll
  for(int r=0;r<16;++r){int kv=kb+(r&3)+8*(r>>2); if(kv>qrel)p0[r]=NEG; if(kv+32>qrel)p1[r]=NEG;}
}

constexpr int NSLOT=3, SLOTB=8192;
constexpr int LDS_K=0, LDS_V=NSLOT*SLOTB, LDS_V2=2*NSLOT*SLOTB  , LDS_WS=3*NSLOT*SLOTB, LDS_OST=LDS_WS+NW*64*4, LDS_BYTES=LDS_OST+NW*4096;
constexpr float C2=0.125f*1.4426950408889634f;
__device__ __forceinline__ void glds16(const void*gsrc,unsigned lds_dst){unsigned keep;
  asm volatile("s_mov_b32 %0, m0\n\ts_mov_b32 m0, %2\n\ts_nop 0\n\tglobal_load_lds_dwordx4 %1, off\n\ts_mov_b32 m0, %0":"=&s"(keep):"v"(gsrc),"s"(lds_dst):"memory");}
__device__ __forceinline__ float max3f(float a,float b,float c){float r;asm("v_max3_f32 %0, %1, %2, %3":"=v"(r):"v"(a),"v"(b),"v"(c));return r;}
__device__ __forceinline__ float max2f(float a,float b){float r;asm("v_max_f32_e32 %0, %1, %2":"=v"(r):"v"(a),"v"(b));return r;}
__device__ __forceinline__ float fadd_s(float a,float b){float r;asm("v_add_f32_e32 %0, %1, %2":"=v"(r):"v"(a),"v"(b));return r;}
__device__ __forceinline__ float fsub_s(float a,float b){float r;asm("v_sub_f32_e32 %0, %1, %2":"=v"(r):"v"(a),"v"(b));return r;}
typedef float f32x2_t __attribute__((ext_vector_type(2))); typedef __bf16 bf16x2_t __attribute__((ext_vector_type(2)));
__device__ __forceinline__ unsigned cvtpk_s(float lo,float hi){f32x2_t v={lo,hi};bf16x2_t b=__builtin_convertvector(v,bf16x2_t);return __builtin_bit_cast(unsigned,b);}
#define WAIT_BAR(N) asm volatile("s_waitcnt vmcnt(" #N ") lgkmcnt(0)\n\ts_barrier":::"memory")

__device__ __forceinline__ void qkt(f32x16&p0,f32x16&p1,const char*Kslot,const bf16x8*qr,const f32x16&negm,int r32,int hi){
  const char*kb=Kslot+hi*1024+r32*16;
  #pragma unroll
  for(int d0=0;d0<4;++d0){
    const bf16x8 b0=*reinterpret_cast<const bf16x8*>(kb+d0*2048);
    const bf16x8 b1=*reinterpret_cast<const bf16x8*>(kb+d0*2048+512);
    if(d0==0){p0=__builtin_amdgcn_mfma_f32_32x32x16_bf16(b0,qr[0],negm,0,0,0);p1=__builtin_amdgcn_mfma_f32_32x32x16_bf16(b1,qr[0],negm,0,0,0);}
    else{p0=__builtin_amdgcn_mfma_f32_32x32x16_bf16(b0,qr[d0],p0,0,0,0);p1=__builtin_amdgcn_mfma_f32_32x32x16_bf16(b1,qr[d0],p1,0,0,0);}}
}
typedef __attribute__((address_space(3))) const char* lds_cptr;
typedef short v4i16_t __attribute__((ext_vector_type(4)));
__device__ __forceinline__ void kload8(bf16x8*kf,lds_cptr kp){
  kf[0]=*(const __attribute__((address_space(3))) bf16x8*)(kp);      kf[1]=*(const __attribute__((address_space(3))) bf16x8*)(kp+512);
  kf[2]=*(const __attribute__((address_space(3))) bf16x8*)(kp+2048); kf[3]=*(const __attribute__((address_space(3))) bf16x8*)(kp+2560);
  kf[4]=*(const __attribute__((address_space(3))) bf16x8*)(kp+4096); kf[5]=*(const __attribute__((address_space(3))) bf16x8*)(kp+4608);
  kf[6]=*(const __attribute__((address_space(3))) bf16x8*)(kp+6144); kf[7]=*(const __attribute__((address_space(3))) bf16x8*)(kp+6656);
}
__device__ __forceinline__ void kload2(bf16x8*kf,lds_cptr kp,int j){ kf[2*j]=*(const __attribute__((address_space(3))) bf16x8*)(kp+j*2048); kf[2*j+1]=*(const __attribute__((address_space(3))) bf16x8*)(kp+j*2048+512); }
__device__ __forceinline__ s16x4 vtr(lds_cptr p){ return __builtin_bit_cast(s16x4,__builtin_amdgcn_ds_read_tr16_b64_v4i16((__attribute__((address_space(3))) v4i16_t*)p)); }
__device__ __forceinline__ float rowmax(const f32x16&p0,const f32x16&p1){
  float a=max3f(p0[0],p0[1],p1[0]),b=max3f(p0[2],p0[3],p1[1]);a=max3f(a,p1[2],p1[3]);
  #pragma unroll
  for(int r=4;r<16;r+=4){a=max3f(a,p0[r],p0[r+1]);b=max3f(b,p0[r+2],p0[r+3]);a=max3f(a,p1[r],p1[r+1]);b=max3f(b,p1[r+2],p1[r+3]);}
  const float m=max2f(a,b);
  auto rr=__builtin_amdgcn_permlane32_swap(__float_as_uint(m),__float_as_uint(m),false,false);
  return max2f(__uint_as_float(rr[0]),__uint_as_float(rr[1]));
}
__device__ __forceinline__ void pv(f32x16*o,int vb,bf16x8 pa0,bf16x8 pa1,bf16x8 pa2,bf16x8 pa3){
  #pragma unroll
  for(int d0=0;d0<2;++d0){s16x4 lo[4],hi[4];
    #pragma unroll
    for(int ks=0;ks<4;++ks){
      asm volatile("ds_read_b64_tr_b16 %0,%1 offset:%c2":"=&v"(lo[ks]):"v"(vb),"i"(d0*4096+ks*1024):"memory");
      asm volatile("ds_read_b64_tr_b16 %0,%1 offset:%c2":"=&v"(hi[ks]):"v"(vb),"i"(d0*4096+ks*1024+512):"memory");}
    asm volatile("s_waitcnt lgkmcnt(0)":::"memory");SBAR();
    #define PK(k) (bf16x8){lo[k][0],lo[k][1],lo[k][2],lo[k][3],hi[k][0],hi[k][1],hi[k][2],hi[k][3]}
    o[d0]=__builtin_amdgcn_mfma_f32_32x32x16_bf16(pa0,PK(0),o[d0],0,0,0);
    o[d0]=__builtin_amdgcn_mfma_f32_32x32x16_bf16(pa1,PK(1),o[d0],0,0,0);
    o[d0]=__builtin_amdgcn_mfma_f32_32x32x16_bf16(pa2,PK(2),o[d0],0,0,0);
    o[d0]=__builtin_amdgcn_mfma_f32_32x32x16_bf16(pa3,PK(3),o[d0],0,0,0);
    #undef PK
  }
}

#ifndef ATTN_STORE16
#define ATTN_STORE16(p,v) (*(u32x4*)(p)=(v))
#endif
__device__ __forceinline__ void band_fix(f32x16&p0,f32x16&p1,int ct,int wid,int r32,int hi,const __attribute__((address_space(3))) float*tbl,float mhat){
  const int dist=(wid>>1)-ct;
  if(dist<0||dist>8){
    #pragma unroll
    for(int r=0;r<16;++r){p0[r]=-INFINITY;p1[r]=-INFINITY;}
  } else if(dist<=2){
    const int A=64*dist+32*(wid&1)+r32-4*hi+128;
    #pragma unroll
    for(int r=0;r<16;++r){ const int kc=(r&3)+8*(r>>2); int i0=A-kc,i1=A-32-kc; i0=i0<0?0:(i0>256?256:i0); i1=i1<0?0:(i1>256?256:i1); p0[r]+=tbl[i0]-mhat; p1[r]+=tbl[i1]-mhat; }
  } else {
    #pragma unroll
    for(int r=0;r<16;++r){p0[r]-=mhat;p1[r]-=mhat;}
  }
}
template<int BAND> __device__ __forceinline__ f32x16 cinit(const f32x16&negm){ if constexpr(BAND!=0){ return f32x16{}; } else { return negm; } }
template<int THRL,int QOR,int OPITCH,int BAND,int DV2> __device__ __forceinline__ void attn_unit(int b,int hq,int hv,int ho,int qb,const bf16*Q,const bf16*__restrict__ K,const bf16*__restrict__ V,bf16*O,char*shm,int tid_in,const __attribute__((address_space(3))) float*tbl){
  const int tid=tid_in,lane=tid&63,r32=lane&31,hi=lane>>5; const int wid=__builtin_amdgcn_readfirstlane(tid>>6);
  const long rowbase=(long)b*SEQ; const int q0=qb*QB;
  const int t_lo=BAND?(qb>=2?4*qb-8:0):0; const int NT=BAND?(4*qb+4-t_lo):(q0+QB)/KVBLK; const int rot=BAND?NT-4:0;
  #define TMAP(s) (BAND?(((s)+rot>=NT)?(s)+rot-NT:(s)+rot):(s))
  const bf16*Qw=Q+(rowbase+q0+wid*QBLK)*DM+hq*D;
  const bf16*Kh=K+(rowbase+(long)t_lo*KVBLK)*DM+hq*D,*Vh=V+(rowbase+(long)t_lo*KVBLK)*DM+hv*D;
  const unsigned lds0=(unsigned)(uintptr_t)shm;
  float*wsf=(float*)(shm+LDS_WS)+wid*64;
  const bf16*ksrc=Kh+(long)lane*DM+wid*8;
  const bf16*vsrc=Vh+(long)(16*(wid&3)+(lane>>2))*DM+(wid>>2)*32+(lane&3)*8;
  const unsigned kdst=lds0+LDS_K+wid*1024, vdst=lds0+LDS_V+wid*1024, vdst2=lds0+LDS_V2+wid*1024;
  #define DMA_K(t,slot) glds16(ksrc+(long)TMAP(t)*KVBLK*DM,(unsigned)__builtin_amdgcn_readfirstlane(kdst+(slot)))
  #define DMA_V(t,slot) do{ glds16(vsrc+(long)TMAP(t)*KVBLK*DM,(unsigned)__builtin_amdgcn_readfirstlane(vdst+(slot))); if constexpr(DV2!=0){ glds16(vsrc+64+(long)TMAP(t)*KVBLK*DM,(unsigned)__builtin_amdgcn_readfirstlane(vdst2+(slot))); } }while(0)
  const int vb0=(int)(lds0+LDS_V)+((lane>>4)&1)*32+(lane&3)*8+(4*hi+((lane&15)>>2))*64;
  const char*Kbase=shm+LDS_K; bf16x8 kf[8];
  const lds_cptr shm3=(lds_cptr)shm; const lds_cptr kp0=shm3+LDS_K+hi*1024+r32*16; const lds_cptr vp0=shm3+LDS_V+((lane>>4)&1)*32+(lane&3)*8+(4*hi+((lane&15)>>2))*64;
  DMA_K(0,0);DMA_V(0,0);DMA_K(1,SLOTB);
  bf16x8 qr[4];
  #pragma unroll
  for(int d0=0;d0<4;++d0)qr[d0]=*reinterpret_cast<const bf16x8*>(&Qw[(long)r32*DM+d0*16+hi*8]);
  float zz_=0.f;asm volatile("":"+v"(zz_));
  float mhat=0.f,l_reg=0.f;f32x16 o[2];f32x16 o2[2];f32x16 negm;
  _Pragma("unroll") for(int r=0;r<16;++r){o[0][r]=zz_;o[1][r]=zz_;o2[0][r]=zz_;o2[1][r]=zz_;negm[r]=zz_;} if constexpr(BAND==0&&DV2==0){ asm volatile("":"+v"(negm)); }
  const int qrel=(wid*QBLK+r32)|QOR;
  #define CMASK(P0,P1,t) do{ if constexpr(BAND!=0){ band_fix(P0,P1,TMAP(t)-(NT-4),wid,r32,hi,tbl,mhat); } else { if constexpr(DV2!=0){ if(__any(mhat!=0.f)){ _Pragma("unroll") for(int r_=0;r_<16;++r_){P0[r_]-=mhat;P1[r_]-=mhat;} } } int jb_=(t)-(NT-4); if(jb_>=0)cmask(P0,P1,jb_,qrel,hi);} }while(0)
  bool resc=false;
  #define START(P0,P1) do{ const float rm=rowmax(P0,P1); resc=false; \
    if(DV2==0 || __any(__builtin_fabsf(rm)>(float)THRL)) { const float dl=rm; mhat=fadd_s(mhat,dl);     \
      _Pragma("unroll") for(int r=0;r<16;++r){P0[r]=fsub_s(P0[r],dl);P1[r]=fsub_s(P1[r],dl);} \
      if constexpr(BAND==0&&DV2==0){ _Pragma("unroll") for(int r=0;r<16;++r)negm[r]=-mhat; asm volatile("":"+v"(negm)); } } \
    _Pragma("unroll") for(int r=0;r<16;++r)P0[r]=__builtin_amdgcn_exp2f(P0[r]); }while(0)
  #define RESC() do{ if(resc){ asm volatile("s_waitcnt lgkmcnt(0)":::"memory"); \
      _Pragma("unroll") for(int d_=0;d_<2;++d_) _Pragma("unroll") for(int r=0;r<16;++r){ const float f_=wsf[crow(r,hi)]; o[d_][r]*=f_; if constexpr(DV2!=0){ o2[d_][r]*=f_; } } } }while(0)
  f32x16 pA0,pA1,pB0,pB1;
  int sl_prev=0,sl_cur=0,sl_next=SLOTB;
  #define ROT() do{sl_prev=sl_cur;sl_cur=sl_next;sl_next=(sl_next==(NSLOT-1)*SLOTB)?0:sl_next+SLOTB;}while(0)
  DMA_K(2,2*SLOTB);
  if constexpr(DV2!=0){WAIT_BAR(4);}else{WAIT_BAR(3);}
  qkt(pA0,pA1,Kbase,qr,cinit<(BAND|DV2)>(negm),r32,hi);asm volatile("s_nop 15\n\ts_nop 7":"+v"(pA0),"+v"(pA1));CMASK(pA0,pA1,0);
  START(pA0,pA1);
  _Pragma("unroll") for(int r=0;r<16;++r)pA1[r]=__builtin_amdgcn_exp2f(pA1[r]);
  WAIT_BAR(0);
  DMA_K(3,0);DMA_V(1,SLOTB);
  ROT();
  kload8(kf,kp0+sl_cur);
  if constexpr(DV2!=0){WAIT_BAR(3);}else{WAIT_BAR(2);}
  s16x4 vlo[8],vhi[8]; u32x4 pw0,pw1,pw2,pw3;
  #define PKW(P,B) cvtpk_s(P[B],P[B+1])
  #define PAF(k) __builtin_bit_cast(bf16x8,pw##k)
  #define VFR(i) (bf16x8){vlo[i][0],vlo[i][1],vlo[i][2],vlo[i][3],vhi[i][0],vhi[i][1],vhi[i][2],vhi[i][3]}
  #define PIN(x) asm volatile("":"+v"(x))
  #define MX3(a,b,c) __builtin_fmaxf(__builtin_fmaxf((a),(b)),(c))
  #define GAPA(MF,A0,A1,A2,A3,W0,W1,PW) do{ MF; sacc+=A0; sacc+=A1; sacc+=A2; sacc+=A3; PIN(sacc); W0; W1; PIN(PW); SBAR(); }while(0)
  #define EX(v) __builtin_amdgcn_exp2f(v)
  #define GAPB(MF,X,B) do{ MF; X[B]=EX(X[B]); X[B+1]=EX(X[B+1]); X[B+2]=EX(X[B+2]); X[B+3]=EX(X[B+3]); PIN(X); SBAR(); }while(0)
  #define GAPB2(MF,X,B,VI) do{ MF; X[B]=EX(X[B]); X[B+1]=EX(X[B+1]); PIN(X); vlo[VI]=vtr(vq_+(((VI)>>2)*4096+((VI)&3)*1024)); vhi[VI]=vtr(vq_+(((VI)>>2)*4096+((VI)&3)*1024+512)); SBAR(); }while(0)
  #define GAPB3(MF,X,B) do{ MF; X[B]=EX(X[B]); X[B+1]=EX(X[B+1]); PIN(X); SBAR(); }while(0)
  #define VRD(i) do{ if constexpr(DV2==0){ vlo[i]=vtr(vp_+(((i)>>2)*4096+((i)&3)*1024)); vhi[i]=vtr(vp_+(((i)>>2)*4096+((i)&3)*1024+512)); } }while(0)
  #define KRD(G,j) do{ if(G){ kload2(kf,kp0+sl_next,j); SBAR(); } }while(0)
  #define STEP(C0,C1,P0,P1,t,GK,GV,GL) do{ SBAR(); \
    const lds_cptr vp_=vp0+sl_prev; \
    VRD(0); SBAR(); float sacc=(P0[0]+P0[1]); \
    GAPA(C0=__builtin_amdgcn_mfma_f32_32x32x16_bf16(kf[0],qr[0],cinit<(BAND|DV2)>(negm),0,0,0), P0[2],P0[3],P0[4],P0[5],     pw0[0]=PKW(P0,0), pw0[1]=PKW(P0,2), pw0); \
    VRD(4); SBAR(); GAPA(C1=__builtin_amdgcn_mfma_f32_32x32x16_bf16(kf[1],qr[0],cinit<(BAND|DV2)>(negm),0,0,0), P0[6],P0[7],P0[8],P0[9],     pw0[2]=PKW(P0,4), pw0[3]=PKW(P0,6), pw0); \
    VRD(1); SBAR(); GAPA(C0=__builtin_amdgcn_mfma_f32_32x32x16_bf16(kf[2],qr[1],C0,0,0,0),   P0[10],P0[11],P0[12],P0[13], pw1[0]=PKW(P0,8), pw1[1]=PKW(P0,10), pw1); \
    VRD(5); SBAR(); GAPA(C1=__builtin_amdgcn_mfma_f32_32x32x16_bf16(kf[3],qr[1],C1,0,0,0),   P0[14],P0[15],P1[0],P1[1],   pw1[2]=PKW(P0,12),pw1[3]=PKW(P0,14), pw1); \
    VRD(2); SBAR(); GAPA(C0=__builtin_amdgcn_mfma_f32_32x32x16_bf16(kf[4],qr[2],C0,0,0,0),   P1[2],P1[3],P1[4],P1[5],     pw2[0]=PKW(P1,0), pw2[1]=PKW(P1,2), pw2); \
    VRD(6); SBAR(); GAPA(C1=__builtin_amdgcn_mfma_f32_32x32x16_bf16(kf[5],qr[2],C1,0,0,0),   P1[6],P1[7],P1[8],P1[9],     pw2[2]=PKW(P1,4), pw2[3]=PKW(P1,6), pw2); \
    VRD(3); SBAR(); GAPA(C0=__builtin_amdgcn_mfma_f32_32x32x16_bf16(kf[6],qr[3],C0,0,0,0),   P1[10],P1[11],P1[12],P1[13], pw3[0]=PKW(P1,8), pw3[1]=PKW(P1,10), pw3); \
    VRD(7); SBAR(); GAPA(C1=__builtin_amdgcn_mfma_f32_32x32x16_bf16(kf[7],qr[3],C1,0,0,0),   P1[14],P1[15],0.f,0.f,       pw3[2]=PKW(P1,12),pw3[3]=PKW(P1,14), pw3); \
    l_reg+=sacc; \
    if(GK){DMA_K((t)+3,sl_cur);} if(GV){DMA_V((t)+1,sl_next);} \
    CMASK(C0,C1,t); \
    { float a=MX3(C0[0],C0[1],C1[0]),b=MX3(C0[2],C0[3],C1[1]); a=MX3(a,C1[2],C1[3]); \
      _Pragma("unroll") for(int r=4;r<16;r+=4){a=MX3(a,C0[r],C0[r+1]);b=MX3(b,C0[r+2],C0[r+3]);a=MX3(a,C1[r],C1[r+1]);b=MX3(b,C1[r+2],C1[r+3]);} \
      float rm=__builtin_fmaxf(a,b); { auto rr=__builtin_amdgcn_permlane32_swap(__float_as_uint(rm),__float_as_uint(rm),false,false); rm=__builtin_fmaxf(__uint_as_float(rr[0]),__uint_as_float(rr[1])); } \
      resc=false; \
      if(__builtin_expect(__any(rm>(float)THRL),0)){ const float dl=__builtin_fmaxf(rm,0.f); mhat+=dl; \
        _Pragma("unroll") for(int r=0;r<16;++r){C0[r]-=dl;C1[r]-=dl;} \
        if constexpr(BAND==0&&DV2==0){ _Pragma("unroll") for(int r=0;r<16;++r)negm[r]=-mhat; asm volatile("":"+v"(negm)); } \
        const float f=__builtin_amdgcn_exp2f(-dl); l_reg*=f; if(hi==0)wsf[r32]=f; resc=true; } } \
    SBAR(); \
    if constexpr(DV2!=0){ _Pragma("unroll") for(int i_=0;i_<8;++i_){ vlo[i_]=vtr(vp_+((i_>>2)*4096+(i_&3)*1024)); vhi[i_]=vtr(vp_+((i_>>2)*4096+(i_&3)*1024+512)); } SBAR(); } \
    if constexpr(DV2==0){ \
    GAPB(o[0]=__builtin_amdgcn_mfma_f32_32x32x16_bf16(PAF(0),VFR(0),o[0],0,0,0), C0,0); \
    GAPB(o[1]=__builtin_amdgcn_mfma_f32_32x32x16_bf16(PAF(0),VFR(4),o[1],0,0,0), C0,4); \
    KRD(GL,0); GAPB(o[0]=__builtin_amdgcn_mfma_f32_32x32x16_bf16(PAF(1),VFR(1),o[0],0,0,0), C0,8); \
    KRD(GL,1); GAPB(o[1]=__builtin_amdgcn_mfma_f32_32x32x16_bf16(PAF(1),VFR(5),o[1],0,0,0), C0,12); \
    KRD(GL,2); GAPB(o[0]=__builtin_amdgcn_mfma_f32_32x32x16_bf16(PAF(2),VFR(2),o[0],0,0,0), C1,0); \
    KRD(GL,3); GAPB(o[1]=__builtin_amdgcn_mfma_f32_32x32x16_bf16(PAF(2),VFR(6),o[1],0,0,0), C1,4); \
    GAPB(o[0]=__builtin_amdgcn_mfma_f32_32x32x16_bf16(PAF(3),VFR(3),o[0],0,0,0), C1,8); \
    GAPB(o[1]=__builtin_amdgcn_mfma_f32_32x32x16_bf16(PAF(3),VFR(7),o[1],0,0,0), C1,12); \
    } else {     \
    const lds_cptr vq_=vp0+(LDS_V2-LDS_V)+sl_prev; \
    GAPB2(o[0]=__builtin_amdgcn_mfma_f32_32x32x16_bf16(PAF(0),VFR(0),o[0],0,0,0), C0,0, 0); \
    GAPB2(o[1]=__builtin_amdgcn_mfma_f32_32x32x16_bf16(PAF(0),VFR(4),o[1],0,0,0), C0,2, 4); \
    KRD(GL,0); GAPB2(o[0]=__builtin_amdgcn_mfma_f32_32x32x16_bf16(PAF(1),VFR(1),o[0],0,0,0), C0,4, 1); \
    KRD(GL,1); GAPB2(o[1]=__builtin_amdgcn_mfma_f32_32x32x16_bf16(PAF(1),VFR(5),o[1],0,0,0), C0,6, 5); \
    KRD(GL,2); GAPB2(o[0]=__builtin_amdgcn_mfma_f32_32x32x16_bf16(PAF(2),VFR(2),o[0],0,0,0), C0,8, 2); \
    KRD(GL,3); GAPB2(o[1]=__builtin_amdgcn_mfma_f32_32x32x16_bf16(PAF(2),VFR(6),o[1],0,0,0), C0,10, 6); \
    GAPB2(o[0]=__builtin_amdgcn_mfma_f32_32x32x16_bf16(PAF(3),VFR(3),o[0],0,0,0), C0,12, 3); \
    GAPB2(o[1]=__builtin_amdgcn_mfma_f32_32x32x16_bf16(PAF(3),VFR(7),o[1],0,0,0), C0,14, 7); \
    GAPB3(o2[0]=__builtin_amdgcn_mfma_f32_32x32x16_bf16(PAF(0),VFR(0),o2[0],0,0,0), C1,0); \
    GAPB3(o2[1]=__builtin_amdgcn_mfma_f32_32x32x16_bf16(PAF(0),VFR(4),o2[1],0,0,0), C1,2); \
    GAPB3(o2[0]=__builtin_amdgcn_mfma_f32_32x32x16_bf16(PAF(1),VFR(1),o2[0],0,0,0), C1,4); \
    GAPB3(o2[1]=__builtin_amdgcn_mfma_f32_32x32x16_bf16(PAF(1),VFR(5),o2[1],0,0,0), C1,6); \
    GAPB3(o2[0]=__builtin_amdgcn_mfma_f32_32x32x16_bf16(PAF(2),VFR(2),o2[0],0,0,0), C1,8); \
    GAPB3(o2[1]=__builtin_amdgcn_mfma_f32_32x32x16_bf16(PAF(2),VFR(6),o2[1],0,0,0), C1,10); \
    GAPB3(o2[0]=__builtin_amdgcn_mfma_f32_32x32x16_bf16(PAF(3),VFR(3),o2[0],0,0,0), C1,12); \
    GAPB3(o2[1]=__builtin_amdgcn_mfma_f32_32x32x16_bf16(PAF(3),VFR(7),o2[1],0,0,0), C1,14); \
    } \
    }while(0)
  int t=1;
  #undef CMASK
  #define CMASK(P0,P1,t) do{ if constexpr(BAND!=0){ band_fix(P0,P1,TMAP(t)-(NT-4),wid,r32,hi,tbl,mhat); } else if constexpr(DV2!=0){ if(__any(mhat!=0.f)){ _Pragma("unroll") for(int r_=0;r_<16;++r_){P0[r_]-=mhat;P1[r_]-=mhat;} } } }while(0)
  for(;t+5<NT;t+=2){
    STEP(pB0,pB1,pA0,pA1,t,true,true,true);     if constexpr(DV2!=0){WAIT_BAR(3);}else{WAIT_BAR(2);} RESC(); ROT();
    STEP(pA0,pA1,pB0,pB1,t+1,true,true,true);   if constexpr(DV2!=0){WAIT_BAR(3);}else{WAIT_BAR(2);} RESC(); ROT();
  }
  #undef CMASK
  #define CMASK(P0,P1,t) do{ if constexpr(BAND!=0){ band_fix(P0,P1,TMAP(t)-(NT-4),wid,r32,hi,tbl,mhat); } else { if constexpr(DV2!=0){ if(__any(mhat!=0.f)){ _Pragma("unroll") for(int r_=0;r_<16;++r_){P0[r_]-=mhat;P1[r_]-=mhat;} } } int jb_=(t)-(NT-4); if(jb_>=0)cmask(P0,P1,jb_,qrel,hi);} }while(0)
  #define ENDW(tt) do{ if constexpr(DV2!=0){ if((tt)+3<NT){WAIT_BAR(3);} else if((tt)+2<NT){WAIT_BAR(2);} else {WAIT_BAR(0);} } else { if((tt)+3<NT){WAIT_BAR(2);} else if((tt)+2<NT){WAIT_BAR(1);} else {WAIT_BAR(0);} } }while(0)
  for(;t+1<NT;t+=2){
    STEP(pB0,pB1,pA0,pA1,t,(t+3<NT),(t+1<NT),(t+1<NT));       ENDW(t);   RESC(); ROT();
    STEP(pA0,pA1,pB0,pB1,t+1,(t+4<NT),(t+2<NT),(t+2<NT));     ENDW(t+1); RESC(); ROT();
  }
  STEP(pB0,pB1,pA0,pA1,NT-1,false,false,false); RESC();
  { float sacc=pB0[0]+pB0[1]; _Pragma("unroll") for(int r=2;r<16;++r)sacc+=pB0[r]; _Pragma("unroll") for(int r=0;r<16;++r)sacc+=pB1[r]; l_reg+=sacc;
    pw0=(u32x4){PKW(pB0,0),PKW(pB0,2),PKW(pB0,4),PKW(pB0,6)};pw1=(u32x4){PKW(pB0,8),PKW(pB0,10),PKW(pB0,12),PKW(pB0,14)};pw2=(u32x4){PKW(pB1,0),PKW(pB1,2),PKW(pB1,4),PKW(pB1,6)};pw3=(u32x4){PKW(pB1,8),PKW(pB1,10),PKW(pB1,12),PKW(pB1,14)};
    SBAR(); pv(o,vb0+sl_cur,PAF(0),PAF(1),PAF(2),PAF(3)); if constexpr(DV2!=0){ SBAR(); pv(o2,vb0+(LDS_V2-LDS_V)+sl_cur,PAF(0),PAF(1),PAF(2),PAF(3)); } }
  #undef PKW
  #undef PAF
  #undef VFR
  #undef PIN
  #undef MX3
  #undef GAPA
  #undef GAPB
  #undef GAPB2
  #undef GAPB3
  #undef EX
  #undef VRD
  #undef KRD
  #undef STEP
  #undef ENDW
  {auto rr=__builtin_amdgcn_permlane32_swap(__float_as_uint(l_reg),__float_as_uint(l_reg),false,false);l_reg=__uint_as_float(rr[0])+__uint_as_float(rr[1]);}
  if(hi==0)wsf[32+r32]=l_reg;asm volatile("s_waitcnt lgkmcnt(0)":::"memory");
  float rli[16];
  #pragma unroll
  for(int r=0;r<16;++r)rli[r]=__builtin_amdgcn_rcpf(wsf[32+crow(r,hi)]);
  bf16*Ow=O+(rowbase+q0+wid*QBLK)*(long)OPITCH+ho*D;
  { bf16*stg=(bf16*)(shm+LDS_OST)+wid*2048;
    #pragma unroll
    for(int r=0;r<16;++r){const int orow=crow(r,hi);
      #pragma unroll
      for(int d0=0;d0<2;++d0)stg[orow*64+d0*32+r32]=__float2bfloat16(o[d0][r]*rli[r]);}
    asm volatile("s_waitcnt lgkmcnt(0)":::"memory");
    #pragma unroll
    for(int i=0;i<4;++i){const int row=i*8+(lane>>3),ch=lane&7; const u32x4 v=*(const u32x4*)(stg+row*64+ch*8); ATTN_STORE16(Ow+(long)row*OPITCH+ch*8,v);}
    if constexpr(DV2!=0){ asm volatile("s_waitcnt lgkmcnt(0)":::"memory");
      #pragma unroll
      for(int r=0;r<16;++r){const int orow=crow(r,hi);
        #pragma unroll
        for(int d0=0;d0<2;++d0)stg[orow*64+d0*32+r32]=__float2bfloat16(o2[d0][r]*rli[r]);}
      asm volatile("s_waitcnt lgkmcnt(0)":::"memory");
      #pragma unroll
      for(int i=0;i<4;++i){const int row=i*8+(lane>>3),ch=lane&7; const u32x4 v=*(const u32x4*)(stg+row*64+ch*8); ATTN_STORE16(Ow+D+(long)row*OPITCH+ch*8,v);} } }
  asm volatile("s_waitcnt lgkmcnt(0)\n\ts_barrier":::"memory");
  #undef DMA_K
  #undef TMAP
  #undef DMA_V
  #undef CMASK
  #undef START
  #undef RESC
  #undef ROT
}
constexpr int ATTN_LDS_BYTES=LDS_BYTES;
#undef SBAR
#undef WAIT_BAR
}

using pg8::bf16_t; using pg8::bf16x8; using pg8::f32x4; using pg8::f32x2; using pg8::u32x4; using pg8::u32x2; using pg8::cvt_pk_bf16; using pg8::bf2f;

enum { IN_XP = 0, IN_XS, IN_CAK, IN_CAV, IN_SBC, IN_SBH, IN_CCK, IN_CCV, IN_GMIX, IN_GMLP, IN_GFIN, IN_AWIN, IN_AQG, IN_AKG, IN_ALAM, IN_ASUB, IN_AWOUT,
       IN_BWIN, IN_BBIN, IN_BCW, IN_BCB, IN_BGAW, IN_BGAB, IN_BGXW, IN_BGXB, IN_BLAM, IN_BWOUT, IN_CWIN, IN_CQG, IN_CKG, IN_CBIAS, IN_CWOUT, IN_W1, IN_W2, N_IN };
constexpr size_t OUT_YP = 0, OUT_YS = OUT_YP + (size_t)MP * D, OUT_AKP = OUT_YS + (size_t)MS * D, OUT_AVP = OUT_AKP + 2 * (size_t)MP * D, OUT_AKS = OUT_AVP + 2 * (size_t)MP * D,
    OUT_AVS = OUT_AKS + 2 * (size_t)MS * D, OUT_BCP = OUT_AVS + 2 * (size_t)MS * D, OUT_BHP = OUT_BCP + (size_t)NB * 3 * D, OUT_BCS = OUT_BHP + (size_t)NB * D, OUT_BHS = OUT_BCS + (size_t)NB * 3 * D,
    OUT_CKP = OUT_BHS + (size_t)NB * D, OUT_CVP = OUT_CKP + (size_t)NB * CWIN * D, OUT_CKS = OUT_CVP + (size_t)NB * CWIN * D, OUT_CVS = OUT_CKS + (size_t)MS * D, OUT_TOTAL = OUT_CVS + (size_t)MS * D;
static_assert(OUT_TOTAL == 186515456ull, "output map");

constexpr size_t MiB = 1u << 20;
constexpr size_t ACT_BF = (size_t)MT * D * 2;
constexpr size_t WS_CTL = 0, CTL_ZERO_BYTES = 32 * 1024;
constexpr size_t WS_ROPE = 1 * MiB;
constexpr size_t WS_SP8 = WS_ROPE + 1 * MiB;
constexpr size_t WS_SSQ = WS_SP8 + 64 * 1024;
constexpr size_t WS_CP = 7 * MiB, WS_CH = 9 * MiB;
constexpr size_t WS_W = 12 * MiB;
constexpr size_t W_AIN = 0, W_AOUT = W_AIN + 2ull * 3072 * 1024, W_BIN = W_AOUT + 2ull * 1024 * 1024, W_BG = W_BIN + 2048ull * 1024, W_BOUT = W_BG + 2048ull * 256,
    W_CIN = W_BOUT + 1024ull * 1024, W_COUT = W_CIN + 3072ull * 1024, W_1 = W_COUT + 1024ull * 1024, W_2 = W_1 + 4ull * 4096 * 1024, W_END = W_2 + 4ull * 4096 * 1024;
constexpr size_t WS_X = WS_W + ((W_END * 2 + MiB - 1) / MiB) * MiB;
constexpr size_t WS_XN = WS_X + (size_t)MT * D * 4;
constexpr size_t WS_Q = WS_XN + ACT_BF, WS_K = WS_Q + ACT_BF, WS_V = WS_K + ACT_BF, WS_ON = WS_V + ACT_BF;
constexpr size_t WS_H = WS_ON + ACT_BF;
constexpr size_t WS_AA = WS_H + (size_t)MT * FF * 2, WS_BB = WS_AA + (size_t)MT * D * 4;
constexpr size_t WS_PO = WS_BB + (size_t)MT * D * 4;
constexpr int NSPLIT = 16;
constexpr size_t WS_PML = WS_PO + 128ull * NSPLIT * 2 * 16 * 128 * 4;
constexpr size_t WS_END = WS_PML + 1 * MiB;

constexpr int RING_OFF = 0, RING_BYTES = 131072;
constexpr int LDSCTL_OFF = RING_BYTES, MISC_OFF = LDSCTL_OFF + 320;
constexpr int LDS_BYTES = 147456;
constexpr int NWAVES = 8;

#define GAS __attribute__((address_space(1)))
#define LAS __attribute__((address_space(3)))
typedef GAS unsigned gu32;
#define RLX_AGENT __ATOMIC_RELAXED, __HIP_MEMORY_SCOPE_AGENT
#define LDS_WAIT() asm volatile("s_waitcnt lgkmcnt(0)" ::: "memory")
#define VM_WAIT() asm volatile("s_waitcnt vmcnt(0)" ::: "memory")

#define XB_TMO      128
#define XB_XCNT(j)  (256  + 64 * (j))
#define XB_XSUB(j)  (1280 + 64 * (j))
#define XB_XGEN(j)  (2304 + 64 * (j))
#define XB_TOP      3328
#define XB_TOPGEN   3392
#define XCD_BAR_WORDS 3456
#define XB_SPIN_CAP (1u << 22)
constexpr int CW_BAR = 4096;

__device__ __forceinline__ unsigned xb_ld(unsigned* p)              { return __hip_atomic_load(p, __ATOMIC_RELAXED, __HIP_MEMORY_SCOPE_AGENT); }
__device__ __forceinline__ unsigned xb_add(unsigned* p, unsigned v) { return __hip_atomic_fetch_add(p, v, __ATOMIC_RELAXED, __HIP_MEMORY_SCOPE_AGENT); }
__device__ __forceinline__ unsigned xb_xcc_id() { return (unsigned)__builtin_amdgcn_s_getreg((3 << 11) | 20) & 0xFu; }
#define XB_SPIN(cond, bar) do { unsigned _sp = 0; while (cond) { __builtin_amdgcn_s_sleep(1); \
    if ((++_sp & 255u) == 0u) { if (xb_ld(&(bar)[XB_TMO])) break; if (_sp > XB_SPIN_CAP) { atomicAdd(&(bar)[XB_TMO], 1u); break; } } } } while (0)

struct XcdBarrier { unsigned* bar; unsigned x; volatile LAS unsigned* st; };

__device__ __forceinline__ XcdBarrier xcd_barrier_post(unsigned* bar, volatile LAS unsigned* st) {
    XcdBarrier b; b.bar = bar; b.x = xb_xcc_id(); b.st = st;
    if (threadIdx.x == 0) (void)xb_add(&bar[XB_XCNT(b.x)], 1u);
    return b;
}
__device__ __forceinline__ void xcd_barrier_complete(unsigned* bar, unsigned x, unsigned& nloc, unsigned& nx) {
    const unsigned G = gridDim.x * gridDim.y * gridDim.z;
    unsigned sum, cnt, mine, sp = 0u;
    for (;;) {
        sum = 0u; cnt = 0u; mine = 0u;
#pragma unroll
        for (unsigned j = 0; j < 16; ++j) { const unsigned c = xb_ld(&bar[XB_XCNT(j)]); sum += c; cnt += (c > 0u) ? 1u : 0u; mine = (j == x) ? c : mine; }
        if (sum == G) break;
        __builtin_amdgcn_s_sleep(1);
        if ((++sp & 255u) == 0u) { if (xb_ld(&bar[XB_TMO])) break; if (sp > XB_SPIN_CAP) { atomicAdd(&bar[XB_TMO], 1u); break; } }
    }
    nloc = mine > 0u ? mine : 1u; nx = cnt > 0u ? cnt : 1u;
}
__device__ __forceinline__ void xcd_barrier(const XcdBarrier& b) {
    asm volatile("s_waitcnt vmcnt(0)" ::: "memory");
    __syncthreads();
    if (threadIdx.x == 0) {
        unsigned* bar = b.bar;
        __builtin_amdgcn_s_waitcnt(0);
        unsigned nloc = b.st[0], nx = b.st[1];
        if (nloc == 0u) { xcd_barrier_complete(bar, b.x, nloc, nx); b.st[0] = nloc; b.st[1] = nx; }
        const unsigned old = xb_add(&bar[XB_XSUB(b.x)], 1u);
        const unsigned gen = old / nloc;
        if (old + 1u == (gen + 1u) * nloc) {
            __builtin_amdgcn_fence(__ATOMIC_RELEASE, "agent");
            asm volatile("s_waitcnt vmcnt(0)" ::: "memory");
            const unsigned og = xb_add(&bar[XB_TOP], 1u);
            const unsigned tg = og / nx;
            if (og + 1u == (tg + 1u) * nx) xb_add(&bar[XB_TOPGEN], 1u);
            else XB_SPIN(xb_ld(&bar[XB_TOPGEN]) == tg, bar);
            __builtin_amdgcn_fence(__ATOMIC_ACQUIRE, "agent");
            xb_add(&bar[XB_XGEN(b.x)], 1u);
            asm volatile("s_waitcnt vmcnt(0)" ::: "memory");
        } else {
            XB_SPIN(xb_ld(&bar[XB_XGEN(b.x)]) == gen, bar);
            __builtin_amdgcn_fence(__ATOMIC_ACQUIRE, "agent");
            asm volatile("s_waitcnt vmcnt(0)" ::: "memory");
        }
    }
    __syncthreads();
}

using pg8::swz_xor; using pg8::xadd32; using pg8::xmax32;
__device__ __forceinline__ float wave_sum(float v) {
    v += swz_xor<1>(v); v += swz_xor<2>(v); v += swz_xor<4>(v); v += swz_xor<8>(v); v += swz_xor<16>(v);
    return xadd32(v);
}
__device__ __forceinline__ unsigned f2bf(float f) { unsigned u = __builtin_bit_cast(unsigned, f); return (u + 0x7fffu + ((u >> 16) & 1u)) >> 16; }
__device__ __forceinline__ unsigned pk2(float lo, float hi) { return f2bf(lo) | (f2bf(hi) << 16); }

__device__ __forceinline__ void tr_item(const float* W, int N, int k0, int n0, bf16_t* WT, int K, int dst_row0, LAS float* scr, int lane, const float* gk = nullptr) {
    float wv[32], gv[32];
#pragma unroll
    for (int i = 0; i < 32; ++i) { const int kk = 2 * i + (lane >> 5); wv[i] = W[(size_t)(k0 + kk) * N + n0 + (lane & 31)]; gv[i] = gk ? gk[k0 + kk] : 1.0f; }
    __builtin_amdgcn_sched_barrier(0);
#pragma unroll
    for (int i = 0; i < 32; ++i) { const int kk = 2 * i + (lane >> 5); scr[kk * 33 + (lane & 31)] = wv[i] * gv[i]; }
    LDS_WAIT(); asm volatile("" ::: "memory");
    const int c = lane & 7;
#pragma unroll
    for (int j = 0; j < 4; ++j) { const int n = (lane >> 3) + 8 * j; const LAS float* s = scr + (8 * c) * 33 + n;
        u32x4 o; o.x = pk2(s[0 * 33], s[1 * 33]); o.y = pk2(s[2 * 33], s[3 * 33]); o.z = pk2(s[4 * 33], s[5 * 33]); o.w = pk2(s[6 * 33], s[7 * 33]);
        *(u32x4*)(WT + (size_t)(dst_row0 + n) * K + k0 + 8 * c) = o; }
    LDS_WAIT(); asm volatile("" ::: "memory");
}
__device__ __forceinline__ int qkv_phys_row(int n0) { const int lb = (n0 & 255) >> 5, wc = lb >> 1, bjh = lb & 1; return (n0 & ~255) + (bjh * 4 + wc) * 32; }

__device__ __forceinline__ void norm_row(const float* xrow, const float* g, bf16_t* orow, float* copyrow, float* f32out, int lane, float* prep = nullptr) {
    const f32x4* xr = (const f32x4*)xrow + lane; const f32x4* gr = (const f32x4*)g + lane;
    f32x4 v[4]; float s = 0.f;
#pragma unroll
    for (int j = 0; j < 4; ++j) { v[j] = xr[64 * j]; s += (v[j].x * v[j].x + v[j].y * v[j].y) + (v[j].z * v[j].z + v[j].w * v[j].w); }
    if (copyrow) {
#pragma unroll
        for (int j = 0; j < 4; ++j) ((f32x4*)copyrow + lane)[64 * j] = v[j]; }
    const float tot = wave_sum(s);
    const float rs = prep ? 1.0f : 1.0f / sqrtf(tot * (1.0f / D) + EPS);
    if (prep && lane < 16) prep[lane] = lane == 0 ? tot : 0.f;
#pragma unroll
    for (int j = 0; j < 4; ++j) { if (!prep) { const f32x4 gg = gr[64 * j]; v[j] = v[j] * rs * gg; } }
    if (orow) { unsigned long long* o8 = (unsigned long long*)orow + lane;
#pragma unroll
        for (int j = 0; j < 4; ++j) o8[64 * j] = (unsigned long long)cvt_pk_bf16(v[j].x, v[j].y) | ((unsigned long long)cvt_pk_bf16(v[j].z, v[j].w) << 32); }
    if (f32out) {
#pragma unroll
        for (int j = 0; j < 4; ++j) ((f32x4*)f32out + lane)[64 * j] = v[j]; }
}

constexpr int RS_OFF = LDSCTL_OFF + 2048;
static_assert(RS_OFF + 8 * 256 * 4 <= LDS_BYTES, "LDS map");
__device__ __forceinline__ void fill_row_factors(LAS unsigned char* ldsp, const pg8::StaticOrder& S, const float* SSQ, int tid) {
    LAS float* RS = (LAS float*)(ldsp + RS_OFF); pg8::Unit u;
    const int r = tid & 255, i0 = tid >> 8;
    f32x4 t[4][4]; bool ok[4];
#pragma unroll
    for (int k = 0; k < 4; ++k) { ok[k] = S.next(i0 + 2 * k, u);
        if (ok[k]) { const f32x4* p = (const f32x4*)(SSQ + (size_t)(u.pm * 256 + r) * 16);
#pragma unroll
            for (int j = 0; j < 4; ++j) t[k][j] = p[j]; } }
#pragma unroll
    for (int k = 0; k < 4; ++k) if (ok[k]) { const f32x4 a = (t[k][0] + t[k][1]) + (t[k][2] + t[k][3]);
        RS[(i0 + 2 * k) * 256 + r] = 1.0f / sqrtf(((a.x + a.y) + (a.z + a.w)) * (1.0f / 1024.0f) + EPS); }
    asm volatile("s_waitcnt vmcnt(0) lgkmcnt(0)" ::: "memory"); __syncthreads();
}

struct AttnItem { const bf16_t* q; const float* kc; const float* vc; const bf16_t* kn; const bf16_t* vn; const float* btab; int cstride, n_cache, k_lo, k_hi, n_total, rel0, head; };

template <int NC, int DV>
__device__ __forceinline__ void attn16_core(const AttnItem& it, int lane, float (&m)[NC], float (&l)[NC], f32x4 (&o)[NC][DV / 16]) {
    const int g = lane >> 4, c16 = lane & 15;
    bf16x8 qop[NC][2];
#pragma unroll
    for (int c = 0; c < NC; ++c)
#pragma unroll
        for (int s = 0; s < 2; ++s) qop[c][s] = *(const bf16x8*)(it.q + (size_t)c16 * D + c * 64 + 32 * s + 8 * g);
    __builtin_amdgcn_sched_barrier(0);
#pragma unroll
    for (int c = 0; c < NC; ++c) { m[c] = -1e30f; l[c] = 0.f;
#pragma unroll
        for (int e = 0; e < DV / 16; ++e) o[c][e] = (f32x4){0.f, 0.f, 0.f, 0.f}; }
    for (int k0 = it.k_lo; k0 < it.k_hi; k0 += 32) {
        const bool cache = k0 < it.n_cache;
        int vkey[8];
#pragma unroll
        for (int j = 0; j < 8; ++j) { int key = k0 + 16 * (j >> 2) + 4 * g + (j & 3); vkey[j] = key < it.n_total ? key : it.n_total - 1; }
        f32x4 sacc[NC][2];
        float vv[DV / 16][8];
        if (cache) {
            f32x4 kv[2][NC][2][2];
#pragma unroll
            for (int t = 0; t < 2; ++t) { const int key = k0 + 16 * t + c16;
#pragma unroll
                for (int c = 0; c < NC; ++c)
#pragma unroll
                    for (int s = 0; s < 2; ++s) { const float* p = it.kc + (size_t)key * it.cstride + c * 64 + 32 * s + 8 * g; kv[t][c][s][0] = *(const f32x4*)p; kv[t][c][s][1] = *(const f32x4*)(p + 4); } }
            __builtin_amdgcn_sched_barrier(0);
#pragma unroll
            for (int e = 0; e < DV / 32; ++e)
#pragma unroll
                for (int j = 0; j < 8; ++j) vv[e][j] = it.vc[(size_t)vkey[j] * it.cstride + e * 16 + c16];
            __builtin_amdgcn_sched_barrier(0);
#pragma unroll
            for (int t = 0; t < 2; ++t)
#pragma unroll
                for (int c = 0; c < NC; ++c) { f32x4 acc = (f32x4){0.f, 0.f, 0.f, 0.f};
#pragma unroll
                    for (int s = 0; s < 2; ++s) { const f32x4 v0 = kv[t][c][s][0], v1 = kv[t][c][s][1];
                        u32x4 w; w.x = cvt_pk_bf16(v0.x, v0.y); w.y = cvt_pk_bf16(v0.z, v0.w); w.z = cvt_pk_bf16(v1.x, v1.y); w.w = cvt_pk_bf16(v1.z, v1.w);
                        acc = __builtin_amdgcn_mfma_f32_16x16x32_bf16(__builtin_bit_cast(bf16x8, w), qop[c][s], acc, 0, 0, 0); }
                    sacc[c][t] = acc; }
            __builtin_amdgcn_sched_barrier(0);
#pragma unroll
            for (int e = DV / 32; e < DV / 16; ++e)
#pragma unroll
                for (int j = 0; j < 8; ++j) vv[e][j] = it.vc[(size_t)vkey[j] * it.cstride + e * 16 + c16];
            __builtin_amdgcn_sched_barrier(0);
        } else {
#pragma unroll
            for (int t = 0; t < 2; ++t) {
                int key = k0 + 16 * t + c16; key = key < it.n_total ? key : it.n_total - 1;
#pragma unroll
                for (int c = 0; c < NC; ++c) {
                    f32x4 acc = (f32x4){0.f, 0.f, 0.f, 0.f};
#pragma unroll
                    for (int s = 0; s < 2; ++s) {
                        const bf16x8 a = *(const bf16x8*)(it.kn + (size_t)(key - it.n_cache) * D + c * 64 + 32 * s + 8 * g);
                        acc = __builtin_amdgcn_mfma_f32_16x16x32_bf16(a, qop[c][s], acc, 0, 0, 0);
                    }
                    sacc[c][t] = acc;
                }
            }
        }
        if (it.btab) {
            float bvv[2][4];
#pragma unroll
            for (int t = 0; t < 2; ++t)
#pragma unroll
                for (int r = 0; r < 4; ++r) { const int kidx = k0 + 16 * t + 4 * g + r; int rel = it.rel0 + c16 - kidx; rel = rel < -128 ? -128 : (rel > 128 ? 128 : rel); bvv[t][r] = it.btab[(rel + 128) * 16 + it.head]; }
#pragma unroll
            for (int t = 0; t < 2; ++t)
#pragma unroll
                for (int r = 0; r < 4; ++r)
#pragma unroll
                    for (int c = 0; c < NC; ++c) sacc[c][t][r] += bvv[t][r] * LOG2E;
        }
#pragma unroll
        for (int t = 0; t < 2; ++t)
#pragma unroll
            for (int r = 0; r < 4; ++r) { const int kidx = k0 + 16 * t + 4 * g + r;
                if (kidx >= it.n_total) {
#pragma unroll
                    for (int c = 0; c < NC; ++c) sacc[c][t][r] = -1e30f; } }
        bf16x8 pop[NC];
#pragma unroll
        for (int c = 0; c < NC; ++c) {
            float bm = fmaxf(fmaxf(fmaxf(sacc[c][0][0], sacc[c][0][1]), fmaxf(sacc[c][0][2], sacc[c][0][3])), fmaxf(fmaxf(sacc[c][1][0], sacc[c][1][1]), fmaxf(sacc[c][1][2], sacc[c][1][3])));
            bm = fmaxf(bm, swz_xor<16>(bm)); bm = xmax32(bm);
            const float mn = fmaxf(m[c], bm), alpha = __builtin_amdgcn_exp2f(m[c] - mn); m[c] = mn;
            float p[8], ps = 0.f;
#pragma unroll
            for (int t = 0; t < 2; ++t)
#pragma unroll
                for (int r = 0; r < 4; ++r) { p[4 * t + r] = __builtin_amdgcn_exp2f(sacc[c][t][r] - mn); ps += p[4 * t + r]; }
            l[c] = l[c] * alpha + ps;
#pragma unroll
            for (int e = 0; e < DV / 16; ++e) o[c][e] = o[c][e] * alpha;
            u32x4 w; w.x = cvt_pk_bf16(p[0], p[1]); w.y = cvt_pk_bf16(p[2], p[3]); w.z = cvt_pk_bf16(p[4], p[5]); w.w = cvt_pk_bf16(p[6], p[7]); pop[c] = __builtin_bit_cast(bf16x8, w);
        }
#pragma unroll
        for (int e = 0; e < DV / 16; ++e) {
            bf16x8 av;
            if (cache) { u32x4 w; w.x = cvt_pk_bf16(vv[e][0], vv[e][1]); w.y = cvt_pk_bf16(vv[e][2], vv[e][3]); w.z = cvt_pk_bf16(vv[e][4], vv[e][5]); w.w = cvt_pk_bf16(vv[e][6], vv[e][7]); av = __builtin_bit_cast(bf16x8, w); }
            else { unsigned short v[8];
#pragma unroll
                for (int j = 0; j < 8; ++j) v[j] = it.vn[(size_t)(vkey[j] - it.n_cache) * D + e * 16 + c16];
                u32x4 w; w.x = v[0] | ((unsigned)v[1] << 16); w.y = v[2] | ((unsigned)v[3] << 16); w.z = v[4] | ((unsigned)v[5] << 16); w.w = v[6] | ((unsigned)v[7] << 16); av = __builtin_bit_cast(bf16x8, w); }
#pragma unroll
            for (int c = 0; c < NC; ++c) o[c][e] = __builtin_amdgcn_mfma_f32_16x16x32_bf16(av, pop[c], o[c][e], 0, 0, 0);
        }
    }
#pragma unroll
    for (int c = 0; c < NC; ++c) { l[c] += swz_xor<16>(l[c]); l[c] = xadd32(l[c]); }
}


typedef float f32x16s __attribute__((ext_vector_type(16)));
template <class F>
__device__ __forceinline__ void skinny_gemm(LAS unsigned char* lds, const bf16_t* A, int lda, const bf16_t* Bt, int K, int ncb, const F& f, int vcu, int G, int wave, int lane) {
    const int r32 = lane & 31, hi = lane >> 5, tid = wave * 64 + lane;
    LAS float* part = (LAS float*)lds;
    for (int item = vcu; item < 8 * ncb; item += G) {
        const int rb = item & 7, cb = item >> 3;
        const bf16_t* ap = A + f.aoff(cb) + (size_t)(rb * 32 + r32) * lda + hi * 8 + wave * (K >> 3);
        const bf16_t* b0 = Bt + (size_t)(f.brow(cb, 0) + r32) * K + hi * 8 + wave * (K >> 3);
        const bf16_t* b1 = Bt + (size_t)(f.brow(cb, 1) + r32) * K + hi * 8 + wave * (K >> 3);
        const f32x4 pv = f.pre(rb * 32 + (tid >> 4), cb, tid & 15);
        f32x16s acc0, acc1;
#pragma unroll
        for (int r = 0; r < 16; ++r) { acc0[r] = 0.f; acc1[r] = 0.f; }
        const int nks = K >> 7;
        if (nks >= 8) {
            for (int ks = 0; ks < nks; ks += 8) {
                bf16x8 a[8], p[8], qv[8];
#pragma unroll
                for (int j = 0; j < 8; ++j) { a[j] = *(const bf16x8*)(ap + (ks + j) * 16); p[j] = *(const bf16x8*)(b0 + (ks + j) * 16); qv[j] = *(const bf16x8*)(b1 + (ks + j) * 16); }
                __builtin_amdgcn_sched_barrier(0);
#pragma unroll
                for (int j = 0; j < 8; ++j) { acc0 = __builtin_amdgcn_mfma_f32_32x32x16_bf16(a[j], p[j], acc0, 0, 0, 0); acc1 = __builtin_amdgcn_mfma_f32_32x32x16_bf16(a[j], qv[j], acc1, 0, 0, 0); }
                __builtin_amdgcn_sched_barrier(0);
            }
        } else {
            for (int ks = 0; ks < nks; ks += 2) {
                const bf16x8 a0 = *(const bf16x8*)(ap + ks * 16), a1 = *(const bf16x8*)(ap + ks * 16 + 16);
                const bf16x8 p0 = *(const bf16x8*)(b0 + ks * 16), p1 = *(const bf16x8*)(b0 + ks * 16 + 16);
                const bf16x8 q0 = *(const bf16x8*)(b1 + ks * 16), q1 = *(const bf16x8*)(b1 + ks * 16 + 16);
                acc0 = __builtin_amdgcn_mfma_f32_32x32x16_bf16(a0, p0, acc0, 0, 0, 0); acc1 = __builtin_amdgcn_mfma_f32_32x32x16_bf16(a0, q0, acc1, 0, 0, 0);
                acc0 = __builtin_amdgcn_mfma_f32_32x32x16_bf16(a1, p1, acc0, 0, 0, 0); acc1 = __builtin_amdgcn_mfma_f32_32x32x16_bf16(a1, q1, acc1, 0, 0, 0);
            }
        }
        LAS float* pw = part + wave * (32 * 65);
#pragma unroll
        for (int r = 0; r < 16; ++r) { const int row = (r & 3) + 8 * (r >> 2) + 4 * hi; pw[row * 65 + r32] = acc0[r]; pw[row * 65 + 32 + r32] = acc1[r]; }
        asm volatile("s_waitcnt lgkmcnt(0)\n\ts_barrier" ::: "memory");
        const int row = tid >> 4, q = tid & 15;
        float x[4] = {0.f, 0.f, 0.f, 0.f};
#pragma unroll
        for (int w = 0; w < 8; ++w) { const LAS float* p = part + w * (32 * 65) + row * 65 + 4 * q;
#pragma unroll
            for (int i = 0; i < 4; ++i) x[i] += p[i]; }
        asm volatile("s_waitcnt lgkmcnt(0)\n\ts_barrier" ::: "memory");
        f.epi(rb * 32 + row, cb, q, x, pv);
    }
}
__device__ __forceinline__ u32x2 pack4(const float (&x)[4]) { u32x2 w; w.x = cvt_pk_bf16(x[0], x[1]); w.y = cvt_pk_bf16(x[2], x[3]); return w; }
template <bool ROPE> struct SkQKV {
    bf16_t* Q; size_t qkv_stride; const float *qg, *kg, *rope; float* oks; size_t kvs_stride; const float* SSQ;
    __device__ __forceinline__ size_t aoff(int) const { return 0; }
    __device__ __forceinline__ int brow(int cb, int blk) const { const int kind = cb >> 4, hc = cb & 15, n0 = kind * 1024 + hc * 64; return (n0 & ~255) + (blk * 4 + (hc & 3)) * 32; }
    __device__ __forceinline__ f32x4 pre(int srow, int, int) const { return (f32x4){pg8::row_rstd(SSQ, MP + srow), 0.f, 0.f, 0.f}; }
    __device__ __forceinline__ void epi(int srow, int cb, int q, float (&x)[4], const f32x4& pv) const {
        const int kind = cb >> 4, hc = cb & 15, d0 = 4 * q, col = hc * 64 + d0;
        { const float rr = pv.x;
#pragma unroll
          for (int i = 0; i < 4; ++i) x[i] *= rr; }
        if (kind < 2) {
            float ss = (x[0] * x[0] + x[1] * x[1]) + (x[2] * x[2] + x[3] * x[3]);
            ss += swz_xor<1>(ss); ss += swz_xor<2>(ss); ss += swz_xor<4>(ss); ss += swz_xor<8>(ss);
            const float rs = 1.0f / sqrtf(ss * (1.0f / 64.0f) + EPS);
            const f32x4 g = *(const f32x4*)((kind == 0 ? qg : kg) + d0);
#pragma unroll
            for (int i = 0; i < 4; ++i) x[i] *= rs * g[i];
            if (ROPE) {
                float y[4];
#pragma unroll
                for (int i = 0; i < 4; ++i) y[i] = swz_xor<8>(x[i]);
                const float* rp = rope + (size_t)(SEQ + (srow & (DSEQ - 1))) * 64 + (d0 & 31);
                const f32x4 c = *(const f32x4*)rp, sn = *(const f32x4*)(rp + 32);
                const float sg = d0 < 32 ? -1.0f : 1.0f;
#pragma unroll
                for (int i = 0; i < 4; ++i) x[i] = x[i] * c[i] + sg * y[i] * sn[i];
            }
        }
        if (kind >= 1) *(f32x4*)(oks + (size_t)(kind - 1) * kvs_stride + (size_t)srow * D + col) = (f32x4){x[0], x[1], x[2], x[3]};
        if (kind == 0) {
#pragma unroll
            for (int i = 0; i < 4; ++i) x[i] *= QSCALE; }
        *(u32x2*)(Q + (size_t)kind * qkv_stride + (size_t)(MP + srow) * D + col) = pack4(x);
    }
};
struct SkResAdd {
    bf16_t* Xb; const float* Xrs32; float* X32s; float* SSQ;
    __device__ __forceinline__ size_t aoff(int) const { return 0; }
    __device__ __forceinline__ int brow(int cb, int blk) const { return cb * 64 + blk * 32; }
    __device__ __forceinline__ f32x4 pre(int srow, int cb, int q) const { const int col = cb * 64 + 4 * q;
        if (Xrs32) return *(const f32x4*)(Xrs32 + (size_t)srow * D + col);
        const u32x2 w = *(const u32x2*)(Xb + (size_t)(MP + srow) * D + col); return (f32x4){bf2f(w.x & 0xffff), bf2f(w.x >> 16), bf2f(w.y & 0xffff), bf2f(w.y >> 16)}; }
    __device__ __forceinline__ void epi(int srow, int cb, int q, float (&x)[4], const f32x4& pv) const { const int col = cb * 64 + 4 * q;
        const f32x4 v = pv + (f32x4){x[0], x[1], x[2], x[3]};
        if (X32s) *(f32x4*)(X32s + (size_t)srow * D + col) = v;
        else { float ss = (v.x * v.x + v.y * v.y) + (v.z * v.z + v.w * v.w); ss += swz_xor<1>(ss); ss += swz_xor<2>(ss); ss += swz_xor<4>(ss); ss += swz_xor<8>(ss);
            if (q == 0) SSQ[(size_t)(MP + srow) * 16 + cb] = ss;
            u32x2 w; w.x = cvt_pk_bf16(v.x, v.y); w.y = cvt_pk_bf16(v.z, v.w); *(u32x2*)(Xb + (size_t)(MP + srow) * D + col) = w; } }
};
struct SkRelu2 {
    bf16_t* O; const float* SSQ;
    __device__ __forceinline__ size_t aoff(int) const { return 0; }
    __device__ __forceinline__ int brow(int cb, int blk) const { return cb * 64 + blk * 32; }
    __device__ __forceinline__ f32x4 pre(int srow, int, int) const { return (f32x4){pg8::row_rstd(SSQ, MP + srow), 0.f, 0.f, 0.f}; }
    __device__ __forceinline__ void epi(int srow, int cb, int q, float (&x)[4], const f32x4& pv) const { const float rr = pv.x;
#pragma unroll
        for (int i = 0; i < 4; ++i) { const float v = fmaxf(x[i] * rr, 0.f); x[i] = v * v; }
        *(u32x2*)(O + (size_t)(MP + srow) * FF + cb * 64 + 4 * q) = pack4(x); }
};
struct SkBin {
    bf16_t *G, *U; const float* bias; float* ocs; const float* SSQ;
    __device__ __forceinline__ size_t aoff(int) const { return 0; }
    __device__ __forceinline__ int brow(int cb, int blk) const { return cb * 64 + blk * 32; }
    __device__ __forceinline__ f32x4 pre(int srow, int, int) const { return (f32x4){pg8::row_rstd(SSQ, MP + srow), 0.f, 0.f, 0.f}; }
    __device__ __forceinline__ void epi(int srow, int cb, int q, float (&x)[4], const f32x4& pv) const {
        const int col = cb * 64 + 4 * q; const f32x4 bv = *(const f32x4*)(bias + col); const float rr = pv.x;
#pragma unroll
        for (int i = 0; i < 4; ++i) x[i] = x[i] * rr + bv[i];
        if (col < D) {
#pragma unroll
            for (int i = 0; i < 4; ++i) x[i] = pg8::gelu_tanh(x[i]);
            *(u32x2*)(G + (size_t)(MP + srow) * D + col) = pack4(x);
        } else {
            const int uc = col - D; *(u32x2*)(U + (size_t)(MP + srow) * D + uc) = pack4(x);
            const int t = srow & (DSEQ - 1), b = srow >> 4;
            if (t >= DSEQ - 3) *(f32x4*)(ocs + (size_t)(b * 3 + (t - (DSEQ - 3))) * D + uc) = (f32x4){x[0], x[1], x[2], x[3]};
        }
    }
};
struct SkGates {
    const bf16_t* XCB; const float *gab, *gxb, *sp8; bf16_t *AA, *BB;
    __device__ __forceinline__ size_t aoff(int cb) const { return (size_t)(cb >> 3) * MT * 256; }
    __device__ __forceinline__ int brow(int cb, int blk) const { const int nb = cb >> 3, cg = cb & 7; return (nb * 2 + (cg >> 2)) * 256 + blk * 128 + (cg & 3) * 32; }
    __device__ __forceinline__ f32x4 pre(int, int, int) const { return (f32x4){0.f, 0.f, 0.f, 0.f}; }
    __device__ __forceinline__ void epi(int srow, int cb, int q, float (&x)[4], const f32x4&) const {
        float y[4];
#pragma unroll
        for (int i = 0; i < 4; ++i) y[i] = swz_xor<8>(x[i]);
        if (q < 8) {
            const int nb = cb >> 3, cg = cb & 7, cin = cg * 32 + 4 * q, ch = nb * 256 + cin;
            const f32x4 ba = *(const f32x4*)(gab + ch), bx = *(const f32x4*)(gxb + ch), sp = *(const f32x4*)(sp8 + ch);
            const u32x2 xw = *(const u32x2*)(XCB + ((size_t)nb * MT + MP + srow) * 256 + cin);
            f32x4 a, b;
#pragma unroll
            for (int i = 0; i < 4; ++i) {
                const unsigned w = i < 2 ? xw.x : xw.y; const float xc = bf2f((unsigned short)((i & 1) ? (w >> 16) : (w & 0xffffu)));
                const float r = 1.0f / (1.0f + __expf(-(x[i] + ba[i]))), ig = 1.0f / (1.0f + __expf(-(y[i] + bx[i])));
                const float la = -r * sp[i], t2 = 2.0f * la;
                a[i] = la;
                const float poly = -t2 * (1.0f + t2 * (0.5f + t2 * (0.16666667f + t2 * (0.041666668f + t2 * (0.0083333338f + t2 * 0.0013888889f)))));
                const float em = t2 > -0.25f ? poly : 1.0f - __expf(t2);
                b[i] = sqrtf(em) * (ig * xc); }
            { u32x2 wa, wb; wa.x = cvt_pk_bf16(a[0], a[1]); wa.y = cvt_pk_bf16(a[2], a[3]); wb.x = cvt_pk_bf16(b[0], b[1]); wb.y = cvt_pk_bf16(b[2], b[3]);
              *(u32x2*)(AA + (size_t)(MP + srow) * D + ch) = wa; *(u32x2*)(BB + (size_t)(MP + srow) * D + ch) = wb; }
        }
    }
};

struct Args;
struct Args { const GAS float* in[N_IN]; GAS float* out; GAS unsigned char* ws;     int ph_lo, ph_hi, single, dupmask; float lam_init[2]; float rope_inv[32]; };

typedef const __attribute__((address_space(4))) Args* KArgs;
__device__ __forceinline__ KArgs kargs() { KArgs p = (KArgs)__builtin_amdgcn_kernarg_segment_ptr(); asm volatile("" : "+s"(p)); return p; }
__global__ void __launch_bounds__(NWAVES * 64, 2) fwd_kernel(Args args) {
    extern __shared__ __attribute__((aligned(16))) unsigned char lds[];
    LAS unsigned char* const ldsp = (LAS unsigned char*)lds;
    volatile LAS unsigned* const MISC = (volatile LAS unsigned*)(ldsp + MISC_OFF);
    const int tid = threadIdx.x; const int wave = __builtin_amdgcn_readfirstlane(tid >> 6);
    const int G = gridDim.x; const int bx = blockIdx.x; const int vcu = (G % 8 == 0) ? (bx % 8) * (G / 8) + bx / 8 : bx;
    const int gw = vcu * NWAVES + wave, NGW = G * NWAVES;
    const int NGT = NGW * 64;
    gu32* const ctl = (gu32*)((unsigned char*)args.ws + WS_CTL);
    for (int u = tid; u < (LDS_BYTES - LDSCTL_OFF) / 4; u += NWAVES * 64) ((LAS unsigned*)(ldsp + LDSCTL_OFF))[u] = 0u;
    __syncthreads();
    XcdBarrier bar; bar.bar = (unsigned*)(ctl + CW_BAR); bar.x = 0; bar.st = nullptr;
    if (args.single) bar = xcd_barrier_post((unsigned*)(ctl + CW_BAR), MISC + 8);
    const int lo = args.ph_lo, hi = args.ph_hi;
#ifndef PHM
#define PHM 0xFFFFFFFFu
#endif
#define EN(b) (((PHM) >> (b)) & 1u)
#define RUN(k) (lo <= (k) && (k) < hi)
#define SEAM() do { if (args.single) xcd_barrier(bar); } while (0)

#if PROBE_DUP
#define REP_BEGIN(k) for (int rep_ = 0, nrep_ = (args.dupmask >> (k)) & 1; rep_ <= nrep_; ++rep_) {
#define REP_END }
#define REP_DUMMY (rep_ < nrep_)
#else
#define REP_BEGIN(k) {
#define REP_END }
#define REP_DUMMY false
#endif
#define INP(i) ((const float*)ap->in[i])
#define PHASE_PTRS \
    unsigned ones_ = ~0u; asm volatile("" : "+s"(ones_)); int lane = (int)__builtin_amdgcn_mbcnt_hi(ones_, __builtin_amdgcn_mbcnt_lo(ones_, 0u)); asm volatile("" : "+v"(lane)); const int gt = gw * 64 + lane; (void)gt; const int ptid = wave * 64 + lane; (void)ptid; int pG = G, pbx = bx; asm volatile("" : "+s"(pG), "+s"(pbx));   \
    const KArgs ap = kargs(); unsigned char* const ws = (unsigned char*)ap->ws; float* const out = (float*)ap->out; (void)out; \
    float* const X = (float*)(ws + WS_X); (void)X; bf16_t* const XN = (bf16_t*)(ws + WS_XN); (void)XN; \
    bf16_t* const Qb = (bf16_t*)(ws + WS_Q); (void)Qb; bf16_t* const Kb = (bf16_t*)(ws + WS_K); (void)Kb; bf16_t* const Vb = (bf16_t*)(ws + WS_V); (void)Vb; bf16_t* const ON = (bf16_t*)(ws + WS_ON); (void)ON; \
    bf16_t* const Hb = (bf16_t*)(ws + WS_H); (void)Hb; float* const AA = (float*)(ws + WS_AA); (void)AA; float* const BB = (float*)(ws + WS_BB); (void)BB; \
    float* const ROPE = (float*)(ws + WS_ROPE); (void)ROPE; float* const SP8 = (float*)(ws + WS_SP8); (void)SP8; float* const SSQ0 = (float*)(ws + WS_SSQ); (void)SSQ0; float* const SSQ1 = SSQ0 + (size_t)MT * 16; (void)SSQ1; \
    float* const CP = (float*)(ws + WS_CP); (void)CP; float* const CH = (float*)(ws + WS_CH); (void)CH; \
    float* const PO = (float*)(ws + WS_PO); (void)PO; float* const PML = (float*)(ws + WS_PML); (void)PML; \
    bf16_t* const Wb = (bf16_t*)(ws + WS_W); (void)Wb; \
    bf16_t* const Gb = Qb; (void)Gb; bf16_t* const Ub = Kb; (void)Ub; bf16_t* const XCB = Vb; (void)XCB; bf16_t* const HG = ON; (void)HG;

    if (EN(0) && RUN(0)) {
            REP_BEGIN(0)
            PHASE_PTRS
        LAS float* scr = (LAS float*)(ldsp + RING_OFF + wave * 16384);
        constexpr int I_AIN = 16 * 96, I_SQ = 16 * 32, I_BIN = 16 * 64, I_G = 4 * 8, I_1 = 16 * 128, I_2 = 64 * 32;
        constexpr int NITEMS = 2 * I_AIN + 2 * I_SQ + I_BIN + 8 * I_G + I_SQ + I_AIN + I_SQ + 4 * I_1 + 4 * I_2;
        for (int it = gw; it < NITEMS; it += NGW) {
            int r = it;
            if (r < 2 * I_AIN) { const int li = r / I_AIN, q = r % I_AIN, kb = q / 96, nb = q % 96;
                tr_item(INP(IN_AWIN) + (size_t)li * 1024 * 3072, 3072, 64 * kb, 32 * nb, Wb + W_AIN + (size_t)li * 3072 * 1024, 1024, qkv_phys_row(32 * nb), scr, lane, INP(IN_GMIX) + 3 * li * D); continue; } r -= 2 * I_AIN;
            if (r < 2 * I_SQ) { const int li = r / I_SQ, q = r % I_SQ, kb = q / 32, nb = q % 32;
                tr_item(INP(IN_AWOUT) + (size_t)li * 1024 * 1024, 1024, 64 * kb, 32 * nb, Wb + W_AOUT + (size_t)li * 1024 * 1024, 1024, 32 * nb, scr, lane); continue; } r -= 2 * I_SQ;
            if (r < I_BIN) { const int kb = r / 64, nb = r % 64;
                tr_item(INP(IN_BWIN), 2048, 64 * kb, 32 * nb, Wb + W_BIN, 1024, 32 * nb, scr, lane, INP(IN_GMIX) + 1 * D); continue; } r -= I_BIN;
            if (r < 8 * I_G) { const int mi = r / I_G, q = r % I_G, gk = mi >> 2, blk = mi & 3, kb = q / 8, d0 = q % 8;
                const float* src = (gk == 0 ? INP(IN_BGAW) : INP(IN_BGXW)) + (size_t)blk * 256 * 256;
                tr_item(src, 256, 64 * kb, 32 * d0, Wb + W_BG, 256, (blk * 2 + (d0 >> 2)) * 256 + gk * 128 + (d0 & 3) * 32, scr, lane); continue; } r -= 8 * I_G;
            if (r < I_SQ) { const int kb = r / 32, nb = r % 32; tr_item(INP(IN_BWOUT), 1024, 64 * kb, 32 * nb, Wb + W_BOUT, 1024, 32 * nb, scr, lane); continue; } r -= I_SQ;
            if (r < I_AIN) { const int kb = r / 96, nb = r % 96; tr_item(INP(IN_CWIN), 3072, 64 * kb, 32 * nb, Wb + W_CIN, 1024, qkv_phys_row(32 * nb), scr, lane, INP(IN_GMIX) + 2 * D); continue; } r -= I_AIN;
            if (r < I_SQ) { const int kb = r / 32, nb = r % 32; tr_item(INP(IN_CWOUT), 1024, 64 * kb, 32 * nb, Wb + W_COUT, 1024, 32 * nb, scr, lane); continue; } r -= I_SQ;
            if (r < 4 * I_1) { const int li = r / I_1, q = r % I_1, kb = q / 128, nb = q % 128;
                tr_item(INP(IN_W1) + (size_t)li * 1024 * 4096, 4096, 64 * kb, 32 * nb, Wb + W_1 + (size_t)li * 4096 * 1024, 1024, 32 * nb, scr, lane, INP(IN_GMLP) + li * D); continue; } r -= 4 * I_1;
            { const int li = r / I_2, q = r % I_2, kb = q / 32, nb = q % 32;
                tr_item(INP(IN_W2) + (size_t)li * 4096 * 1024, 1024, 64 * kb, 32 * nb, Wb + W_2 + (size_t)li * 1024 * 4096, 4096, 32 * nb, scr, lane); }
        }
        for (int i = gt; i < (SEQ + DSEQ) * 32; i += NGT) { const int tp = i >> 5, d = i & 31; const int pos = tp < SEQ ? tp : PAST + (tp - SEQ);
            const float ang = (float)pos * ap->rope_inv[d];
            ROPE[(size_t)tp * 64 + d] = cosf(ang); ROPE[(size_t)tp * 64 + 32 + d] = sinf(ang); }
        for (int i = gt; i < D; i += NGT) { const float lm = INP(IN_BLAM)[i]; SP8[i] = 8.0f * (fmaxf(-lm, 0.f) + log1pf(expf(-fabsf(lm)))); }
        for (int m0 = gw; m0 < MT; m0 += 2 * NGW) {
            f32x4 v[2][4];
#pragma unroll
            for (int k = 0; k < 2; ++k) { const int mrow = m0 + k * NGW;
                if (mrow < MT) { const float* src = mrow < MP ? INP(IN_XP) + (size_t)mrow * D : INP(IN_XS) + (size_t)(mrow - MP) * D;
#pragma unroll
                    for (int j = 0; j < 4; ++j) v[k][j] = ((const f32x4*)src + lane)[64 * j]; } }
#pragma unroll
            for (int k = 0; k < 2; ++k) { const int mrow = m0 + k * NGW;
                if (mrow < MT) { float s = 0.f;
#pragma unroll
                    for (int j = 0; j < 4; ++j) s += (v[k][j].x * v[k][j].x + v[k][j].y * v[k][j].y) + (v[k][j].z * v[k][j].z + v[k][j].w * v[k][j].w);
                    const float tot = wave_sum(s);
                    if (lane < 16) SSQ1[(size_t)mrow * 16 + lane] = lane == 0 ? tot : 0.f;
                    unsigned long long* o8 = (unsigned long long*)(XN + (size_t)mrow * D) + lane;
#pragma unroll
                    for (int j = 0; j < 4; ++j) o8[64 * j] = (unsigned long long)cvt_pk_bf16(v[k][j].x, v[k][j].y) | ((unsigned long long)cvt_pk_bf16(v[k][j].z, v[k][j].w) << 32); } }
        }
        SEAM();
            REP_END
    }

    for (int L = 0; L < 4; ++L) {
        const int kind = L % 3, idx = L / 3, base = 1 + 16 * L;
        if (kind == 0) {
            if (EN(1) && RUN(base + 0)) {
            REP_BEGIN(1)
            PHASE_PTRS
                pg8::Gemm g{XN, Wb + W_AIN + (size_t)idx * 3072 * 1024, MP, 3072, 1024, 0, 0}; pg8::StaticOrder S; S.init(MP, 3072, pG, pbx);
                pg8::EpiQKV<true> E{Qb, ACT_BF / 2, INP(IN_AQG) + idx * 64, INP(IN_AKG) + idx * 64, ROPE,
                    out + OUT_AKP + (size_t)idx * MP * D, out + OUT_AKS + (size_t)idx * MS * D, OUT_AVP - OUT_AKP, OUT_AVS - OUT_AKS, 0, (const LAS float*)(ldsp + RS_OFF)};
                fill_row_factors(ldsp, S, SSQ1, ptid);
                pg8::gemm_phase<pg8::EpiQKV<true>, pg8::StaticOrder, true, true>(ldsp + RING_OFF, g, S, E, ptid);
                { SkQKV<true> F{Qb, ACT_BF / 2, INP(IN_AQG) + idx * 64, INP(IN_AKG) + idx * 64, ROPE, out + OUT_AKS + (size_t)idx * MS * D, OUT_AVS - OUT_AKS, SSQ1};
                  skinny_gemm(ldsp + RING_OFF, XN + (size_t)MP * D, D, Wb + W_AIN + (size_t)idx * 3072 * 1024, 1024, 48, F, vcu, pG, wave, lane); }
                SEAM();
            REP_END
            }
            if (EN(2) && RUN(base + 1)) {
            REP_BEGIN(2)
            PHASE_PTRS
                const float* lp = INP(IN_ALAM) + idx * 256;
                const float s1 = wave_sum(lp[lane] * lp[64 + lane]), s2 = wave_sum(lp[128 + lane] * lp[192 + lane]);
                const float lam_init = ap->lam_init[idx], lam = expf(s1) - expf(s2) + lam_init;
                {
                    asm volatile("s_waitcnt vmcnt(0) lgkmcnt(0)" ::: "memory"); __syncthreads();
                    int ptid2 = ptid; asm volatile("" : "+v"(ptid2));
                    const attn_body::bf16* Qa = (const attn_body::bf16*)Qb; const attn_body::bf16* Ka = (const attn_body::bf16*)Kb; const attn_body::bf16* Va = (const attn_body::bf16*)Vb;
                    attn_body::bf16* O4 = (attn_body::bf16*)(ws + WS_H);
                    const float* sg = INP(IN_ASUB) + idx * 128;
                    const int ngrp = NB * 8 * 8, nper = (ngrp + pG - 1) / pG;
                    const int lane2 = ptid2 & 63;
                    const int dslot = vcu % (nper + 1);
                    for (int gj = 0; gj <= nper; ++gj) {
                        if (gj == dslot) {
                            int dl = lane2; asm volatile("" : "+v"(dl));
                            const int g4 = dl >> 4, c16 = dl & 15;
                            for (int item = gw; item < 128 * NSPLIT; item += NGW) {
                                const int bh = item / NSPLIT, sp = item % NSPLIT, b = bh >> 3, h = bh & 7;
                                AttnItem it; it.q = Qb + (size_t)(MP + b * 16) * D + h * 128;
                                it.kc = INP(IN_CAK) + ((size_t)(idx * NB + b) * PAST) * D + h * 128; it.vc = INP(IN_CAV) + ((size_t)(idx * NB + b) * PAST) * D + h * 128;
                                it.kn = Kb + (size_t)(MP + b * 16) * D + h * 128; it.vn = Vb + (size_t)(MP + b * 16) * D + h * 128; it.btab = nullptr;
                                it.cstride = D; it.n_cache = PAST; it.k_lo = sp * 256; it.k_hi = (sp == NSPLIT - 1) ? PAST + 32 : (sp + 1) * 256; it.n_total = PAST + DSEQ; it.rel0 = 0; it.head = 0;
                                float m[2], l[2]; f32x4 o[2][8];
                                attn16_core<2, 128>(it, dl, m, l, o);
#pragma unroll
                                for (int c = 0; c < 2; ++c) { float* po = PO + (((size_t)item * 2 + c) * 16 + c16) * 128 + 4 * g4;
#pragma unroll
                                    for (int e = 0; e < 8; ++e) *(f32x4*)(po + e * 16) = o[c][e];
                                    if (g4 == 0) { float* pm = PML + (((size_t)item * 2 + c) * 16 + c16) * 2; pm[0] = m[c]; pm[1] = l[c]; } }
                            }
                            asm volatile("s_waitcnt vmcnt(0) lgkmcnt(0)" ::: "memory"); __syncthreads();
                        }
                        const int gid = vcu * nper + gj; if (gj >= nper || gid >= ngrp) continue;
                        int ln3 = lane2; asm volatile("" : "+v"(ln3));
                        const int ptid3 = wave * 64 + ln3, csub = ln3 & 7, cvh = csub >> 2, cd0 = (csub & 3) * 16, crr = ln3 >> 3;
                        const int bh = gid >> 3, sel = (gid >> 2) & 1, jq = gid & 3, b = bh >> 3, h = bh & 7;
                        const int qb = sel == 0 ? (jq == 0 ? 0 : (jq == 1 ? 7 : (jq == 2 ? 2 : 5))) : (jq == 0 ? 1 : (jq == 1 ? 6 : (jq == 2 ? 3 : 4)));
                        for (int c = 0; c < 2; ++c)
                            attn_body::attn_unit<8, 63, 2048, 0, 1>(b, h * 2 + c, h * 2, h * 4 + c * 2, qb, Qa, Ka, Va, O4, (char*)lds + RING_OFF, ptid3, nullptr);
                        asm volatile("s_waitcnt vmcnt(0)" ::: "memory");
                        const bf16_t* O4r = (const bf16_t*)O4;
                        float gg[16];
#pragma unroll
                        for (int i = 0; i < 16; ++i) gg[i] = sg[cvh * 64 + cd0 + i] * (1.0f - lam_init);
                        u32x4 ra[4][4];
#pragma unroll
                        for (int ps = 0; ps < 4; ++ps) {
                            const int row = b * SEQ + qb * 256 + wave * 32 + ps * 8 + crr;
                            const bf16_t* p0 = O4r + (size_t)row * 2048 + (h * 4 + cvh) * 64 + cd0; const bf16_t* p1 = p0 + 128;
                            ra[ps][0] = *(const u32x4*)p0; ra[ps][1] = *(const u32x4*)(p0 + 8); ra[ps][2] = *(const u32x4*)p1; ra[ps][3] = *(const u32x4*)(p1 + 8); }
#pragma unroll
                        for (int ps = 0; ps < 4; ++ps) {
                            const int row = b * SEQ + qb * 256 + wave * 32 + ps * 8 + crr;
                            const u32x4 a0 = ra[ps][0], a1 = ra[ps][1], b0 = ra[ps][2], b1 = ra[ps][3];
                            float o[16]; float ss = 0.f;
#pragma unroll
                            for (int i = 0; i < 16; ++i) { const unsigned wa = i < 8 ? a0[(i >> 1) & 3] : a1[(i >> 1) & 3], wb = i < 8 ? b0[(i >> 1) & 3] : b1[(i >> 1) & 3];
                                const float fa = bf2f((unsigned short)((i & 1) ? (wa >> 16) : (wa & 0xffffu))), fb = bf2f((unsigned short)((i & 1) ? (wb >> 16) : (wb & 0xffffu)));
                                o[i] = fa - lam * fb; ss += o[i] * o[i]; }
                            ss += swz_xor<1>(ss); ss += swz_xor<2>(ss); ss += swz_xor<4>(ss);
                            const float rs = 1.0f / sqrtf(ss * (1.0f / 128.0f) + EPS);
                            float y0[8], y1[8];
#pragma unroll
                            for (int i = 0; i < 8; ++i) { y0[i] = o[i] * rs * gg[i]; y1[i] = o[8 + i] * rs * gg[8 + i]; }
                            bf16_t* op = ON + (size_t)row * D + h * 128 + cvh * 64 + cd0;
                            *(u32x4*)op = pg8::pack8(y0); *(u32x4*)(op + 8) = pg8::pack8(y1);
                        }
                    }
                }
                SEAM();
            REP_END
            }
            if (EN(3) && RUN(base + 2)) {
            REP_BEGIN(3)
            PHASE_PTRS
                const float* lp = INP(IN_ALAM) + idx * 256;
                const float s1 = wave_sum(lp[lane] * lp[64 + lane]), s2 = wave_sum(lp[128 + lane] * lp[192 + lane]);
                const float lam_init = ap->lam_init[idx], lam = expf(s1) - expf(s2) + lam_init;
                const float* sg = INP(IN_ASUB) + idx * 128;
                for (int id = gw; id < MS * 8; id += NGW) {
                    const int s = id >> 3, h = id & 7, b = s >> 4, q = s & 15, bh = b * 8 + h;
                    f32x2 oc[2];
#pragma unroll
                    for (int c = 0; c < 2; ++c) {
                        f32x2 ml[NSPLIT], pv[NSPLIT];
#pragma unroll
                        for (int sp = 0; sp < NSPLIT; ++sp) { const size_t pi = (((size_t)bh * NSPLIT + sp) * 2 + c) * 16 + q; ml[sp] = *(const f32x2*)(PML + pi * 2); pv[sp] = *(const f32x2*)(PO + pi * 128 + 2 * lane); }
                        __builtin_amdgcn_sched_barrier(0);
                        float mx = -1e30f;
#pragma unroll
                        for (int sp = 0; sp < NSPLIT; ++sp) mx = fmaxf(mx, ml[sp].x);
                        float lt = 0.f; f32x2 acc = (f32x2){0.f, 0.f};
#pragma unroll
                        for (int sp = 0; sp < NSPLIT; ++sp) { const float w = __builtin_amdgcn_exp2f(ml[sp].x - mx); lt += ml[sp].y * w; acc = acc + pv[sp] * w; }
                        oc[c] = acc * (1.0f / lt);
                    }
                    const f32x2 ov = oc[0] - oc[1] * lam;
                    const float ss = wave_sum(ov.x * ov.x + ov.y * ov.y);
                    const float rs = (1.0f - lam_init) / sqrtf(ss * (1.0f / 128.0f) + EPS);
                    const f32x2 gg = *(const f32x2*)(sg + 2 * lane);
                    *(unsigned*)(ON + (size_t)(MP + s) * D + h * 128 + 2 * lane) = cvt_pk_bf16(ov.x * rs * gg.x, ov.y * rs * gg.y);
                }
                SEAM();
            REP_END
            }
            if (EN(4) && RUN(base + 3)) {
            REP_BEGIN(4)
            PHASE_PTRS
                pg8::Gemm g{ON, Wb + W_AOUT + (size_t)idx * 1024 * 1024, MP, 1024, 1024, 0, 0}; const bf16_t* skA = ON + (size_t)MP * D; const bf16_t* skB = Wb + W_AOUT + (size_t)idx * 1024 * 1024; const int skK = 1024; pg8::StaticOrder S; S.init(MP, 1024, pG, pbx);
                pg8::EpiResAdd E{XN, nullptr, nullptr, SSQ0};
                pg8::gemm_phase<pg8::EpiResAdd, pg8::StaticOrder, true, true>(ldsp + RING_OFF, g, S, E, ptid);
                { SkResAdd F{XN, nullptr, nullptr, SSQ0}; skinny_gemm(ldsp + RING_OFF, skA, skK, skB, skK, 16, F, vcu, pG, wave, lane); }
                SEAM();
            REP_END
            }
        } else if (kind == 1) {
            if (EN(5) && RUN(base + 0)) {
            REP_BEGIN(5)
            PHASE_PTRS
                pg8::Gemm g{XN, Wb + W_BIN, MP, 2048, 1024, 0, 0}; pg8::StaticOrder S; S.init(MP, 2048, pG, pbx);
                pg8::EpiBin E{Gb, Ub, INP(IN_BBIN), out + OUT_BCP, out + OUT_BCS, (const LAS float*)(ldsp + RS_OFF)};
                fill_row_factors(ldsp, S, SSQ1, ptid);
                pg8::gemm_phase<pg8::EpiBin, pg8::StaticOrder, true, true>(ldsp + RING_OFF, g, S, E, ptid);
                { SkBin F{Gb, Ub, INP(IN_BBIN), out + OUT_BCS, SSQ1}; skinny_gemm(ldsp + RING_OFF, XN + (size_t)MP * D, D, Wb + W_BIN, 1024, 32, F, vcu, pG, wave, lane); }
                SEAM();
            REP_END
            }
            if (EN(6) && RUN(base + 1)) {
            REP_BEGIN(6)
            PHASE_PTRS
                const float* cw = INP(IN_BCW); const float* cb = INP(IN_BCB); const float* hist = INP(IN_SBC);
                const int ch0 = (gt & 127) * 8;
                float wj[4][8], bs[8];
#pragma unroll
                for (int c = 0; c < 8; ++c) { bs[c] = cb[ch0 + c];
#pragma unroll
                    for (int jj = 0; jj < 4; ++jj) wj[jj][c] = cw[jj * D + ch0 + c]; }
                for (int rbk = gt >> 7; rbk < MT / 16; rbk += NGT >> 7) {
                    const int row0 = rbk * 16; const bool pr = row0 < MP; const int t0 = pr ? (row0 & (SEQ - 1)) : 0; const int b = pr ? (row0 >> 11) : ((row0 - MP) >> 4);
                    u32x4 wr_[19];
#pragma unroll
                    for (int r = 0; r < 16; ++r) wr_[3 + r] = *(const u32x4*)(Ub + (size_t)(row0 + r) * D + ch0);
                    float um[3][8];
                    if (t0 > 0) {
#pragma unroll
                        for (int k = 0; k < 3; ++k) { const u32x4 w = *(const u32x4*)(Ub + (size_t)(row0 - 3 + k) * D + ch0);
                            um[k][0] = bf2f(w.x & 0xffff); um[k][1] = bf2f(w.x >> 16); um[k][2] = bf2f(w.y & 0xffff); um[k][3] = bf2f(w.y >> 16); um[k][4] = bf2f(w.z & 0xffff); um[k][5] = bf2f(w.z >> 16); um[k][6] = bf2f(w.w & 0xffff); um[k][7] = bf2f(w.w >> 16); }
                    } else if (!pr) {
#pragma unroll
                        for (int k = 0; k < 3; ++k) { const float* hp = hist + (size_t)(b * 3 + k) * D + ch0;
#pragma unroll
                            for (int c = 0; c < 8; ++c) um[k][c] = hp[c]; }
                    } else {
#pragma unroll
                        for (int k = 0; k < 3; ++k)
#pragma unroll
                            for (int c = 0; c < 8; ++c) um[k][c] = 0.f;
                    }
#pragma unroll
                    for (int r = 0; r < 16; ++r) { const u32x4 w = wr_[3 + r]; float u0[8], acc[8];
                        u0[0] = bf2f(w.x & 0xffff); u0[1] = bf2f(w.x >> 16); u0[2] = bf2f(w.y & 0xffff); u0[3] = bf2f(w.y >> 16); u0[4] = bf2f(w.z & 0xffff); u0[5] = bf2f(w.z >> 16); u0[6] = bf2f(w.w & 0xffff); u0[7] = bf2f(w.w >> 16);
#pragma unroll
                        for (int c = 0; c < 8; ++c) { acc[c] = bs[c] + um[0][c] * wj[0][c] + um[1][c] * wj[1][c] + um[2][c] * wj[2][c] + u0[c] * wj[3][c]; um[0][c] = um[1][c]; um[1][c] = um[2][c]; um[2][c] = u0[c]; }
                        *(u32x4*)(XCB + ((size_t)(ch0 >> 8) * MT + row0 + r) * 256 + (ch0 & 255)) = pg8::pack8(acc); }
                }
                SEAM();
            REP_END
            }
            if (EN(7) && RUN(base + 2)) {
            REP_BEGIN(7)
            PHASE_PTRS
                pg8::Gemm g{XCB, Wb + W_BG, MP, 2048, 256, 1, (size_t)MT * 256 * 2}; pg8::StaticOrder S; S.init(MP, 2048, pG, pbx);
                pg8::EpiGates E{XCB, INP(IN_BGAB), INP(IN_BGXB), SP8, (bf16_t*)AA, (bf16_t*)BB};
                pg8::gemm_phase<pg8::EpiGates, pg8::StaticOrder, true, true>(ldsp + RING_OFF, g, S, E, ptid);
                { SkGates F{XCB, INP(IN_BGAB), INP(IN_BGXB), SP8, (bf16_t*)AA, (bf16_t*)BB}; skinny_gemm(ldsp + RING_OFF, XCB + (size_t)MP * 256, 256, Wb + W_BG, 256, 32, F, vcu, pG, wave, lane); }
                SEAM();
            REP_END
            }
            if (EN(8) && RUN(base + 3)) {
            REP_BEGIN(8)
            PHASE_PTRS
            const bf16_t* const LAq = (const bf16_t*)AA; const bf16_t* const BQq = (const bf16_t*)BB;
                for (int id = gw; id < NB * 32 * 4; id += NGW) {
                    const int cq = id & 3, ck = (id >> 2) & 31, b = id >> 7, ch = cq * 256 + lane * 4; const size_t r0 = (size_t)(b * SEQ + ck * 64) * D + ch;
                    f32x4 P = (f32x4){1.f, 1.f, 1.f, 1.f}, Hc = (f32x4){0.f, 0.f, 0.f, 0.f};
                    for (int t0 = 0; t0 < 64; t0 += 16) { u32x2 a[16], bb[16];
#pragma unroll
                        for (int j = 0; j < 16; ++j) { a[j] = *(const u32x2*)(LAq + r0 + (size_t)(t0 + j) * D); bb[j] = *(const u32x2*)(BQq + r0 + (size_t)(t0 + j) * D); }
                        __builtin_amdgcn_sched_barrier(0);
#pragma unroll
                        for (int j = 0; j < 16; ++j) {
                            const f32x4 la = (f32x4){bf2f(a[j].x & 0xffff), bf2f(a[j].x >> 16), bf2f(a[j].y & 0xffff), bf2f(a[j].y >> 16)};
                            const f32x4 bv = (f32x4){bf2f(bb[j].x & 0xffff), bf2f(bb[j].x >> 16), bf2f(bb[j].y & 0xffff), bf2f(bb[j].y >> 16)};
                            const f32x4 av = (f32x4){__expf(la.x), __expf(la.y), __expf(la.z), __expf(la.w)};
                            P = P * av; Hc = av * Hc + bv; }
                        __builtin_amdgcn_sched_barrier(0); }
                    *(f32x4*)(CP + (size_t)(b * 32 + ck) * D + ch) = P; *(f32x4*)(CH + (size_t)(b * 32 + ck) * D + ch) = Hc;
                }
                SEAM();
            REP_END
            }
            if (EN(9) && RUN(base + 4)) {
            REP_BEGIN(9)
            PHASE_PTRS
            const bf16_t* const LAq = (const bf16_t*)AA; const bf16_t* const BQq = (const bf16_t*)BB;
                for (int id = gw; id < NB * 32 * 4; id += NGW) {
                    const int cq = id & 3, ck = (id >> 2) & 31, b = id >> 7, ch = cq * 256 + lane * 4; const size_t r0 = (size_t)(b * SEQ + ck * 64) * D + ch;
                    f32x4 h = (f32x4){0.f, 0.f, 0.f, 0.f};
                    for (int k0 = 0; k0 < ck; k0 += 8) {
                        f32x4 cp[8], chh[8];
#pragma unroll
                        for (int j = 0; j < 8; ++j) { const int kk = (k0 + j) < 32 ? (k0 + j) : 31; cp[j] = *(const f32x4*)(CP + (size_t)(b * 32 + kk) * D + ch); chh[j] = *(const f32x4*)(CH + (size_t)(b * 32 + kk) * D + ch); }
                        __builtin_amdgcn_sched_barrier(0);
#pragma unroll
                        for (int j = 0; j < 8; ++j) if (k0 + j < ck) h = cp[j] * h + chh[j];
                        __builtin_amdgcn_sched_barrier(0); }
                    for (int t0 = 0; t0 < 64; t0 += 8) { u32x2 a[8], bb[8], gg[8];
#pragma unroll
                        for (int j = 0; j < 8; ++j) { a[j] = *(const u32x2*)(LAq + r0 + (size_t)(t0 + j) * D); bb[j] = *(const u32x2*)(BQq + r0 + (size_t)(t0 + j) * D); gg[j] = *(const u32x2*)(Gb + r0 + (size_t)(t0 + j) * D); }
                        __builtin_amdgcn_sched_barrier(0);
#pragma unroll
                        for (int j = 0; j < 8; ++j) {
                            const f32x4 la = (f32x4){bf2f(a[j].x & 0xffff), bf2f(a[j].x >> 16), bf2f(a[j].y & 0xffff), bf2f(a[j].y >> 16)};
                            const f32x4 bv = (f32x4){bf2f(bb[j].x & 0xffff), bf2f(bb[j].x >> 16), bf2f(bb[j].y & 0xffff), bf2f(bb[j].y >> 16)};
                            const f32x4 gv = (f32x4){bf2f(gg[j].x & 0xffff), bf2f(gg[j].x >> 16), bf2f(gg[j].y & 0xffff), bf2f(gg[j].y >> 16)};
                            const f32x4 av = (f32x4){__expf(la.x), __expf(la.y), __expf(la.z), __expf(la.w)};
                            h = av * h + bv; const f32x4 y = h * gv;
                            u32x2 w; w.x = cvt_pk_bf16(y.x, y.y); w.y = cvt_pk_bf16(y.z, y.w); *(u32x2*)(HG + r0 + (size_t)(t0 + j) * D) = w; } }
                    if (ck == 31) *(f32x4*)(out + OUT_BHP + (size_t)b * D + ch) = h;
                }
                for (int id = gw; id < NB * 4; id += NGW) {
                    const int cq = id & 3, b = id >> 2, ch = cq * 256 + lane * 4; const size_t r0 = (size_t)(MP + b * DSEQ) * D + ch;
                    f32x4 h = *(const f32x4*)(INP(IN_SBH) + (size_t)b * D + ch);
                    u32x2 sa[DSEQ], sb[DSEQ], sg[DSEQ];
#pragma unroll
                    for (int j = 0; j < DSEQ; ++j) { sa[j] = *(const u32x2*)(LAq + r0 + (size_t)j * D); sb[j] = *(const u32x2*)(BQq + r0 + (size_t)j * D); sg[j] = *(const u32x2*)(Gb + r0 + (size_t)j * D); }
                    __builtin_amdgcn_sched_barrier(0);
#pragma unroll
                    for (int j = 0; j < DSEQ; ++j) { const u32x2 a = sa[j], bb = sb[j], gg = sg[j];
                        const f32x4 av = (f32x4){__expf(bf2f(a.x & 0xffff)), __expf(bf2f(a.x >> 16)), __expf(bf2f(a.y & 0xffff)), __expf(bf2f(a.y >> 16))};
                        const f32x4 bv = (f32x4){bf2f(bb.x & 0xffff), bf2f(bb.x >> 16), bf2f(bb.y & 0xffff), bf2f(bb.y >> 16)};
                        const f32x4 gv = (f32x4){bf2f(gg.x & 0xffff), bf2f(gg.x >> 16), bf2f(gg.y & 0xffff), bf2f(gg.y >> 16)};
                        h = av * h + bv; const f32x4 y = h * gv; u32x2 w; w.x = cvt_pk_bf16(y.x, y.y); w.y = cvt_pk_bf16(y.z, y.w); *(u32x2*)(HG + r0 + (size_t)j * D) = w; }
                    *(f32x4*)(out + OUT_BHS + (size_t)b * D + ch) = h;
                }
                SEAM();
            REP_END
            }
            if (EN(10) && RUN(base + 5)) {
            REP_BEGIN(10)
            PHASE_PTRS
                pg8::Gemm g{HG, Wb + W_BOUT, MP, 1024, 1024, 0, 0}; const bf16_t* skA = HG + (size_t)MP * D; const bf16_t* skB = Wb + W_BOUT; const int skK = 1024; pg8::StaticOrder S; S.init(MP, 1024, pG, pbx);
                pg8::EpiResAdd E{XN, nullptr, nullptr, SSQ0};
                pg8::gemm_phase<pg8::EpiResAdd, pg8::StaticOrder, true, true>(ldsp + RING_OFF, g, S, E, ptid);
                { SkResAdd F{XN, nullptr, nullptr, SSQ0}; skinny_gemm(ldsp + RING_OFF, skA, skK, skB, skK, 16, F, vcu, pG, wave, lane); }
                SEAM();
            REP_END
            }
        } else {
            if (EN(11) && RUN(base + 0)) {
            REP_BEGIN(11)
            PHASE_PTRS
                pg8::Gemm g{XN, Wb + W_CIN, MP, 3072, 1024, 0, 0}; pg8::StaticOrder S; S.init(MP, 3072, pG, pbx);
                pg8::EpiQKV<false> E{Qb, ACT_BF / 2, INP(IN_CQG), INP(IN_CKG), ROPE, out + OUT_CKP, out + OUT_CKS, OUT_CVP - OUT_CKP, OUT_CVS - OUT_CKS, SEQ - CWIN, (const LAS float*)(ldsp + RS_OFF)};
                fill_row_factors(ldsp, S, SSQ1, ptid);
                pg8::gemm_phase<pg8::EpiQKV<false>, pg8::StaticOrder, true, true>(ldsp + RING_OFF, g, S, E, ptid);
                { SkQKV<false> F{Qb, ACT_BF / 2, INP(IN_CQG), INP(IN_CKG), ROPE, out + OUT_CKS, OUT_CVS - OUT_CKS, SSQ1};
                  skinny_gemm(ldsp + RING_OFF, XN + (size_t)MP * D, D, Wb + W_CIN, 1024, 48, F, vcu, pG, wave, lane); }
                SEAM();
            REP_END
            }
            if (EN(12) && RUN(base + 1)) {
            REP_BEGIN(12)
            PHASE_PTRS
                const int g4 = lane >> 4, c16 = lane & 15; const float* tab = INP(IN_CBIAS);
                if (vcu < NB * 16) {
                    const int b = vcu >> 4, h = vcu & 15;
                    AttnItem it; it.q = Qb + (size_t)(MP + b * 16) * D + h * 64;
                    it.kc = INP(IN_CCK) + ((size_t)b * CWIN) * D + h * 64; it.vc = INP(IN_CCV) + ((size_t)b * CWIN) * D + h * 64;
                    it.kn = Kb + (size_t)(MP + b * 16) * D + h * 64; it.vn = Vb + (size_t)(MP + b * 16) * D + h * 64; it.btab = tab;
                    it.cstride = D; it.n_cache = CWIN; it.k_lo = 64 * wave; it.k_hi = 64 * (wave + 1) + (wave == NWAVES - 1 ? 32 : 0); it.n_total = CWIN + DSEQ; it.rel0 = CWIN; it.head = h;
                    float m[1], l[1]; f32x4 o[1][4];
                    attn16_core<1, 64>(it, lane, m, l, o);
                    LAS float* px = (LAS float*)(ldsp + RING_OFF); LAS float* pml = px + NWAVES * 1024;
#pragma unroll
                    for (int e = 0; e < 4; ++e) *(LAS f32x4*)(px + wave * 1024 + lane * 16 + e * 4) = o[0][e];
                    if (g4 == 0) { pml[(wave * 16 + c16) * 2] = m[0]; pml[(wave * 16 + c16) * 2 + 1] = l[0]; }
                    asm volatile("s_waitcnt lgkmcnt(0)" ::: "memory"); __syncthreads();
                    if (wave == 0) {
                        float mx = -1e30f;
#pragma unroll
                        for (int w = 0; w < NWAVES; ++w) mx = fmaxf(mx, pml[(w * 16 + c16) * 2]);
                        float lt = 0.f; f32x4 acc[4];
#pragma unroll
                        for (int e = 0; e < 4; ++e) acc[e] = (f32x4){0.f, 0.f, 0.f, 0.f};
#pragma unroll
                        for (int w = 0; w < NWAVES; ++w) { const float sc = __builtin_amdgcn_exp2f(pml[(w * 16 + c16) * 2] - mx); lt += pml[(w * 16 + c16) * 2 + 1] * sc;
#pragma unroll
                            for (int e = 0; e < 4; ++e) acc[e] = acc[e] + *(const LAS f32x4*)(px + w * 1024 + lane * 16 + e * 4) * sc; }
                        const float il = 1.0f / lt; bf16_t* orow = ON + (size_t)(MP + b * 16 + c16) * D + h * 64 + 4 * g4;
#pragma unroll
                        for (int e = 0; e < 4; ++e) { const f32x4 v = acc[e] * il; u32x2 w; w.x = cvt_pk_bf16(v.x, v.y); w.y = cvt_pk_bf16(v.z, v.w); *(u32x2*)(orow + e * 16) = w; }
                    }
                }
                {
                    asm volatile("s_waitcnt vmcnt(0) lgkmcnt(0)" ::: "memory"); __syncthreads();
                    int ptid2 = ptid; asm volatile("" : "+v"(ptid2));
                    LAS float* tb = (LAS float*)(ldsp + RING_OFF + attn_body::ATTN_LDS_BYTES);
                    for (int i = ptid2; i < 16 * NTAB; i += NWAVES * 64) { const int hh = i / NTAB, r = i % NTAB; tb[hh * 260 + r] = (tab[r * 16 + hh] - tab[256 * 16 + hh]) * LOG2E; }
                    asm volatile("s_waitcnt vmcnt(0) lgkmcnt(0)" ::: "memory"); __syncthreads();
                    const attn_body::bf16* Qa = (const attn_body::bf16*)Qb; const attn_body::bf16* Ka = (const attn_body::bf16*)Kb; const attn_body::bf16* Va = (const attn_body::bf16*)Vb;
                    const int nper = (NB * 16 * 8 + pG - 1) / pG;
                    for (int ui = vcu * nper; ui < (vcu + 1) * nper && ui < NB * 16 * 8; ++ui) {
                        const int bh = ui >> 3, qb = 7 - (ui & 7), b = bh >> 4, h = bh & 15;
                        attn_body::attn_unit<8, 63, 1024, 1, 0>(b, h, h, h, qb, Qa, Ka, Va, (attn_body::bf16*)ON, (char*)lds + RING_OFF, ptid2, tb + h * 260);
                    }
                }
                SEAM();
            REP_END
            }
            if (EN(13) && RUN(base + 2)) {
            REP_BEGIN(13)
            PHASE_PTRS
                pg8::Gemm g{ON, Wb + W_COUT, MP, 1024, 1024, 0, 0}; const bf16_t* skA = ON + (size_t)MP * D; const bf16_t* skB = Wb + W_COUT; const int skK = 1024; pg8::StaticOrder S; S.init(MP, 1024, pG, pbx);
                pg8::EpiResAdd E{XN, nullptr, nullptr, SSQ0};
                pg8::gemm_phase<pg8::EpiResAdd, pg8::StaticOrder, true, true>(ldsp + RING_OFF, g, S, E, ptid);
                { SkResAdd F{XN, nullptr, nullptr, SSQ0}; skinny_gemm(ldsp + RING_OFF, skA, skK, skB, skK, 16, F, vcu, pG, wave, lane); }
                SEAM();
            REP_END
            }
        }
        if (EN(15) && RUN(base + 9)) {
            REP_BEGIN(15)
            PHASE_PTRS
            pg8::Gemm g{XN, Wb + W_1 + (size_t)L * 4096 * 1024, MP, FF, 1024, 0, 0}; pg8::StaticOrder S; S.init(MP, FF, pG, pbx);
            pg8::EpiRelu2 E{Hb, FF, (const LAS float*)(ldsp + RS_OFF)};
            fill_row_factors(ldsp, S, SSQ0, ptid);
            pg8::gemm_phase<pg8::EpiRelu2, pg8::StaticOrder, true, true>(ldsp + RING_OFF, g, S, E, ptid);
            { SkRelu2 F{Hb, SSQ0}; skinny_gemm(ldsp + RING_OFF, XN + (size_t)MP * D, D, Wb + W_1 + (size_t)L * 4096 * 1024, 1024, 64, F, vcu, pG, wave, lane); }
            SEAM();
            REP_END
        }
        if (EN(16) && RUN(base + 10)) {
            REP_BEGIN(16)
            PHASE_PTRS
            pg8::Gemm g{Hb, Wb + W_2 + (size_t)L * 1024 * 4096, MP, 1024, FF, 0, 0}; const bf16_t* skA = Hb + (size_t)MP * FF; const bf16_t* skB = Wb + W_2 + (size_t)L * 1024 * 4096; const int skK = FF; pg8::StaticOrder S; S.init(MP, 1024, pG, pbx);
            pg8::EpiResAdd E{XN, nullptr, nullptr, SSQ1};
            pg8::gemm_phase<pg8::EpiResAdd, pg8::StaticOrder, true, true>(ldsp + RING_OFF, g, S, E, ptid);
                { SkResAdd F{XN, nullptr, nullptr, SSQ1}; skinny_gemm(ldsp + RING_OFF, skA, skK, skB, skK, 16, F, vcu, pG, wave, lane); }
            SEAM();
            REP_END
        }
        if (EN(17) && RUN(base + 11)) {
            REP_BEGIN(17)
            PHASE_PTRS
            if (L == 3) {
                const float* gf = INP(IN_GFIN);
                f32x4 g0[2], g1[2];
#pragma unroll
                for (int hh = 0; hh < 2; ++hh) { g0[hh] = *(const f32x4*)(gf + hh * 512 + lane * 8); g1[hh] = *(const f32x4*)(gf + hh * 512 + lane * 8 + 4); }
                for (int mrow = gw; mrow < MT; mrow += NGW) {
                    const float rr = pg8::row_rstd(SSQ1, mrow);
                    float* yr = out + (mrow < MP ? OUT_YP + (size_t)mrow * D : OUT_YS + (size_t)(mrow - MP) * D);
#pragma unroll
                    for (int hh = 0; hh < 2; ++hh) { const u32x4 w = *(const u32x4*)(XN + (size_t)mrow * D + hh * 512 + lane * 8);
                        const f32x4 a = (f32x4){bf2f(w.x & 0xffff), bf2f(w.x >> 16), bf2f(w.y & 0xffff), bf2f(w.y >> 16)} * rr * g0[hh];
                        const f32x4 b = (f32x4){bf2f(w.z & 0xffff), bf2f(w.z >> 16), bf2f(w.w & 0xffff), bf2f(w.w >> 16)} * rr * g1[hh];
                        __builtin_nontemporal_store(a, (f32x4*)(yr + hh * 512 + lane * 8)); __builtin_nontemporal_store(b, (f32x4*)(yr + hh * 512 + lane * 8 + 4)); }
                }
            }
            REP_END
        }
    }
#undef RUN
#undef SEAM
}

#ifndef HOSTDUP
#define HOSTDUP 0ull
#endif
#ifndef MK_SINGLE
#define MK_SINGLE 1
#endif
static bool phase_valid(int id) {
    if (id == 0) return true;
    const int L = (id - 1) / 16, sub = (id - 1) % 16, kind = L % 3;
    if (L > 3) return false;
    if (sub >= 8) return sub == 9 || sub == 10 || (sub == 11 && L == 3);
    return sub < (kind == 0 ? 4 : (kind == 1 ? 6 : 3));
}
extern "C" void kernel_launch(void* const* d_in, const int* in_sizes, int n_in, void* d_out, int out_size, void* d_ws, size_t ws_size, hipStream_t stream) {
    static int grid = 0;
    if (grid == 0) {
        if (n_in != N_IN || (size_t)out_size != OUT_TOTAL || ws_size < WS_END || in_sizes[IN_XP] != MP * D || in_sizes[IN_CAK] != 2 * NB * PAST * D) {
            fprintf(stderr, "kernel_launch: unexpected shapes: n_in %d out %d ws %zu (need %zu)\n", n_in, out_size, ws_size, (size_t)WS_END); grid = -1; return; }
        int dev = 0, cus = 0, per_cu = 0;
        if (hipGetDevice(&dev) != hipSuccess || hipDeviceGetAttribute(&cus, hipDeviceAttributeMultiprocessorCount, dev) != hipSuccess) { fprintf(stderr, "kernel_launch: device query failed\n"); grid = -1; return; }
        if (hipFuncSetAttribute((const void*)fwd_kernel, hipFuncAttributeMaxDynamicSharedMemorySize, LDS_BYTES) != hipSuccess) { fprintf(stderr, "kernel_launch: hipFuncSetAttribute failed\n"); grid = -1; return; }
        if (hipOccupancyMaxActiveBlocksPerMultiprocessor(&per_cu, (const void*)fwd_kernel, NWAVES * 64, LDS_BYTES) != hipSuccess || per_cu < 1)
            fprintf(stderr, "kernel_launch: note: occupancy query reports %d workgroups per CU\n", per_cu);
        (void)hipGetLastError();
        grid = cus;
    }
    if (grid < 0) return;
    if (hipMemsetAsync((char*)d_ws + WS_CTL, 0, CTL_ZERO_BYTES, stream) != hipSuccess) { fprintf(stderr, "kernel_launch: memset failed\n"); return; }
    Args a{};
    for (int i = 0; i < N_IN; ++i) a.in[i] = (const GAS float*)d_in[i];
    a.out = (GAS float*)d_out; a.ws = (GAS unsigned char*)d_ws; a.dupmask = PROBE_DUP;
    for (int d = 0; d < 32; ++d) a.rope_inv[d] = (float)pow(10000.0, -(double)d / 32.0);
    a.lam_init[0] = (float)(0.8 - 0.6 * exp(-0.3 * 0.0)); a.lam_init[1] = (float)(0.8 - 0.6 * exp(-0.3 * 3.0));
    if (MK_SINGLE) {
        a.ph_lo = 0; a.ph_hi = 1 << 20; a.single = 1;
        hipLaunchKernelGGL(fwd_kernel, dim3(grid), dim3(NWAVES * 64), LDS_BYTES, stream, a);
    } else {
        for (int id = 0; id < 1 + 16 * 4; ++id) { if (!phase_valid(id)) continue;
            a.ph_lo = id; a.ph_hi = id + 1; a.single = 0;
            hipLaunchKernelGGL(fwd_kernel, dim3(grid), dim3(NWAVES * 64), LDS_BYTES, stream, a);
            if ((HOSTDUP >> id) & 1ull) hipLaunchKernelGGL(fwd_kernel, dim3(grid), dim3(NWAVES * 64), LDS_BYTES, stream, a); }
    }
    const hipError_t le = hipPeekAtLastError();
    if (le != hipSuccess) fprintf(stderr, "kernel_launch: launch failed: %s\n", hipGetErrorName(le));
}
```

```cpp
#include <hip/hip_runtime.h>
#include <cstdio>
#include <cstdint>
#include <cmath>

constexpr int D = 1024, NB = 16, SEQ = 2048, MP = NB * SEQ  , DSEQ = 16, MS = NB * DSEQ  , MT = MP + MS  ;
constexpr int PAST = 4096, FF = 4096, CWIN = 512, NTAB = 257;
constexpr float EPS = 1e-6f;
constexpr float LOG2E = 1.4426950408889634f;
constexpr float QSCALE = 0.125f * LOG2E;

namespace pg8 {
#define PG8_LAS __attribute__((address_space(3)))
typedef unsigned short bf16_t;
typedef short bf16x8 __attribute__((ext_vector_type(8)));
typedef float f32x4 __attribute__((ext_vector_type(4)));
typedef float f32x2 __attribute__((ext_vector_type(2)));
typedef unsigned u32x4 __attribute__((ext_vector_type(4)));
typedef unsigned u32x2 __attribute__((ext_vector_type(2)));
constexpr int BM = 256, BK = 64, HALF = 128, HTB = HALF * BK * 2  , STAGE_BYTES = 8 * HTB, NXCD = 8, WGM = 8;

__host__ __device__ __forceinline__ int lds_byte(int r, int c) { const int st = (r >> 4) * 2 + (c >> 5), rr = r & 15, cc = c & 31, ob = rr * 64 + cc * 2; return st * 1024 + (ob ^ (((ob >> 9) & 1) << 5)); }
__host__ __device__ __forceinline__ void stage_rc(int b, int& R, int& C) { const int st = b / 1024, sb = b % 1024, swz = sb ^ (((sb >> 9) & 1) << 5); R = (st >> 1) * 16 + swz / 64; C = (st & 1) * 32 + (swz % 64) / 2; }
__host__ __device__ __forceinline__ int perm32(int rho) { const int n = rho >> 4, i = rho & 15; return 8 * (i >> 2) + 4 * n + (i & 3); }

struct Unit { int pm, pn, ui; };
struct Gemm { const bf16_t* A; const bf16_t* Bt; int M, N, K; int a_shift; size_t a_blk;
    __device__ __forceinline__ size_t a_off(int pn) const { return (size_t)(pn >> a_shift) * a_blk; } };

struct StaticOrder {
    int nM, nN, nwg, G, c;
    __host__ __device__ void init(int M, int N, int G_, int c_) { nM = M / BM; nN = N / BM; nwg = nM * nN; G = G_; c = c_; }
    __host__ __device__ bool next(int i, Unit& u) const {
        const long L = (long)i * G + c; if (L >= nwg) return false;
        int wgid = (int)L; { const int q = nwg / NXCD, r = nwg % NXCD, xcd = wgid % NXCD, off = wgid / NXCD; wgid = (xcd < r ? xcd * (q + 1) : r * (q + 1) + (xcd - r) * q) + off; }
        const int nig = WGM * nN, gid = wgid / nig, fm = gid * WGM, gsz = (nM - fm) < WGM ? (nM - fm) : WGM;
        u.pm = fm + ((wgid % nig) % gsz); u.pn = (wgid % nig) / gsz; return true;
    }
    __device__ __forceinline__ void a_ready(const Unit&) const {}
    __device__ __forceinline__ void done(const Unit&) const {}
};

__device__ __forceinline__ unsigned cvt_pk_bf16(float lo, float hi) { typedef __bf16 bf2 __attribute__((ext_vector_type(2))); f32x2 v = {lo, hi}; bf2 b = __builtin_convertvector(v, bf2); return __builtin_bit_cast(unsigned, b); }
__device__ __forceinline__ u32x4 pack8(const float (&x)[8]) { u32x4 w; w.x = cvt_pk_bf16(x[0], x[1]); w.y = cvt_pk_bf16(x[2], x[3]); w.z = cvt_pk_bf16(x[4], x[5]); w.w = cvt_pk_bf16(x[6], x[7]); return w; }
template <int X> __device__ __forceinline__ float swz_xor(float v) { return __builtin_bit_cast(float, __builtin_amdgcn_ds_swizzle(__builtin_bit_cast(int, v), (X << 10) | 0x1F)); }
__device__ __forceinline__ float xadd32(float v) { const unsigned u = __builtin_bit_cast(unsigned, v); auto r = __builtin_amdgcn_permlane32_swap(u, u, false, false); return __builtin_bit_cast(float, (unsigned)r[0]) + __builtin_bit_cast(float, (unsigned)r[1]); }
__device__ __forceinline__ float xmax32(float v) { const unsigned u = __builtin_bit_cast(unsigned, v); auto r = __builtin_amdgcn_permlane32_swap(u, u, false, false); return fmaxf(__builtin_bit_cast(float, (unsigned)r[0]), __builtin_bit_cast(float, (unsigned)r[1])); }
__device__ __forceinline__ float bf2f(unsigned short h) { return __builtin_bit_cast(float, (unsigned)h << 16); }

__device__ __forceinline__ float row_rstd(const float* SSQ, int row) {
    const f32x4* p = (const f32x4*)(SSQ + (size_t)row * 16); const f32x4 a = (p[0] + p[1]) + (p[2] + p[3]);
    return 1.0f / sqrtf(((a.x + a.y) + (a.z + a.w)) * (1.0f / 1024.0f) + EPS); }

__device__ __forceinline__ void rows_rstd(const float* SSQ, int row0, int fq, float (&rr)[2][4]) {
    f32x4 t[2][4];
#pragma unroll
    for (int ai = 0; ai < 2; ++ai)
#pragma unroll
        for (int m = 0; m < 4; ++m) t[ai][m] = *(const f32x4*)(SSQ + (size_t)(row0 + ai * HALF + m * 16) * 16 + 4 * fq);
#pragma unroll
    for (int ai = 0; ai < 2; ++ai)
#pragma unroll
        for (int m = 0; m < 4; ++m) { float s = (t[ai][m].x + t[ai][m].y) + (t[ai][m].z + t[ai][m].w); s += swz_xor<16>(s); s = xadd32(s); rr[ai][m] = 1.0f / sqrtf(s * (1.0f / 1024.0f) + EPS); }
}
__device__ __forceinline__ void rows_rstd_lds(const PG8_LAS float* RS, const Unit& u, int rowin  , float (&rr)[2][4]) {
#pragma unroll
    for (int ai = 0; ai < 2; ++ai)
#pragma unroll
        for (int m = 0; m < 4; ++m) rr[ai][m] = RS[u.ui * 256 + ai * HALF + m * 16 + rowin];
}
template <bool ROPE> struct EpiQKV {
    static constexpr bool PERM = true, AFTER_DRAIN = false;
    bf16_t* Q; size_t qkv_stride  ; const float *qg, *kg, *rope; float *okp, *oks; size_t kvp_stride, kvs_stride  ; int t0; const PG8_LAS float* RS;
    __device__ __forceinline__ float* f32_dst(int kind, int row, int colb) const {
        float* p = nullptr;
        if (row < MP) { const int t = row & (SEQ - 1), b = row >> 11; if (t >= t0) p = okp + (size_t)(kind - 1) * kvp_stride + ((size_t)(b * (SEQ - t0) + (t - t0))) * D + colb; }
        else p = oks + (size_t)(kind - 1) * kvs_stride + (size_t)(row - MP) * D + colb;
        return p; }
    __device__ __forceinline__ void operator()(const f32x4 (&acc)[2][2][4][2], const Unit& u, int wr, int wc, int fr, int fq) const {
        const int kind = u.pn >> 2, hc = (u.pn & 3) * 4 + wc, j0 = 8 * fq, colb = hc * 64 + j0;
        bf16_t* dst = Q + (size_t)kind * qkv_stride;
        float rrs[2][4]; rows_rstd_lds(RS, u, wr * 64 + fr, rrs);
        const int rowb = u.pm * BM + wr * 64 + fr;
        if (kind < 2) {
            const float* gp = kind == 0 ? qg : kg; const float qs = kind == 0 ? QSCALE : 1.0f;
            float g1[8], g2[8];
            { const f32x4 a = *(const f32x4*)(gp + j0), b = *(const f32x4*)(gp + j0 + 4), c = *(const f32x4*)(gp + 32 + j0), d = *(const f32x4*)(gp + 36 + j0);
#pragma unroll
              for (int i = 0; i < 4; ++i) { g1[i] = a[i] * qs; g1[4 + i] = b[i] * qs; g2[i] = c[i] * qs; g2[4 + i] = d[i] * qs; } }
            f32x4 rc[2][4];
            if (ROPE) { const int row = rowb; const int tpos = row < MP ? (row & (SEQ - 1)) : SEQ + ((row - MP) & (DSEQ - 1)); const float* rp = rope + (size_t)tpos * 64 + j0;
                rc[0][0] = *(const f32x4*)rp; rc[0][1] = *(const f32x4*)(rp + 4); rc[0][2] = *(const f32x4*)(rp + 32); rc[0][3] = *(const f32x4*)(rp + 36); }
#pragma unroll
            for (int rg = 0; rg < 8; ++rg) {
                const int ai = rg >> 2, m = rg & 3, row = rowb + ai * HALF + m * 16;
                if (ROPE && rg < 7) { const int rown = rowb + ((rg + 1) >> 2) * HALF + ((rg + 1) & 3) * 16; const int tpos = rown < MP ? (rown & (SEQ - 1)) : SEQ + ((rown - MP) & (DSEQ - 1));
                    const float* rp = rope + (size_t)tpos * 64 + j0; f32x4 (&rn)[4] = rc[(rg + 1) & 1];
                    rn[0] = *(const f32x4*)rp; rn[1] = *(const f32x4*)(rp + 4); rn[2] = *(const f32x4*)(rp + 32); rn[3] = *(const f32x4*)(rp + 36); }
                float x1[8], x2[8];
                { const float rr = rrs[ai][m];
#pragma unroll
                  for (int n = 0; n < 2; ++n)
#pragma unroll
                    for (int i = 0; i < 4; ++i) { x1[4 * n + i] = acc[ai][0][m][n][i] * rr; x2[4 * n + i] = acc[ai][1][m][n][i] * rr; } }
                float ss = 0.f;
#pragma unroll
                for (int i = 0; i < 8; ++i) ss += x1[i] * x1[i] + x2[i] * x2[i];
                ss += swz_xor<16>(ss); ss = xadd32(ss);
                const float rs = 1.0f / sqrtf(ss * (1.0f / 64.0f) + EPS);
#pragma unroll
                for (int i = 0; i < 8; ++i) { x1[i] *= rs * g1[i]; x2[i] *= rs * g2[i]; }
                if (ROPE) { const f32x4 (&r)[4] = rc[rg & 1];
#pragma unroll
                    for (int i = 0; i < 8; ++i) { const float c = i < 4 ? r[0][i & 3] : r[1][i & 3], sn = i < 4 ? r[2][i & 3] : r[3][i & 3];
                        const float a = x1[i], b = x2[i]; x1[i] = a * c - b * sn; x2[i] = b * c + a * sn; } }
                if (kind == 1) { float* p = f32_dst(1, row, colb);
                    if (p) { __builtin_nontemporal_store((f32x4){x1[0], x1[1], x1[2], x1[3]}, (f32x4*)p); __builtin_nontemporal_store((f32x4){x1[4], x1[5], x1[6], x1[7]}, (f32x4*)(p + 4));
                             __builtin_nontemporal_store((f32x4){x2[0], x2[1], x2[2], x2[3]}, (f32x4*)(p + 32)); __builtin_nontemporal_store((f32x4){x2[4], x2[5], x2[6], x2[7]}, (f32x4*)(p + 36)); } }
                bf16_t* o = dst + (size_t)row * D + colb;
                *(u32x4*)o = pack8(x1); *(u32x4*)(o + 32) = pack8(x2);
            }
        } else {
#pragma unroll
            for (int rg = 0; rg < 8; ++rg) {
                const int ai = rg >> 2, m = rg & 3, row = rowb + ai * HALF + m * 16;
                float x1[8], x2[8];
                { const float rr = rrs[ai][m];
#pragma unroll
                  for (int n = 0; n < 2; ++n)
#pragma unroll
                    for (int i = 0; i < 4; ++i) { x1[4 * n + i] = acc[ai][0][m][n][i] * rr; x2[4 * n + i] = acc[ai][1][m][n][i] * rr; } }
                float* p = f32_dst(2, row, colb);
                if (p) { __builtin_nontemporal_store((f32x4){x1[0], x1[1], x1[2], x1[3]}, (f32x4*)p); __builtin_nontemporal_store((f32x4){x1[4], x1[5], x1[6], x1[7]}, (f32x4*)(p + 4));
                         __builtin_nontemporal_store((f32x4){x2[0], x2[1], x2[2], x2[3]}, (f32x4*)(p + 32)); __builtin_nontemporal_store((f32x4){x2[4], x2[5], x2[6], x2[7]}, (f32x4*)(p + 36)); }
                bf16_t* o = dst + (size_t)row * D + colb;
                *(u32x4*)o = pack8(x1); *(u32x4*)(o + 32) = pack8(x2);
            }
        }
    }
};

struct EpiResAdd {
    static constexpr bool PERM = true, AFTER_DRAIN = false;
    bf16_t* Xb; const float* Xr32; float* X32out; float* SSQ;
    __device__ __forceinline__ void operator()(const f32x4 (&acc)[2][2][4][2], const Unit& u, int wr, int wc, int fr, int fq) const {
        const int col0 = u.pn * BM + wc * 32 + 8 * fq;
        const unsigned row0 = (unsigned)(u.pm * BM + wr * 64 + fr);
        float ssv[2][4];
#pragma unroll
        for (int ai = 0; ai < 2; ++ai)
#pragma unroll
        for (int mh = 0; mh < 4; mh += 2) {
            f32x4 xo[2][2][2];
            if (Xr32) {
#pragma unroll
                for (int k = 0; k < 2; ++k)
#pragma unroll
                    for (int bj = 0; bj < 2; ++bj)
#pragma unroll
                        for (int n = 0; n < 2; ++n) xo[k][bj][n] = *(const f32x4*)(Xr32 + ((row0 + (unsigned)(ai * HALF + (mh + k) * 16)) * (unsigned)D + (unsigned)(col0 + bj * HALF + 4 * n)));
            } else {
                u32x4 xb[2][2];
#pragma unroll
                for (int k = 0; k < 2; ++k)
#pragma unroll
                    for (int bj = 0; bj < 2; ++bj) xb[k][bj] = *(const u32x4*)(Xb + ((row0 + (unsigned)(ai * HALF + (mh + k) * 16)) * (unsigned)D + (unsigned)(col0 + bj * HALF)));
#pragma unroll
                for (int k = 0; k < 2; ++k)
#pragma unroll
                    for (int bj = 0; bj < 2; ++bj) { const u32x4 w = xb[k][bj];
                        xo[k][bj][0] = (f32x4){bf2f(w.x & 0xffff), bf2f(w.x >> 16), bf2f(w.y & 0xffff), bf2f(w.y >> 16)};
                        xo[k][bj][1] = (f32x4){bf2f(w.z & 0xffff), bf2f(w.z >> 16), bf2f(w.w & 0xffff), bf2f(w.w >> 16)}; }
            }
#pragma unroll
            for (int k = 0; k < 2; ++k) { const int m = mh + k; const unsigned ro = (row0 + (unsigned)(ai * HALF + m * 16)) * (unsigned)D + (unsigned)col0;
                float ss = 0.f;
#pragma unroll
                for (int bj = 0; bj < 2; ++bj) { const f32x4 v0 = xo[k][bj][0] + acc[ai][bj][m][0], v1 = xo[k][bj][1] + acc[ai][bj][m][1];
                    ss += ((v0.x * v0.x + v0.y * v0.y) + (v0.z * v0.z + v0.w * v0.w)) + ((v1.x * v1.x + v1.y * v1.y) + (v1.z * v1.z + v1.w * v1.w));
                    if (X32out) { *(f32x4*)(X32out + (ro + (unsigned)(bj * HALF))) = v0; *(f32x4*)(X32out + (ro + (unsigned)(bj * HALF + 4))) = v1; }
                    else { u32x4 w; w.x = cvt_pk_bf16(v0.x, v0.y); w.y = cvt_pk_bf16(v0.z, v0.w); w.z = cvt_pk_bf16(v1.x, v1.y); w.w = cvt_pk_bf16(v1.z, v1.w);
                        *(u32x4*)(Xb + (ro + (unsigned)(bj * HALF))) = w; } }
                ssv[ai][m] = ss; }
        }
        if (!X32out) {
#pragma unroll
            for (int ai = 0; ai < 2; ++ai)
#pragma unroll
                for (int m = 0; m < 4; ++m) { float ss = ssv[ai][m]; ss += swz_xor<16>(ss); ss = xadd32(ss); if (fq == 0) SSQ[(size_t)(row0 + (unsigned)(ai * HALF + m * 16)) * 16 + u.pn * 4 + wc] = ss; } }
    }
};

struct EpiRelu2 {
    static constexpr bool PERM = true, AFTER_DRAIN = false;
    bf16_t* O; int ldc; const PG8_LAS float* RS;
    __device__ __forceinline__ void operator()(const f32x4 (&acc)[2][2][4][2], const Unit& u, int wr, int wc, int fr, int fq) const {
        const int col0 = u.pn * BM + wc * 32 + 8 * fq;
        float rrs[2][4]; rows_rstd_lds(RS, u, wr * 64 + fr, rrs);
#pragma unroll
        for (int ai = 0; ai < 2; ++ai)
#pragma unroll
            for (int m = 0; m < 4; ++m) { const int row = u.pm * BM + ai * HALF + wr * 64 + m * 16 + fr; bf16_t* rowp = O + (size_t)row * ldc + col0; const float rr = rrs[ai][m];
#pragma unroll
                for (int bj = 0; bj < 2; ++bj) { float x[8];
#pragma unroll
                    for (int n = 0; n < 2; ++n)
#pragma unroll
                        for (int i = 0; i < 4; ++i) { const float v = fmaxf(acc[ai][bj][m][n][i] * rr, 0.f); x[4 * n + i] = v * v; }
                    *(u32x4*)(rowp + bj * HALF) = pack8(x); } }
    }
};

__device__ __forceinline__ float gelu_tanh(float x) {
    const float y = 0.7978845608028654f * (x + 0.044715f * x * x * x);
    const float e = __expf(2.0f * y);
    const float th = 1.0f - 2.0f / (1.0f + e);
    return 0.5f * x * (1.0f + th);
}
struct EpiBin {
    static constexpr bool PERM = true, AFTER_DRAIN = false;
    bf16_t *G, *U; const float* bias; float *ocp, *ocs; const PG8_LAS float* RS;
    __device__ __forceinline__ void operator()(const f32x4 (&acc)[2][2][4][2], const Unit& u, int wr, int wc, int fr, int fq) const {
        const int col0 = u.pn * BM + wc * 32 + 8 * fq; const bool isu = u.pn >= 4;
        float bv[2][8];
#pragma unroll
        for (int bj = 0; bj < 2; ++bj)
#pragma unroll
            for (int i = 0; i < 8; ++i) bv[bj][i] = bias[col0 + bj * HALF + i];
        float rrs[2][4]; rows_rstd_lds(RS, u, wr * 64 + fr, rrs);
#pragma unroll
        for (int ai = 0; ai < 2; ++ai)
#pragma unroll
            for (int m = 0; m < 4; ++m) { const int row = u.pm * BM + ai * HALF + wr * 64 + m * 16 + fr; const float rr = rrs[ai][m];
#pragma unroll
                for (int bj = 0; bj < 2; ++bj) { float x[8];
#pragma unroll
                    for (int n = 0; n < 2; ++n)
#pragma unroll
                        for (int i = 0; i < 4; ++i) x[4 * n + i] = acc[ai][bj][m][n][i] * rr + bv[bj][4 * n + i];
                    if (!isu) {
#pragma unroll
                        for (int i = 0; i < 8; ++i) x[i] = gelu_tanh(x[i]);
                        *(u32x4*)(G + (size_t)row * D + col0 + bj * HALF) = pack8(x);
                    } else {
                        const int uc = col0 + bj * HALF - D;
                        *(u32x4*)(U + (size_t)row * D + uc) = pack8(x);
                        float* p = nullptr;
                        if (row < MP) { const int t = row & (SEQ - 1), b = row >> 11; if (t >= SEQ - 3) p = ocp + (size_t)(b * 3 + (t - (SEQ - 3))) * D + uc; }
                        else { const int s = row - MP, t = s & (DSEQ - 1), b = s >> 4; if (t >= DSEQ - 3) p = ocs + (size_t)(b * 3 + (t - (DSEQ - 3))) * D + uc; }
                        if (p) { *(f32x4*)p = (f32x4){x[0], x[1], x[2], x[3]}; *(f32x4*)(p + 4) = (f32x4){x[4], x[5], x[6], x[7]}; }
                    } } }
    }
};

struct EpiGates {
    static constexpr bool PERM = true, AFTER_DRAIN = false;
    const bf16_t* XCB; const float *gab, *gxb, *sp8  ; bf16_t *AA, *BB;
    __device__ __forceinline__ void operator()(const f32x4 (&acc)[2][2][4][2], const Unit& u, int wr, int wc, int fr, int fq) const {
        const int nb = u.pn >> 1, cin = 128 * (u.pn & 1) + wc * 32 + 8 * fq, ch0 = 256 * nb + cin;
        const unsigned row0 = (unsigned)(u.pm * BM + wr * 64 + fr);
        const unsigned xoff0 = ((unsigned)nb * MT + row0) * 256u + (unsigned)cin, ooff0 = row0 * (unsigned)D + (unsigned)ch0;
        u32x4 xw[2][4];
#pragma unroll
        for (int ai = 0; ai < 2; ++ai)
#pragma unroll
            for (int m = 0; m < 4; ++m) xw[ai][m] = *(const u32x4*)(XCB + (xoff0 + (unsigned)(ai * HALF + m * 16) * 256u));
#pragma unroll
        for (int n = 0; n < 2; ++n) {
            const f32x4 ba = *(const f32x4*)(gab + ch0 + 4 * n), bx = *(const f32x4*)(gxb + ch0 + 4 * n), sp = *(const f32x4*)(sp8 + ch0 + 4 * n);
#pragma unroll
            for (int ai = 0; ai < 2; ++ai)
#pragma unroll
                for (int m = 0; m < 4; ++m) {
                    const unsigned dr = (unsigned)(ai * HALF + m * 16);
                    f32x4 a, b;
#pragma unroll
                    for (int i = 0; i < 4; ++i) {
                        const unsigned w = xw[ai][m][2 * n + (i >> 1)];
                        const float xc = bf2f((unsigned short)((i & 1) ? (w >> 16) : (w & 0xffffu)));
                        const float r = __builtin_amdgcn_rcpf(1.0f + __expf(-(acc[ai][0][m][n][i] + ba[i])));
                        const float ig = __builtin_amdgcn_rcpf(1.0f + __expf(-(acc[ai][1][m][n][i] + bx[i])));
                        const float la = -r * sp[i], t2 = 2.0f * la;
                        a[i] = la;
                        const float poly = -t2 * (1.0f + t2 * (0.5f + t2 * (0.16666667f + t2 * (0.041666668f + t2 * (0.0083333338f + t2 * 0.0013888889f)))));
                        const float em = t2 > -0.25f ? poly : 1.0f - __expf(t2);
                        b[i] = __builtin_amdgcn_sqrtf(em) * (ig * xc); }
                    { u32x2 wa, wb; wa.x = cvt_pk_bf16(a[0], a[1]); wa.y = cvt_pk_bf16(a[2], a[3]); wb.x = cvt_pk_bf16(b[0], b[1]); wb.y = cvt_pk_bf16(b[2], b[3]);
                      *(u32x2*)(AA + (ooff0 + dr * (unsigned)D + 4u * n)) = wa; *(u32x2*)(BB + (ooff0 + dr * (unsigned)D + 4u * n)) = wb; }
                }
        }
    }
};

template <class Epi, class Sched, bool ALIGN_EPI = false, bool SP2 = false>
__device__ __forceinline__ void gemm_phase(PG8_LAS unsigned char* lds, const Gemm g, const Sched& S, const Epi& E, const int tid_in) {
    const int tid = tid_in; const int wid = __builtin_amdgcn_readfirstlane(tid >> 6), lane = tid & 63, wr = wid >> 2, wc = wid & 3, fr = lane & 15, fq = lane >> 4;
    int K = g.K; asm volatile("" : "+s"(K)); const int nt = K / BK;
    unsigned voffA[2], voffB[2];
#pragma unroll
    for (int i = 0; i < 2; ++i) { int R, C; stage_rc(tid * 16 + i * 8192, R, C); const int Rb = Epi::PERM ? ((R & ~31) + perm32(R & 31)) : R;
        voffA[i] = (unsigned)(R * K + C) * 2u; voffB[i] = (unsigned)(Rb * K + C) * 2u; }
    const size_t kstep = (size_t)(BK * 2);
    const size_t hstep = (size_t)HALF * K * 2;
    const size_t tstep = 2 * hstep;
    const unsigned ldsw = (unsigned)wid * 1024u;
    const int aoff = lds_byte(wr * 64 + fr, fq * 8), boff = lds_byte(wc * 32 + fr, fq * 8);
#define PG8_SA(b, h) (((b) * 2 + (h)) * HTB)
#define PG8_SB(b, h) ((4 + (b) * 2 + (h)) * HTB)
#define PG8_STAGE(bufoff, gbase, voff) do { _Pragma("unroll") for (int _i = 0; _i < 2; ++_i) \
        __builtin_amdgcn_global_load_lds((const unsigned*)((const char*)(gbase) + (voff)[_i]), (PG8_LAS unsigned*)(lds + (bufoff) + ldsw + _i * 8192), 16, 0, 0); } while (0)
#define PG8_LDA(dst, b, h) do { _Pragma("unroll") for (int m = 0; m < 4; ++m) _Pragma("unroll") for (int k = 0; k < 2; ++k) dst[m][k] = *(const PG8_LAS bf16x8*)(lds + PG8_SA(b, h) + aoff + m * 2048 + k * 1024); } while (0)
#define PG8_LDB(dst, b, h) do { _Pragma("unroll") for (int n = 0; n < 2; ++n) _Pragma("unroll") for (int k = 0; k < 2; ++k) dst[n][k] = *(const PG8_LAS bf16x8*)(lds + PG8_SB(b, h) + boff + n * 2048 + k * 1024); } while (0)
#define PG8_MMA(ai, bj, At, Bt) do { __builtin_amdgcn_s_setprio(1); _Pragma("unroll") for (int m = 0; m < 4; ++m) _Pragma("unroll") for (int n = 0; n < 2; ++n) _Pragma("unroll") for (int k = 0; k < 2; ++k) \
        acc[ai][bj][m][n] = __builtin_amdgcn_mfma_f32_16x16x32_bf16(Bt[n][k], At[m][k], acc[ai][bj][m][n], 0, 0, 0); __builtin_amdgcn_s_setprio(0); } while (0)
#define PG8_WAIT_V(n) asm volatile("s_waitcnt vmcnt(" #n ")" ::: "memory")
#define PG8_WAIT_L(n) asm volatile("s_waitcnt lgkmcnt(" #n ")" ::: "memory")
#define PG8_BAR __builtin_amdgcn_s_barrier()
#define PG8_SCHED __builtin_amdgcn_sched_barrier(0)
    Unit cur, nxt; int ui = 0;
    if (!S.next(0, cur)) return;
    cur.ui = 0;
    f32x4 acc[2][2][4][2];
#pragma unroll
    for (int a = 0; a < 2; ++a)
#pragma unroll
        for (int b = 0; b < 2; ++b)
#pragma unroll
            for (int m = 0; m < 4; ++m)
#pragma unroll
                for (int n = 0; n < 2; ++n) acc[a][b][m][n] = (f32x4){0.f, 0.f, 0.f, 0.f};
    bf16x8 At[4][2], B0[2][2], B1[2][2];
    const char* cA = (const char*)g.A + (size_t)cur.pm * tstep + g.a_off(cur.pn); const char* cB = (const char*)g.Bt + (size_t)cur.pn * tstep;
    S.a_ready(cur);
    if constexpr (SP2) {
        PG8_STAGE(PG8_SB(0, 0), cB, voffB); PG8_STAGE(PG8_SB(0, 1), cB + hstep, voffB); PG8_STAGE(PG8_SA(0, 0), cA, voffA); PG8_STAGE(PG8_SA(0, 1), cA + hstep, voffA);
        if (wr == 1) PG8_BAR;
        PG8_WAIT_V(2); PG8_BAR;
        PG8_STAGE(PG8_SB(1, 0), cB + kstep, voffB); PG8_STAGE(PG8_SA(1, 0), cA + kstep, voffA); PG8_STAGE(PG8_SB(1, 1), cB + hstep + kstep, voffB);
        PG8_WAIT_V(6); PG8_BAR;
    } else {
        PG8_STAGE(PG8_SB(0, 0), cB, voffB); PG8_STAGE(PG8_SA(0, 0), cA, voffA); PG8_STAGE(PG8_SB(0, 1), cB + hstep, voffB); PG8_STAGE(PG8_SA(0, 1), cA + hstep, voffA);
        if (wr == 1) PG8_BAR;
        PG8_WAIT_V(4); PG8_BAR;
        PG8_STAGE(PG8_SB(1, 0), cB + kstep, voffB); PG8_STAGE(PG8_SA(1, 0), cA + kstep, voffA); PG8_STAGE(PG8_SB(1, 1), cB + hstep + kstep, voffB);
        PG8_WAIT_V(6); PG8_BAR;
    }
    for (;;) {
        const bool has_next = S.next(ui + 1, nxt); nxt.ui = ui + 1;
        const char* nA = has_next ? (const char*)g.A + (size_t)nxt.pm * tstep + g.a_off(nxt.pn) : cA; const char* nB = has_next ? (const char*)g.Bt + (size_t)nxt.pn * tstep : cB;
        for (int t = 0; t < nt; t += 2) {
            const bool last = (t == nt - 2);
            const char* a1 = cA + (size_t)(t + 1) * kstep;
            const char* a2 = last ? nA : cA + (size_t)(t + 2) * kstep; const char* b2 = last ? nB : cB + (size_t)(t + 2) * kstep;
            const char* a3 = a2 + kstep; const char* b3 = b2 + kstep;
            if (last && has_next) S.a_ready(nxt);
            if constexpr (SP2) {
            PG8_LDB(B0, 0, 0); PG8_LDB(B1, 0, 1); PG8_SCHED; PG8_LDA(At, 0, 0); PG8_STAGE(PG8_SA(1, 1), a1 + hstep, voffA);
            PG8_WAIT_V(8); PG8_WAIT_L(0); PG8_BAR; PG8_MMA(0, 0, At, B0); PG8_MMA(0, 1, At, B1); PG8_BAR; PG8_SCHED;
            PG8_LDA(At, 0, 1); PG8_STAGE(PG8_SB(0, 0), b2, voffB); PG8_STAGE(PG8_SB(0, 1), b2 + hstep, voffB); PG8_STAGE(PG8_SA(0, 0), a2, voffA);
            PG8_WAIT_V(8); PG8_WAIT_L(0); PG8_BAR; PG8_MMA(1, 0, At, B0); PG8_MMA(1, 1, At, B1); PG8_BAR; PG8_SCHED;
            PG8_LDB(B0, 1, 0); PG8_LDB(B1, 1, 1); PG8_SCHED; PG8_LDA(At, 1, 0); PG8_STAGE(PG8_SA(0, 1), a2 + hstep, voffA);
            PG8_WAIT_V(8); PG8_WAIT_L(0); PG8_BAR; PG8_MMA(0, 0, At, B0); PG8_MMA(0, 1, At, B1); PG8_BAR; PG8_SCHED;
            PG8_LDA(At, 1, 1); PG8_STAGE(PG8_SB(1, 0), b3, voffB); PG8_STAGE(PG8_SB(1, 1), b3 + hstep, voffB); PG8_STAGE(PG8_SA(1, 0), a3, voffA);
            PG8_WAIT_V(8); PG8_WAIT_L(0); PG8_BAR; PG8_MMA(1, 0, At, B0); PG8_MMA(1, 1, At, B1); PG8_BAR; PG8_SCHED;
            } else {
            PG8_LDB(B0, 0, 0); PG8_SCHED; PG8_LDA(At, 0, 0); PG8_STAGE(PG8_SA(1, 1), a1 + hstep, voffA);
            PG8_WAIT_L(8); PG8_BAR; PG8_WAIT_L(0); PG8_MMA(0, 0, At, B0); PG8_BAR; PG8_SCHED;
            PG8_LDB(B1, 0, 1); PG8_STAGE(PG8_SB(0, 0), b2, voffB);
            PG8_BAR; PG8_WAIT_L(0); PG8_MMA(0, 1, At, B1); PG8_BAR;
            PG8_LDA(At, 0, 1); PG8_STAGE(PG8_SA(0, 0), a2, voffA);
            PG8_BAR; PG8_WAIT_L(0); PG8_MMA(1, 0, At, B0); PG8_BAR; PG8_SCHED;
            PG8_STAGE(PG8_SB(0, 1), b2 + hstep, voffB);
            PG8_WAIT_V(6); PG8_BAR; PG8_MMA(1, 1, At, B1); PG8_BAR;
            PG8_LDB(B0, 1, 0); PG8_SCHED; PG8_LDA(At, 1, 0); PG8_STAGE(PG8_SA(0, 1), a2 + hstep, voffA);
            PG8_WAIT_L(8); PG8_BAR; PG8_WAIT_L(0); PG8_MMA(0, 0, At, B0); PG8_BAR; PG8_SCHED;
            PG8_LDB(B1, 1, 1); PG8_STAGE(PG8_SB(1, 0), b3, voffB);
            PG8_BAR; PG8_WAIT_L(0); PG8_MMA(0, 1, At, B1); PG8_BAR;
            PG8_LDA(At, 1, 1); PG8_STAGE(PG8_SA(1, 0), a3, voffA);
            PG8_BAR; PG8_WAIT_L(0); PG8_MMA(1, 0, At, B0); PG8_BAR; PG8_SCHED;
            PG8_STAGE(PG8_SB(1, 1), b3 + hstep, voffB);
            PG8_WAIT_V(6); PG8_BAR; PG8_MMA(1, 1, At, B1); PG8_BAR;
            }
        }
        if constexpr (ALIGN_EPI) { if (wr == 0) PG8_BAR; }
        if constexpr (!Epi::AFTER_DRAIN) { E(acc, cur, wr, wc, fr, fq); S.done(cur); }
        if (!has_next) break;
#pragma unroll
        for (int a = 0; a < 2; ++a)
#pragma unroll
            for (int b = 0; b < 2; ++b)
#pragma unroll
                for (int m = 0; m < 4; ++m)
#pragma unroll
                    for (int n = 0; n < 2; ++n) acc[a][b][m][n] = (f32x4){0.f, 0.f, 0.f, 0.f};
        cur = nxt; cA = nA; cB = nB; ++ui;
        if constexpr (ALIGN_EPI) { if (wr == 1) PG8_BAR; }
    }
    PG8_WAIT_V(0);
    if constexpr (!ALIGN_EPI) { if (wr == 0) PG8_BAR; }
    PG8_BAR;
    if constexpr (Epi::AFTER_DRAIN) { E.fused(acc, cur, wr, wc, fr, fq, lds, wid, lane); S.done(cur); }
#undef PG8_SA
#undef PG8_SB
#undef PG8_STAGE
#undef PG8_LDA
#undef PG8_LDB
#undef PG8_MMA
#undef PG8_WAIT_V
#undef PG8_WAIT_L
#undef PG8_BAR
#undef PG8_SCHED
}
}

#ifndef PROBE_DUP
#define PROBE_DUP 0
#endif
#include <hip/hip_bf16.h>
#include <cmath>
namespace attn_body {
using bf16=__hip_bfloat16;
using bf16x8=__attribute__((ext_vector_type(8)))short;
using s16x4=__attribute__((ext_vector_type(4)))short;
using f32x16=__attribute__((ext_vector_type(16)))float;
using u32x4=__attribute__((ext_vector_type(4)))unsigned;
constexpr int BATCH=16,NHEAD=16,SEQ=2048,D=64,DM=NHEAD*D;
constexpr int NW=8,QBLK=32,QB=QBLK*NW,KVBLK=64,NQB=SEQ/QB;
constexpr int ATTN_PITCH=DM, ATTN_UNIT_ROWS=QB;
__device__ __forceinline__ int crow(int r,int hi){return (r&3)+8*(r>>2)+4*hi;}
#define SBAR() __builtin_amdgcn_sched_barrier(0)
__device__ __forceinline__ void cmask(f32x16&p0,f32x16&p1,int jb,int qrel,int hi){
  const float NEG=-INFINITY; int kb=64*jb+4*hi;
  #pragma unroll
  for(int r=0;r<16;++r){int kv=kb+(r&3)+8*(r>>2); if(kv>qrel)p0[r]=NEG; if(kv+32>qrel)p1[r]=NEG;}
}

constexpr int NSLOT=3, SLOTB=8192;
constexpr int LDS_K=0, LDS_V=NSLOT*SLOTB, LDS_V2=2*NSLOT*SLOTB  , LDS_WS=3*NSLOT*SLOTB, LDS_OST=LDS_WS+NW*64*4, LDS_BYTES=LDS_OST+NW*4096;
constexpr float C2=0.125f*1.4426950408889634f;
__device__ __forceinline__ void glds16(const void*gsrc,unsigned lds_dst){unsigned keep;
  asm volatile("s_mov_b32 %0, m0\n\ts_mov_b32 m0, %2\n\ts_nop 0\n\tglobal_load_lds_dwordx4 %1, off\n\ts_mov_b32 m0, %0":"=&s"(keep):"v"(gsrc),"s"(lds_dst):"memory");}
__device__ __forceinline__ float max3f(float a,float b,float c){float r;asm("v_max3_f32 %0, %1, %2, %3":"=v"(r):"v"(a),"v"(b),"v"(c));return r;}
__device__ __forceinline__ float max2f(float a,float b){float r;asm("v_max_f32_e32 %0, %1, %2":"=v"(r):"v"(a),"v"(b));return r;}
__device__ __forceinline__ float fadd_s(float a,float b){float r;asm("v_add_f32_e32 %0, %1, %2":"=v"(r):"v"(a),"v"(b));return r;}
__device__ __forceinline__ float fsub_s(float a,float b){float r;asm("v_sub_f32_e32 %0, %1, %2":"=v"(r):"v"(a),"v"(b));return r;}
typedef float f32x2_t __attribute__((ext_vector_type(2))); typedef __bf16 bf16x2_t __attribute__((ext_vector_type(2)));
__device__ __forceinline__ unsigned cvtpk_s(float lo,float hi){f32x2_t v={lo,hi};bf16x2_t b=__builtin_convertvector(v,bf16x2_t);return __builtin_bit_cast(unsigned,b);}
#define WAIT_BAR(N) asm volatile("s_waitcnt vmcnt(" #N ") lgkmcnt(0)\n\ts_barrier":::"memory")

__device__ __forceinline__ void qkt(f32x16&p0,f32x16&p1,const char*Kslot,const bf16x8*qr,const f32x16&negm,int r32,int hi){
  const char*kb=Kslot+hi*1024+r32*16;
  #pragma unroll
  for(int d0=0;d0<4;++d0){
    const bf16x8 b0=*reinterpret_cast<const bf16x8*>(kb+d0*2048);
    const bf16x8 b1=*reinterpret_cast<const bf16x8*>(kb+d0*2048+512);
    if(d0==0){p0=__builtin_amdgcn_mfma_f32_32x32x16_bf16(b0,qr[0],negm,0,0,0);p1=__builtin_amdgcn_mfma_f32_32x32x16_bf16(b1,qr[0],negm,0,0,0);}
    else{p0=__builtin_amdgcn_mfma_f32_32x32x16_bf16(b0,qr[d0],p0,0,0,0);p1=__builtin_amdgcn_mfma_f32_32x32x16_bf16(b1,qr[d0],p1,0,0,0);}}
}
typedef __attribute__((address_space(3))) const char* lds_cptr;
typedef short v4i16_t __attribute__((ext_vector_type(4)));
__device__ __forceinline__ void kload8(bf16x8*kf,lds_cptr kp){
  kf[0]=*(const __attribute__((address_space(3))) bf16x8*)(kp);      kf[1]=*(const __attribute__((address_space(3))) bf16x8*)(kp+512);
  kf[2]=*(const __attribute__((address_space(3))) bf16x8*)(kp+2048); kf[3]=*(const __attribute__((address_space(3))) bf16x8*)(kp+2560);
  kf[4]=*(const __attribute__((address_space(3))) bf16x8*)(kp+4096); kf[5]=*(const __attribute__((address_space(3))) bf16x8*)(kp+4608);
  kf[6]=*(const __attribute__((address_space(3))) bf16x8*)(kp+6144); kf[7]=*(const __attribute__((address_space(3))) bf16x8*)(kp+6656);
}
__device__ __forceinline__ void kload2(bf16x8*kf,lds_cptr kp,int j){ kf[2*j]=*(const __attribute__((address_space(3))) bf16x8*)(kp+j*2048); kf[2*j+1]=*(const __attribute__((address_space(3))) bf16x8*)(kp+j*2048+512); }
__device__ __forceinline__ s16x4 vtr(lds_cptr p){ return __builtin_bit_cast(s16x4,__builtin_amdgcn_ds_read_tr16_b64_v4i16((__attribute__((address_space(3))) v4i16_t*)p)); }
__device__ __forceinline__ float rowmax(const f32x16&p0,const f32x16&p1){
  float a=max3f(p0[0],p0[1],p1[0]),b=max3f(p0[2],p0[3],p1[1]);a=max3f(a,p1[2],p1[3]);
  #pragma unroll
  for(int r=4;r<16;r+=4){a=max3f(a,p0[r],p0[r+1]);b=max3f(b,p0[r+2],p0[r+3]);a=max3f(a,p1[r],p1[r+1]);b=max3f(b,p1[r+2],p1[r+3]);}
  const float m=max2f(a,b);
  auto rr=__builtin_amdgcn_permlane32_swap(__float_as_uint(m),__float_as_uint(m),false,false);
  return max2f(__uint_as_float(rr[0]),__uint_as_float(rr[1]));
}
__device__ __forceinline__ void pv(f32x16*o,int vb,bf16x8 pa0,bf16x8 pa1,bf16x8 pa2,bf16x8 pa3){
  #pragma unroll
  for(int d0=0;d0<2;++d0){s16x4 lo[4],hi[4];
    #pragma unroll
    for(int ks=0;ks<4;++ks){
      asm volatile("ds_read_b64_tr_b16 %0,%1 offset:%c2":"=&v"(lo[ks]):"v"(vb),"i"(d0*4096+ks*1024):"memory");
      asm volatile("ds_read_b64_tr_b16 %0,%1 offset:%c2":"=&v"(hi[ks]):"v"(vb),"i"(d0*4096+ks*1024+512):"memory");}
    asm volatile("s_waitcnt lgkmcnt(0)":::"memory");SBAR();
    #define PK(k) (bf16x8){lo[k][0],lo[k][1],lo[k][2],lo[k][3],hi[k][0],hi[k][1],hi[k][2],hi[k][3]}
    o[d0]=__builtin_amdgcn_mfma_f32_32x32x16_bf16(pa0,PK(0),o[d0],0,0,0);
    o[d0]=__builtin_amdgcn_mfma_f32_32x32x16_bf16(pa1,PK(1),o[d0],0,0,0);
    o[d0]=__builtin_amdgcn_mfma_f32_32x32x16_bf16(pa2,PK(2),o[d0],0,0,0);
    o[d0]=__builtin_amdgcn_mfma_f32_32x32x16_bf16(pa3,PK(3),o[d0],0,0,0);
    #undef PK
  }
}

#ifndef ATTN_STORE16
#define ATTN_STORE16(p,v) (*(u32x4*)(p)=(v))
#endif
__device__ __forceinline__ void band_fix(f32x16&p0,f32x16&p1,int ct,int wid,int r32,int hi,const __attribute__((address_space(3))) float*tbl,float mhat){
  const int dist=(wid>>1)-ct;
  if(dist<0||dist>8){
    #pragma unroll
    for(int r=0;r<16;++r){p0[r]=-INFINITY;p1[r]=-INFINITY;}
  } else if(dist<=2){
    const int A=64*dist+32*(wid&1)+r32-4*hi+128;
    #pragma unroll
    for(int r=0;r<16;++r){ const int kc=(r&3)+8*(r>>2); int i0=A-kc,i1=A-32-kc; i0=i0<0?0:(i0>256?256:i0); i1=i1<0?0:(i1>256?256:i1); p0[r]+=tbl[i0]-mhat; p1[r]+=tbl[i1]-mhat; }
  } else {
    #pragma unroll
    for(int r=0;r<16;++r){p0[r]-=mhat;p1[r]-=mhat;}
  }
}
template<int BAND> __device__ __forceinline__ f32x16 cinit(const f32x16&negm){ if constexpr(BAND!=0){ return f32x16{}; } else { return negm; } }
template<int THRL,int QOR,int OPITCH,int BAND,int DV2> __device__ __forceinline__ void attn_unit(int b,int hq,int hv,int ho,int qb,const bf16*Q,const bf16*__restrict__ K,const bf16*__restrict__ V,bf16*O,char*shm,int tid_in,const __attribute__((address_space(3))) float*tbl){
  const int tid=tid_in,lane=tid&63,r32=lane&31,hi=lane>>5; const int wid=__builtin_amdgcn_readfirstlane(tid>>6);
  const long rowbase=(long)b*SEQ; const int q0=qb*QB;
  const int t_lo=BAND?(qb>=2?4*qb-8:0):0; const int NT=BAND?(4*qb+4-t_lo):(q0+QB)/KVBLK; const int rot=BAND?NT-4:0;
  #define TMAP(s) (BAND?(((s)+rot>=NT)?(s)+rot-NT:(s)+rot):(s))
  const bf16*Qw=Q+(rowbase+q0+wid*QBLK)*DM+hq*D;
  const bf16*Kh=K+(rowbase+(long)t_lo*KVBLK)*DM+hq*D,*Vh=V+(rowbase+(long)t_lo*KVBLK)*DM+hv*D;
  const unsigned lds0=(unsigned)(uintptr_t)shm;
  float*wsf=(float*)(shm+LDS_WS)+wid*64;
  const bf16*ksrc=Kh+(long)lane*DM+wid*8;
  const bf16*vsrc=Vh+(long)(16*(wid&3)+(lane>>2))*DM+(wid>>2)*32+(lane&3)*8;
  const unsigned kdst=lds0+LDS_K+wid*1024, vdst=lds0+LDS_V+wid*1024, vdst2=lds0+LDS_V2+wid*1024;
  #define DMA_K(t,slot) glds16(ksrc+(long)TMAP(t)*KVBLK*DM,(unsigned)__builtin_amdgcn_readfirstlane(kdst+(slot)))
  #define DMA_V(t,slot) do{ glds16(vsrc+(long)TMAP(t)*KVBLK*DM,(unsigned)__builtin_amdgcn_readfirstlane(vdst+(slot))); if constexpr(DV2!=0){ glds16(vsrc+64+(long)TMAP(t)*KVBLK*DM,(unsigned)__builtin_amdgcn_readfirstlane(vdst2+(slot))); } }while(0)
  const int vb0=(int)(lds0+LDS_V)+((lane>>4)&1)*32+(lane&3)*8+(4*hi+((lane&15)>>2))*64;
  const char*Kbase=shm+LDS_K; bf16x8 kf[8];
  const lds_cptr shm3=(lds_cptr)shm; const lds_cptr kp0=shm3+LDS_K+hi*1024+r32*16; const lds_cptr vp0=shm3+LDS_V+((lane>>4)&1)*32+(lane&3)*8+(4*hi+((lane&15)>>2))*64;
  DMA_K(0,0);DMA_V(0,0);DMA_K(1,SLOTB);
  bf16x8 qr[4];
  #pragma unroll
  for(int d0=0;d0<4;++d0)qr[d0]=*reinterpret_cast<const bf16x8*>(&Qw[(long)r32*DM+d0*16+hi*8]);
  float zz_=0.f;asm volatile("":"+v"(zz_));
  float mhat=0.f,l_reg=0.f;f32x16 o[2];f32x16 o2[2];f32x16 negm;
  _Pragma("unroll") for(int r=0;r<16;++r){o[0][r]=zz_;o[1][r]=zz_;o2[0][r]=zz_;o2[1][r]=zz_;negm[r]=zz_;} if constexpr(BAND==0&&DV2==0){ asm volatile("":"+v"(negm)); }
  const int qrel=(wid*QBLK+r32)|QOR;
  #define CMASK(P0,P1,t) do{ if constexpr(BAND!=0){ band_fix(P0,P1,TMAP(t)-(NT-4),wid,r32,hi,tbl,mhat); } else { if constexpr(DV2!=0){ if(__any(mhat!=0.f)){ _Pragma("unroll") for(int r_=0;r_<16;++r_){P0[r_]-=mhat;P1[r_]-=mhat;} } } int jb_=(t)-(NT-4); if(jb_>=0)cmask(P0,P1,jb_,qrel,hi);} }while(0)
  bool resc=false;
  #define START(P0,P1) do{ const float rm=rowmax(P0,P1); resc=false; \
    if(DV2==0 || __any(__builtin_fabsf(rm)>(float)THRL)) { const float dl=rm; mhat=fadd_s(mhat,dl);     \
      _Pragma("unroll") for(int r=0;r<16;++r){P0[r]=fsub_s(P0[r],dl);P1[r]=fsub_s(P1[r],dl);} \
      if constexpr(BAND==0&&DV2==0){ _Pragma("unroll") for(int r=0;r<16;++r)negm[r]=-mhat; asm volatile("":"+v"(negm)); } } \
    _Pragma("unroll") for(int r=0;r<16;++r)P0[r]=__builtin_amdgcn_exp2f(P0[r]); }while(0)
  #define RESC() do{ if(resc){ asm volatile("s_waitcnt lgkmcnt(0)":::"memory"); \
      _Pragma("unroll") for(int d_=0;d_<2;++d_) _Pragma("unroll") for(int r=0;r<16;++r){ const float f_=wsf[crow(r,hi)]; o[d_][r]*=f_; if constexpr(DV2!=0){ o2[d_][r]*=f_; } } } }while(0)
  f32x16 pA0,pA1,pB0,pB1;
  int sl_prev=0,sl_cur=0,sl_next=SLOTB;
  #define ROT() do{sl_prev=sl_cur;sl_cur=sl_next;sl_next=(sl_next==(NSLOT-1)*SLOTB)?0:sl_next+SLOTB;}while(0)
  DMA_K(2,2*SLOTB);
  if constexpr(DV2!=0){WAIT_BAR(4);}else{WAIT_BAR(3);}
  qkt(pA0,pA1,Kbase,qr,cinit<(BAND|DV2)>(negm),r32,hi);asm volatile("s_nop 15\n\ts_nop 7":"+v"(pA0),"+v"(pA1));CMASK(pA0,pA1,0);
  START(pA0,pA1);
  _Pragma("unroll") for(int r=0;r<16;++r)pA1[r]=__builtin_amdgcn_exp2f(pA1[r]);
  WAIT_BAR(0);
  DMA_K(3,0);DMA_V(1,SLOTB);
  ROT();
  kload8(kf,kp0+sl_cur);
  if constexpr(DV2!=0){WAIT_BAR(3);}else{WAIT_BAR(2);}
  s16x4 vlo[8],vhi[8]; u32x4 pw0,pw1,pw2,pw3;
  #define PKW(P,B) cvtpk_s(P[B],P[B+1])
  #define PAF(k) __builtin_bit_cast(bf16x8,pw##k)
  #define VFR(i) (bf16x8){vlo[i][0],vlo[i][1],vlo[i][2],vlo[i][3],vhi[i][0],vhi[i][1],vhi[i][2],vhi[i][3]}
  #define PIN(x) asm volatile("":"+v"(x))
  #define MX3(a,b,c) __builtin_fmaxf(__builtin_fmaxf((a),(b)),(c))
  #define GAPA(MF,A0,A1,A2,A3,W0,W1,PW) do{ MF; sacc+=A0; sacc+=A1; sacc+=A2; sacc+=A3; PIN(sacc); W0; W1; PIN(PW); SBAR(); }while(0)
  #define EX(v) __builtin_amdgcn_exp2f(v)
  #define GAPB(MF,X,B) do{ MF; X[B]=EX(X[B]); X[B+1]=EX(X[B+1]); X[B+2]=EX(X[B+2]); X[B+3]=EX(X[B+3]); PIN(X); SBAR(); }while(0)
  #define GAPB2(MF,X,B,VI) do{ MF; X[B]=EX(X[B]); X[B+1]=EX(X[B+1]); PIN(X); vlo[VI]=vtr(vq_+(((VI)>>2)*4096+((VI)&3)*1024)); vhi[VI]=vtr(vq_+(((VI)>>2)*4096+((VI)&3)*1024+512)); SBAR(); }while(0)
  #define GAPB3(MF,X,B) do{ MF; X[B]=EX(X[B]); X[B+1]=EX(X[B+1]); PIN(X); SBAR(); }while(0)
  #define VRD(i) do{ if constexpr(DV2==0){ vlo[i]=vtr(vp_+(((i)>>2)*4096+((i)&3)*1024)); vhi[i]=vtr(vp_+(((i)>>2)*4096+((i)&3)*1024+512)); } }while(0)
  #define KRD(G,j) do{ if(G){ kload2(kf,kp0+sl_next,j); SBAR(); } }while(0)
  #define STEP(C0,C1,P0,P1,t,GK,GV,GL) do{ SBAR(); \
    const lds_cptr vp_=vp0+sl_prev; \
    VRD(0); SBAR(); float sacc=(P0[0]+P0[1]); \
    GAPA(C0=__builtin_amdgcn_mfma_f32_32x32x16_bf16(kf[0],qr[0],cinit<(BAND|DV2)>(negm),0,0,0), P0[2],P0[3],P0[4],P0[5],     pw0[0]=PKW(P0,0), pw0[1]=PKW(P0,2), pw0); \
    VRD(4); SBAR(); GAPA(C1=__builtin_amdgcn_mfma_f32_32x32x16_bf16(kf[1],qr[0],cinit<(BAND|DV2)>(negm),0,0,0), P0[6],P0[7],P0[8],P0[9],     pw0[2]=PKW(P0,4), pw0[3]=PKW(P0,6), pw0); \
    VRD(1); SBAR(); GAPA(C0=__builtin_amdgcn_mfma_f32_32x32x16_bf16(kf[2],qr[1],C0,0,0,0),   P0[10],P0[11],P0[12],P0[13], pw1[0]=PKW(P0,8), pw1[1]=PKW(P0,10), pw1); \
    VRD(5); SBAR(); GAPA(C1=__builtin_amdgcn_mfma_f32_32x32x16_bf16(kf[3],qr[1],C1,0,0,0),   P0[14],P0[15],P1[0],P1[1],   pw1[2]=PKW(P0,12),pw1[3]=PKW(P0,14), pw1); \
    VRD(2); SBAR(); GAPA(C0=__builtin_amdgcn_mfma_f32_32x32x16_bf16(kf[4],qr[2],C0,0,0,0),   P1[2],P1[3],P1[4],P1[5],     pw2[0]=PKW(P1,0), pw2[1]=PKW(P1,2), pw2); \
    VRD(6); SBAR(); GAPA(C1=__builtin_amdgcn_mfma_f32_32x32x16_bf16(kf[5],qr[2],C1,0,0,0),   P1[6],P1[7],P1[8],P1[9],     pw2[2]=PKW(P1,4), pw2[3]=PKW(P1,6), pw2); \
    VRD(3); SBAR(); GAPA(C0=__builtin_amdgcn_mfma_f32_32x32x16_bf16(kf[6],qr[3],C0,0,0,0),   P1[10],P1[11],P1[12],P1[13], pw3[0]=PKW(P1,8), pw3[1]=PKW(P1,10), pw3); \
    VRD(7); SBAR(); GAPA(C1=__builtin_amdgcn_mfma_f32_32x32x16_bf16(kf[7],qr[3],C1,0,0,0),   P1[14],P1[15],0.f,0.f,       pw3[2]=PKW(P1,12),pw3[3]=PKW(P1,14), pw3); \
    l_reg+=sacc; \
    if(GK){DMA_K((t)+3,sl_cur);} if(GV){DMA_V((t)+1,sl_next);} \
    CMASK(C0,C1,t); \
    { float a=MX3(C0[0],C0[1],C1[0]),b=MX3(C0[2],C0[3],C1[1]); a=MX3(a,C1[2],C1[3]); \
      _Pragma("unroll") for(int r=4;r<16;r+=4){a=MX3(a,C0[r],C0[r+1]);b=MX3(b,C0[r+2],C0[r+3]);a=MX3(a,C1[r],C1[r+1]);b=MX3(b,C1[r+2],C1[r+3]);} \
      float rm=__builtin_fmaxf(a,b); { auto rr=__builtin_amdgcn_permlane32_swap(__float_as_uint(rm),__float_as_uint(rm),false,false); rm=__builtin_fmaxf(__uint_as_float(rr[0]),__uint_as_float(rr[1])); } \
      resc=false; \
      if(__builtin_expect(__any(rm>(float)THRL),0)){ const float dl=__builtin_fmaxf(rm,0.f); mhat+=dl; \
        _Pragma("unroll") for(int r=0;r<16;++r){C0[r]-=dl;C1[r]-=dl;} \
        if constexpr(BAND==0&&DV2==0){ _Pragma("unroll") for(int r=0;r<16;++r)negm[r]=-mhat; asm volatile("":"+v"(negm)); } \
        const float f=__builtin_amdgcn_exp2f(-dl); l_reg*=f; if(hi==0)wsf[r32]=f; resc=true; } } \
    SBAR(); \
    if constexpr(DV2!=0){ _Pragma("unroll") for(int i_=0;i_<8;++i_){ vlo[i_]=vtr(vp_+((i_>>2)*4096+(i_&3)*1024)); vhi[i_]=vtr(vp_+((i_>>2)*4096+(i_&3)*1024+512)); } SBAR(); } \
    if constexpr(DV2==0){ \
    GAPB(o[0]=__builtin_amdgcn_mfma_f32_32x32x16_bf16(PAF(0),VFR(0),o[0],0,0,0), C0,0); \
    GAPB(o[1]=__builtin_amdgcn_mfma_f32_32x32x16_bf16(PAF(0),VFR(4),o[1],0,0,0), C0,4); \
    KRD(GL,0); GAPB(o[0]=__builtin_amdgcn_mfma_f32_32x32x16_bf16(PAF(1),VFR(1),o[0],0,0,0), C0,8); \
    KRD(GL,1); GAPB(o[1]=__builtin_amdgcn_mfma_f32_32x32x16_bf16(PAF(1),VFR(5),o[1],0,0,0), C0,12); \
    KRD(GL,2); GAPB(o[0]=__builtin_amdgcn_mfma_f32_32x32x16_bf16(PAF(2),VFR(2),o[0],0,0,0), C1,0); \
    KRD(GL,3); GAPB(o[1]=__builtin_amdgcn_mfma_f32_32x32x16_bf16(PAF(2),VFR(6),o[1],0,0,0), C1,4); \
    GAPB(o[0]=__builtin_amdgcn_mfma_f32_32x32x16_bf16(PAF(3),VFR(3),o[0],0,0,0), C1,8); \
    GAPB(o[1]=__builtin_amdgcn_mfma_f32_32x32x16_bf16(PAF(3),VFR(7),o[1],0,0,0), C1,12); \
    } else {     \
    const lds_cptr vq_=vp0+(LDS_V2-LDS_V)+sl_prev; \
    GAPB2(o[0]=__builtin_amdgcn_mfma_f32_32x32x16_bf16(PAF(0),VFR(0),o[0],0,0,0), C0,0, 0); \
    GAPB2(o[1]=__builtin_amdgcn_mfma_f32_32x32x16_bf16(PAF(0),VFR(4),o[1],0,0,0), C0,2, 4); \
    KRD(GL,0); GAPB2(o[0]=__builtin_amdgcn_mfma_f32_32x32x16_bf16(PAF(1),VFR(1),o[0],0,0,0), C0,4, 1); \
    KRD(GL,1); GAPB2(o[1]=__builtin_amdgcn_mfma_f32_32x32x16_bf16(PAF(1),VFR(5),o[1],0,0,0), C0,6, 5); \
    KRD(GL,2); GAPB2(o[0]=__builtin_amdgcn_mfma_f32_32x32x16_bf16(PAF(2),VFR(2),o[0],0,0,0), C0,8, 2); \
    KRD(GL,3); GAPB2(o[1]=__builtin_amdgcn_mfma_f32_32x32x16_bf16(PAF(2),VFR(6),o[1],0,0,0), C0,10, 6); \
    GAPB2(o[0]=__builtin_amdgcn_mfma_f32_32x32x16_bf16(PAF(3),VFR(3),o[0],0,0,0), C0,12, 3); \
    GAPB2(o[1]=__builtin_amdgcn_mfma_f32_32x32x16_bf16(PAF(3),VFR(7),o[1],0,0,0), C0,14, 7); \
    GAPB3(o2[0]=__builtin_amdgcn_mfma_f32_32x32x16_bf16(PAF(0),VFR(0),o2[0],0,0,0), C1,0); \
    GAPB3(o2[1]=__builtin_amdgcn_mfma_f32_32x32x16_bf16(PAF(0),VFR(4),o2[1],0,0,0), C1,2); \
    GAPB3(o2[0]=__builtin_amdgcn_mfma_f32_32x32x16_bf16(PAF(1),VFR(1),o2[0],0,0,0), C1,4); \
    GAPB3(o2[1]=__builtin_amdgcn_mfma_f32_32x32x16_bf16(PAF(1),VFR(5),o2[1],0,0,0), C1,6); \
    GAPB3(o2[0]=__builtin_amdgcn_mfma_f32_32x32x16_bf16(PAF(2),VFR(2),o2[0],0,0,0), C1,8); \
    GAPB3(o2[1]=__builtin_amdgcn_mfma_f32_32x32x16_bf16(PAF(2),VFR(6),o2[1],0,0,0), C1,10); \
    GAPB3(o2[0]=__builtin_amdgcn_mfma_f32_32x32x16_bf16(PAF(3),VFR(3),o2[0],0,0,0), C1,12); \
    GAPB3(o2[1]=__builtin_amdgcn_mfma_f32_32x32x16_bf16(PAF(3),VFR(7),o2[1],0,0,0), C1,14); \
    } \
    }while(0)
  int t=1;
  #undef CMASK
  #define CMASK(P0,P1,t) do{ if constexpr(BAND!=0){ band_fix(P0,P1,TMAP(t)-(NT-4),wid,r32,hi,tbl,mhat); } else if constexpr(DV2!=0){ if(__any(mhat!=0.f)){ _Pragma("unroll") for(int r_=0;r_<16;++r_){P0[r_]-=mhat;P1[r_]-=mhat;} } } }while(0)
  for(;t+5<NT;t+=2){
    STEP(pB0,pB1,pA0,pA1,t,true,true,true);     if constexpr(DV2!=0){WAIT_BAR(3);}else{WAIT_BAR(2);} RESC(); ROT();
    STEP(pA0,pA1,pB0,pB1,t+1,true,true,true);   if constexpr(DV2!=0){WAIT_BAR(3);}else{WAIT_BAR(2);} RESC(); ROT();
  }
  #undef CMASK
  #define CMASK(P0,P1,t) do{ if constexpr(BAND!=0){ band_fix(P0,P1,TMAP(t)-(NT-4),wid,r32,hi,tbl,mhat); } else { if constexpr(DV2!=0){ if(__any(mhat!=0.f)){ _Pragma("unroll") for(int r_=0;r_<16;++r_){P0[r_]-=mhat;P1[r_]-=mhat;} } } int jb_=(t)-(NT-4); if(jb_>=0)cmask(P0,P1,jb_,qrel,hi);} }while(0)
  #define ENDW(tt) do{ if constexpr(DV2!=0){ if((tt)+3<NT){WAIT_BAR(3);} else if((tt)+2<NT){WAIT_BAR(2);} else {WAIT_BAR(0);} } else { if((tt)+3<NT){WAIT_BAR(2);} else if((tt)+2<NT){WAIT_BAR(1);} else {WAIT_BAR(0);} } }while(0)
  for(;t+1<NT;t+=2){
    STEP(pB0,pB1,pA0,pA1,t,(t+3<NT),(t+1<NT),(t+1<NT));       ENDW(t);   RESC(); ROT();
    STEP(pA0,pA1,pB0,pB1,t+1,(t+4<NT),(t+2<NT),(t+2<NT));     ENDW(t+1); RESC(); ROT();
  }
  STEP(pB0,pB1,pA0,pA1,NT-1,false,false,false); RESC();
  { float sacc=pB0[0]+pB0[1]; _Pragma("unroll") for(int r=2;r<16;++r)sacc+=pB0[r]; _Pragma("unroll") for(int r=0;r<16;++r)sacc+=pB1[r]; l_reg+=sacc;
    pw0=(u32x4){PKW(pB0,0),PKW(pB0,2),PKW(pB0,4),PKW(pB0,6)};pw1=(u32x4){PKW(pB0,8),PKW(pB0,10),PKW(pB0,12),PKW(pB0,14)};pw2=(u32x4){PKW(pB1,0),PKW(pB1,2),PKW(pB1,4),PKW(pB1,6)};pw3=(u32x4){PKW(pB1,8),PKW(pB1,10),PKW(pB1,12),PKW(pB1,14)};
    SBAR(); pv(o,vb0+sl_cur,PAF(0),PAF(1),PAF(2),PAF(3)); if constexpr(DV2!=0){ SBAR(); pv(o2,vb0+(LDS_V2-LDS_V)+sl_cur,PAF(0),PAF(1),PAF(2),PAF(3)); } }
  #undef PKW
  #undef PAF
  #undef VFR
  #undef PIN
  #undef MX3
  #undef GAPA
  #undef GAPB
  #undef GAPB2
  #undef GAPB3
  #undef EX
  #undef VRD
  #undef KRD
  #undef STEP
  #undef ENDW
  {auto rr=__builtin_amdgcn_permlane32_swap(__float_as_uint(l_reg),__float_as_uint(l_reg),false,false);l_reg=__uint_as_float(rr[0])+__uint_as_float(rr[1]);}
  if(hi==0)wsf[32+r32]=l_reg;asm volatile("s_waitcnt lgkmcnt(0)":::"memory");
  float rli[16];
  #pragma unroll
  for(int r=0;r<16;++r)rli[r]=__builtin_amdgcn_rcpf(wsf[32+crow(r,hi)]);
  bf16*Ow=O+(rowbase+q0+wid*QBLK)*(long)OPITCH+ho*D;
  { bf16*stg=(bf16*)(shm+LDS_OST)+wid*2048;
    #pragma unroll
    for(int r=0;r<16;++r){const int orow=crow(r,hi);
      #pragma unroll
      for(int d0=0;d0<2;++d0)stg[orow*64+d0*32+r32]=__float2bfloat16(o[d0][r]*rli[r]);}
    asm volatile("s_waitcnt lgkmcnt(0)":::"memory");
    #pragma unroll
    for(int i=0;i<4;++i){const int row=i*8+(lane>>3),ch=lane&7; const u32x4 v=*(const u32x4*)(stg+row*64+ch*8); ATTN_STORE16(Ow+(long)row*OPITCH+ch*8,v);}
    if constexpr(DV2!=0){ asm volatile("s_waitcnt lgkmcnt(0)":::"memory");
      #pragma unroll
      for(int r=0;r<16;++r){const int orow=crow(r,hi);
        #pragma unroll
        for(int d0=0;d0<2;++d0)stg[orow*64+d0*32+r32]=__float2bfloat16(o2[d0][r]*rli[r]);}
      asm volatile("s_waitcnt lgkmcnt(0)":::"memory");
      #pragma unroll
      for(int i=0;i<4;++i){const int row=i*8+(lane>>3),ch=lane&7; const u32x4 v=*(const u32x4*)(stg+row*64+ch*8); ATTN_STORE16(Ow+D+(long)row*OPITCH+ch*8,v);} } }
  asm volatile("s_waitcnt lgkmcnt(0)\n\ts_barrier":::"memory");
  #undef DMA_K
  #undef TMAP
  #undef DMA_V
  #undef CMASK
  #undef START
  #undef RESC
  #undef ROT
}
constexpr int ATTN_LDS_BYTES=LDS_BYTES;
#undef SBAR
#undef WAIT_BAR
}

using pg8::bf16_t; using pg8::bf16x8; using pg8::f32x4; using pg8::f32x2; using pg8::u32x4; using pg8::u32x2; using pg8::cvt_pk_bf16; using pg8::bf2f;

enum { IN_XP = 0, IN_XS, IN_CAK, IN_CAV, IN_SBC, IN_SBH, IN_CCK, IN_CCV, IN_GMIX, IN_GMLP, IN_GFIN, IN_AWIN, IN_AQG, IN_AKG, IN_ALAM, IN_ASUB, IN_AWOUT,
       IN_BWIN, IN_BBIN, IN_BCW, IN_BCB, IN_BGAW, IN_BGAB, IN_BGXW, IN_BGXB, IN_BLAM, IN_BWOUT, IN_CWIN, IN_CQG, IN_CKG, IN_CBIAS, IN_CWOUT, IN_W1, IN_W2, N_IN };
constexpr size_t OUT_YP = 0, OUT_YS = OUT_YP + (size_t)MP * D, OUT_AKP = OUT_YS + (size_t)MS * D, OUT_AVP = OUT_AKP + 2 * (size_t)MP * D, OUT_AKS = OUT_AVP + 2 * (size_t)MP * D,
    OUT_AVS = OUT_AKS + 2 * (size_t)MS * D, OUT_BCP = OUT_AVS + 2 * (size_t)MS * D, OUT_BHP = OUT_BCP + (size_t)NB * 3 * D, OUT_BCS = OUT_BHP + (size_t)NB * D, OUT_BHS = OUT_BCS + (size_t)NB * 3 * D,
    OUT_CKP = OUT_BHS + (size_t)NB * D, OUT_CVP = OUT_CKP + (size_t)NB * CWIN * D, OUT_CKS = OUT_CVP + (size_t)NB * CWIN * D, OUT_CVS = OUT_CKS + (size_t)MS * D, OUT_TOTAL = OUT_CVS + (size_t)MS * D;
static_assert(OUT_TOTAL == 186515456ull, "output map");

constexpr size_t MiB = 1u << 20;
constexpr size_t ACT_BF = (size_t)MT * D * 2;
constexpr size_t WS_CTL = 0, CTL_ZERO_BYTES = 32 * 1024;
constexpr size_t WS_ROPE = 1 * MiB;
constexpr size_t WS_SP8 = WS_ROPE + 1 * MiB;
constexpr size_t WS_SSQ = WS_SP8 + 64 * 1024;
constexpr size_t WS_CP = 7 * MiB, WS_CH = 9 * MiB;
constexpr size_t WS_W = 12 * MiB;
constexpr size_t W_AIN = 0, W_AOUT = W_AIN + 2ull * 3072 * 1024, W_BIN = W_AOUT + 2ull * 1024 * 1024, W_BG = W_BIN + 2048ull * 1024, W_BOUT = W_BG + 2048ull * 256,
    W_CIN = W_BOUT + 1024ull * 1024, W_COUT = W_CIN + 3072ull * 1024, W_1 = W_COUT + 1024ull * 1024, W_2 = W_1 + 4ull * 4096 * 1024, W_END = W_2 + 4ull * 4096 * 1024;
constexpr size_t WS_X = WS_W + ((W_END * 2 + MiB - 1) / MiB) * MiB;
constexpr size_t WS_XN = WS_X + (size_t)MT * D * 4;
constexpr size_t WS_Q = WS_XN + ACT_BF, WS_K = WS_Q + ACT_BF, WS_V = WS_K + ACT_BF, WS_ON = WS_V + ACT_BF;
constexpr size_t WS_H = WS_ON + ACT_BF;
constexpr size_t WS_AA = WS_H + (size_t)MT * FF * 2, WS_BB = WS_AA + (size_t)MT * D * 4;
constexpr size_t WS_PO = WS_BB + (size_t)MT * D * 4;
constexpr int NSPLIT = 16;
constexpr size_t WS_PML = WS_PO + 128ull * NSPLIT * 2 * 16 * 128 * 4;
constexpr size_t WS_END = WS_PML + 1 * MiB;

constexpr int RING_OFF = 0, RING_BYTES = 131072;
constexpr int LDSCTL_OFF = RING_BYTES, MISC_OFF = LDSCTL_OFF + 320;
constexpr int LDS_BYTES = 147456;
constexpr int NWAVES = 8;

#define GAS __attribute__((address_space(1)))
#define LAS __attribute__((address_space(3)))
typedef GAS unsigned gu32;
#define RLX_AGENT __ATOMIC_RELAXED, __HIP_MEMORY_SCOPE_AGENT
#define LDS_WAIT() asm volatile("s_waitcnt lgkmcnt(0)" ::: "memory")
#define VM_WAIT() asm volatile("s_waitcnt vmcnt(0)" ::: "memory")

#define XB_TMO      128
#define XB_XCNT(j)  (256  + 64 * (j))
#define XB_XSUB(j)  (1280 + 64 * (j))
#define XB_XGEN(j)  (2304 + 64 * (j))
#define XB_TOP      3328
#define XB_TOPGEN   3392
#define XCD_BAR_WORDS 3456
#define XB_SPIN_CAP (1u << 22)
constexpr int CW_BAR = 4096;

__device__ __forceinline__ unsigned xb_ld(unsigned* p)              { return __hip_atomic_load(p, __ATOMIC_RELAXED, __HIP_MEMORY_SCOPE_AGENT); }
__device__ __forceinline__ unsigned xb_add(unsigned* p, unsigned v) { return __hip_atomic_fetch_add(p, v, __ATOMIC_RELAXED, __HIP_MEMORY_SCOPE_AGENT); }
__device__ __forceinline__ unsigned xb_xcc_id() { return (unsigned)__builtin_amdgcn_s_getreg((3 << 11) | 20) & 0xFu; }
#define XB_SPIN(cond, bar) do { unsigned _sp = 0; while (cond) { __builtin_amdgcn_s_sleep(1); \
    if ((++_sp & 255u) == 0u) { if (xb_ld(&(bar)[XB_TMO])) break; if (_sp > XB_SPIN_CAP) { atomicAdd(&(bar)[XB_TMO], 1u); break; } } } } while (0)

struct XcdBarrier { unsigned* bar; unsigned x; volatile LAS unsigned* st; };

__device__ __forceinline__ XcdBarrier xcd_barrier_post(unsigned* bar, volatile LAS unsigned* st) {
    XcdBarrier b; b.bar = bar; b.x = xb_xcc_id(); b.st = st;
    if (threadIdx.x == 0) (void)xb_add(&bar[XB_XCNT(b.x)], 1u);
    return b;
}
__device__ __forceinline__ void xcd_barrier_complete(unsigned* bar, unsigned x, unsigned& nloc, unsigned& nx) {
    const unsigned G = gridDim.x * gridDim.y * gridDim.z;
    unsigned sum, cnt, mine, sp = 0u;
    for (;;) {
        sum = 0u; cnt = 0u; mine = 0u;
#pragma unroll
        for (unsigned j = 0; j < 16; ++j) { const unsigned c = xb_ld(&bar[XB_XCNT(j)]); sum += c; cnt += (c > 0u) ? 1u : 0u; mine = (j == x) ? c : mine; }
        if (sum == G) break;
        __builtin_amdgcn_s_sleep(1);
        if ((++sp & 255u) == 0u) { if (xb_ld(&bar[XB_TMO])) break; if (sp > XB_SPIN_CAP) { atomicAdd(&bar[XB_TMO], 1u); break; } }
    }
    nloc = mine > 0u ? mine : 1u; nx = cnt > 0u ? cnt : 1u;
}
__device__ __forceinline__ void xcd_barrier(const XcdBarrier& b) {
    asm volatile("s_waitcnt vmcnt(0)" ::: "memory");
    __syncthreads();
    if (threadIdx.x == 0) {
        unsigned* bar = b.bar;
        __builtin_amdgcn_s_waitcnt(0);
        unsigned nloc = b.st[0], nx = b.st[1];
        if (nloc == 0u) { xcd_barrier_complete(bar, b.x, nloc, nx); b.st[0] = nloc; b.st[1] = nx; }
        const unsigned old = xb_add(&bar[XB_XSUB(b.x)], 1u);
        const unsigned gen = old / nloc;
        if (old + 1u == (gen + 1u) * nloc) {
            __builtin_amdgcn_fence(__ATOMIC_RELEASE, "agent");
            asm volatile("s_waitcnt vmcnt(0)" ::: "memory");
            const unsigned og = xb_add(&bar[XB_TOP], 1u);
            const unsigned tg = og / nx;
            if (og + 1u == (tg + 1u) * nx) xb_add(&bar[XB_TOPGEN], 1u);
            else XB_SPIN(xb_ld(&bar[XB_TOPGEN]) == tg, bar);
            __builtin_amdgcn_fence(__ATOMIC_ACQUIRE, "agent");
            xb_add(&bar[XB_XGEN(b.x)], 1u);
            asm volatile("s_waitcnt vmcnt(0)" ::: "memory");
        } else {
            XB_SPIN(xb_ld(&bar[XB_XGEN(b.x)]) == gen, bar);
            __builtin_amdgcn_fence(__ATOMIC_ACQUIRE, "agent");
            asm volatile("s_waitcnt vmcnt(0)" ::: "memory");
        }
    }
    __syncthreads();
}

using pg8::swz_xor; using pg8::xadd32; using pg8::xmax32;
__device__ __forceinline__ float wave_sum(float v) {
    v += swz_xor<1>(v); v += swz_xor<2>(v); v += swz_xor<4>(v); v += swz_xor<8>(v); v += swz_xor<16>(v);
    return xadd32(v);
}
__device__ __forceinline__ unsigned f2bf(float f) { unsigned u = __builtin_bit_cast(unsigned, f); return (u + 0x7fffu + ((u >> 16) & 1u)) >> 16; }
__device__ __forceinline__ unsigned pk2(float lo, float hi) { return f2bf(lo) | (f2bf(hi) << 16); }

__device__ __forceinline__ void tr_item(const float* W, int N, int k0, int n0, bf16_t* WT, int K, int dst_row0, LAS float* scr, int lane, const float* gk = nullptr) {
    f32x4 wv[8]; float gv[8];
    const int r8 = lane >> 3, c4 = (lane & 7) * 4;
#pragma unroll
    for (int i = 0; i < 8; ++i) { const int kk = 8 * i + r8; wv[i] = *(const f32x4*)(W + (size_t)(k0 + kk) * N + n0 + c4); gv[i] = gk ? gk[k0 + kk] : 1.0f; }
    __builtin_amdgcn_sched_barrier(0);
#pragma unroll
    for (int i = 0; i < 8; ++i) { const int kk = 8 * i + r8; LAS float* d = scr + kk * 33 + c4; d[0] = wv[i].x * gv[i]; d[1] = wv[i].y * gv[i]; d[2] = wv[i].z * gv[i]; d[3] = wv[i].w * gv[i]; }
    LDS_WAIT(); asm volatile("" ::: "memory");
    const int c = lane & 7;
#pragma unroll
    for (int j = 0; j < 4; ++j) { const int n = (lane >> 3) + 8 * j; const LAS float* s = scr + (8 * c) * 33 + n;
        u32x4 o; o.x = pk2(s[0 * 33], s[1 * 33]); o.y = pk2(s[2 * 33], s[3 * 33]); o.z = pk2(s[4 * 33], s[5 * 33]); o.w = pk2(s[6 * 33], s[7 * 33]);
        *(u32x4*)(WT + (size_t)(dst_row0 + n) * K + k0 + 8 * c) = o; }
    LDS_WAIT(); asm volatile("" ::: "memory");
}
__device__ __forceinline__ int qkv_phys_row(int n0) { const int lb = (n0 & 255) >> 5, wc = lb >> 1, bjh = lb & 1; return (n0 & ~255) + (bjh * 4 + wc) * 32; }

__device__ __forceinline__ void norm_row(const float* xrow, const float* g, bf16_t* orow, float* copyrow, float* f32out, int lane, float* prep = nullptr) {
    const f32x4* xr = (const f32x4*)xrow + lane; const f32x4* gr = (const f32x4*)g + lane;
    f32x4 v[4]; float s = 0.f;
#pragma unroll
    for (int j = 0; j < 4; ++j) { v[j] = xr[64 * j]; s += (v[j].x * v[j].x + v[j].y * v[j].y) + (v[j].z * v[j].z + v[j].w * v[j].w); }
    if (copyrow) {
#pragma unroll
        for (int j = 0; j < 4; ++j) ((f32x4*)copyrow + lane)[64 * j] = v[j]; }
    const float tot = wave_sum(s);
    const float rs = prep ? 1.0f : 1.0f / sqrtf(tot * (1.0f / D) + EPS);
    if (prep && lane < 16) prep[lane] = lane == 0 ? tot : 0.f;
#pragma unroll
    for (int j = 0; j < 4; ++j) { if (!prep) { const f32x4 gg = gr[64 * j]; v[j] = v[j] * rs * gg; } }
    if (orow) { unsigned long long* o8 = (unsigned long long*)orow + lane;
#pragma unroll
        for (int j = 0; j < 4; ++j) o8[64 * j] = (unsigned long long)cvt_pk_bf16(v[j].x, v[j].y) | ((unsigned long long)cvt_pk_bf16(v[j].z, v[j].w) << 32); }
    if (f32out) {
#pragma unroll
        for (int j = 0; j < 4; ++j) ((f32x4*)f32out + lane)[64 * j] = v[j]; }
}

constexpr int RS_OFF = LDSCTL_OFF + 2048;
static_assert(RS_OFF + 8 * 256 * 4 <= LDS_BYTES, "LDS map");
__device__ __forceinline__ void fill_row_factors(LAS unsigned char* ldsp, const pg8::StaticOrder& S, const float* SSQ, int tid) {
    LAS float* RS = (LAS float*)(ldsp + RS_OFF); pg8::Unit u;
    const int r = tid & 255, i0 = tid >> 8;
    f32x4 t[4][4]; bool ok[4];
#pragma unroll
    for (int k = 0; k < 4; ++k) { ok[k] = S.next(i0 + 2 * k, u);
        if (ok[k]) { const f32x4* p = (const f32x4*)(SSQ + (size_t)(u.pm * 256 + r) * 16);
#pragma unroll
            for (int j = 0; j < 4; ++j) t[k][j] = p[j]; } }
#pragma unroll
    for (int k = 0; k < 4; ++k) if (ok[k]) { const f32x4 a = (t[k][0] + t[k][1]) + (t[k][2] + t[k][3]);
        RS[(i0 + 2 * k) * 256 + r] = 1.0f / sqrtf(((a.x + a.y) + (a.z + a.w)) * (1.0f / 1024.0f) + EPS); }
    asm volatile("s_waitcnt vmcnt(0) lgkmcnt(0)" ::: "memory"); __syncthreads();
}

struct AttnItem { const bf16_t* q; const float* kc; const float* vc; const bf16_t* kn; const bf16_t* vn; const float* btab; int cstride, n_cache, k_lo, k_hi, n_total, rel0, head; };

template <int NC, int DV>
__device__ __forceinline__ void attn16_core(const AttnItem& it, int lane, float (&m)[NC], float (&l)[NC], f32x4 (&o)[NC][DV / 16]) {
    const int g = lane >> 4, c16 = lane & 15;
    bf16x8 qop[NC][2];
#pragma unroll
    for (int c = 0; c < NC; ++c)
#pragma unroll
        for (int s = 0; s < 2; ++s) qop[c][s] = *(const bf16x8*)(it.q + (size_t)c16 * D + c * 64 + 32 * s + 8 * g);
#pragma unroll
    for (int c = 0; c < NC; ++c) { m[c] = -1e30f; l[c] = 0.f;
#pragma unroll
        for (int e = 0; e < DV / 16; ++e) o[c][e] = (f32x4){0.f, 0.f, 0.f, 0.f}; }
    for (int k0 = it.k_lo; k0 < it.k_hi; k0 += 32) {
        const bool cache = k0 < it.n_cache;
        int vkey[8];
#pragma unroll
        for (int j = 0; j < 8; ++j) { int key = k0 + 16 * (j >> 2) + 4 * g + (j & 3); vkey[j] = key < it.n_total ? key : it.n_total - 1; }
        f32x4 sacc[NC][2];
        float vv[DV / 16][8];
        if (cache) {
#pragma unroll
            for (int e = 0; e < DV / 32; ++e)
#pragma unroll
                for (int j = 0; j < 8; ++j) vv[e][j] = it.vc[(size_t)vkey[j] * it.cstride + e * 16 + c16];
            f32x4 kv[2][NC][2][2];
#pragma unroll
            for (int t = 0; t < 2; ++t) { const int key = k0 + 16 * t + c16;
#pragma unroll
                for (int c = 0; c < NC; ++c)
#pragma unroll
                    for (int s = 0; s < 2; ++s) { const float* p = it.kc + (size_t)key * it.cstride + c * 64 + 32 * s + 8 * g; kv[t][c][s][0] = *(const f32x4*)p; kv[t][c][s][1] = *(const f32x4*)(p + 4); } }
            __builtin_amdgcn_sched_barrier(0);
#pragma unroll
            for (int t = 0; t < 2; ++t)
#pragma unroll
                for (int c = 0; c < NC; ++c) { f32x4 acc = (f32x4){0.f, 0.f, 0.f, 0.f};
#pragma unroll
                    for (int s = 0; s < 2; ++s) { const f32x4 v0 = kv[t][c][s][0], v1 = kv[t][c][s][1];
                        u32x4 w; w.x = cvt_pk_bf16(v0.x, v0.y); w.y = cvt_pk_bf16(v0.z, v0.w); w.z = cvt_pk_bf16(v1.x, v1.y); w.w = cvt_pk_bf16(v1.z, v1.w);
                        acc = __builtin_amdgcn_mfma_f32_16x16x32_bf16(__builtin_bit_cast(bf16x8, w), qop[c][s], acc, 0, 0, 0); }
                    sacc[c][t] = acc; }
            __builtin_amdgcn_sched_barrier(0);
#pragma unroll
            for (int e = DV / 32; e < DV / 16; ++e)
#pragma unroll
                for (int j = 0; j < 8; ++j) vv[e][j] = it.vc[(size_t)vkey[j] * it.cstride + e * 16 + c16];
            __builtin_amdgcn_sched_barrier(0);
        } else {
#pragma unroll
            for (int t = 0; t < 2; ++t) {
                int key = k0 + 16 * t + c16; key = key < it.n_total ? key : it.n_total - 1;
#pragma unroll
                for (int c = 0; c < NC; ++c) {
                    f32x4 acc = (f32x4){0.f, 0.f, 0.f, 0.f};
#pragma unroll
                    for (int s = 0; s < 2; ++s) {
                        const bf16x8 a = *(const bf16x8*)(it.kn + (size_t)(key - it.n_cache) * D + c * 64 + 32 * s + 8 * g);
                        acc = __builtin_amdgcn_mfma_f32_16x16x32_bf16(a, qop[c][s], acc, 0, 0, 0);
                    }
                    sacc[c][t] = acc;
                }
            }
        }
        if (it.btab) {
            float bvv[2][4];
#pragma unroll
            for (int t = 0; t < 2; ++t)
#pragma unroll
                for (int r = 0; r < 4; ++r) { const int kidx = k0 + 16 * t + 4 * g + r; int rel = it.rel0 + c16 - kidx; rel = rel < -128 ? -128 : (rel > 128 ? 128 : rel); bvv[t][r] = it.btab[(rel + 128) * 16 + it.head]; }
#pragma unroll
            for (int t = 0; t < 2; ++t)
#pragma unroll
                for (int r = 0; r < 4; ++r)
#pragma unroll
                    for (int c = 0; c < NC; ++c) sacc[c][t][r] += bvv[t][r] * LOG2E;
        }
#pragma unroll
        for (int t = 0; t < 2; ++t)
#pragma unroll
            for (int r = 0; r < 4; ++r) { const int kidx = k0 + 16 * t + 4 * g + r;
                if (kidx >= it.n_total) {
#pragma unroll
                    for (int c = 0; c < NC; ++c) sacc[c][t][r] = -1e30f; } }
        bf16x8 pop[NC];
#pragma unroll
        for (int c = 0; c < NC; ++c) {
            float bm = fmaxf(fmaxf(fmaxf(sacc[c][0][0], sacc[c][0][1]), fmaxf(sacc[c][0][2], sacc[c][0][3])), fmaxf(fmaxf(sacc[c][1][0], sacc[c][1][1]), fmaxf(sacc[c][1][2], sacc[c][1][3])));
            bm = fmaxf(bm, swz_xor<16>(bm)); bm = xmax32(bm);
            const float mn = fmaxf(m[c], bm), alpha = __builtin_amdgcn_exp2f(m[c] - mn); m[c] = mn;
            float p[8], ps = 0.f;
#pragma unroll
            for (int t = 0; t < 2; ++t)
#pragma unroll
                for (int r = 0; r < 4; ++r) { p[4 * t + r] = __builtin_amdgcn_exp2f(sacc[c][t][r] - mn); ps += p[4 * t + r]; }
            l[c] = l[c] * alpha + ps;
#pragma unroll
            for (int e = 0; e < DV / 16; ++e) o[c][e] = o[c][e] * alpha;
            u32x4 w; w.x = cvt_pk_bf16(p[0], p[1]); w.y = cvt_pk_bf16(p[2], p[3]); w.z = cvt_pk_bf16(p[4], p[5]); w.w = cvt_pk_bf16(p[6], p[7]); pop[c] = __builtin_bit_cast(bf16x8, w);
        }
#pragma unroll
        for (int e = 0; e < DV / 16; ++e) {
            bf16x8 av;
            if (cache) { u32x4 w; w.x = cvt_pk_bf16(vv[e][0], vv[e][1]); w.y = cvt_pk_bf16(vv[e][2], vv[e][3]); w.z = cvt_pk_bf16(vv[e][4], vv[e][5]); w.w = cvt_pk_bf16(vv[e][6], vv[e][7]); av = __builtin_bit_cast(bf16x8, w); }
            else { unsigned short v[8];
#pragma unroll
                for (int j = 0; j < 8; ++j) v[j] = it.vn[(size_t)(vkey[j] - it.n_cache) * D + e * 16 + c16];
                u32x4 w; w.x = v[0] | ((unsigned)v[1] << 16); w.y = v[2] | ((unsigned)v[3] << 16); w.z = v[4] | ((unsigned)v[5] << 16); w.w = v[6] | ((unsigned)v[7] << 16); av = __builtin_bit_cast(bf16x8, w); }
#pragma unroll
            for (int c = 0; c < NC; ++c) o[c][e] = __builtin_amdgcn_mfma_f32_16x16x32_bf16(av, pop[c], o[c][e], 0, 0, 0);
        }
    }
#pragma unroll
    for (int c = 0; c < NC; ++c) { l[c] += swz_xor<16>(l[c]); l[c] = xadd32(l[c]); }
}


typedef float f32x16s __attribute__((ext_vector_type(16)));
template <class F>
__device__ __forceinline__ void skinny_gemm(LAS unsigned char* lds, const bf16_t* A, int lda, const bf16_t* Bt, int K, int ncb, const F& f, int vcu, int G, int wave, int lane) {
    const int r32 = lane & 31, hi = lane >> 5, tid = wave * 64 + lane;
    LAS float* part = (LAS float*)lds;
    for (int item = vcu; item < 8 * ncb; item += G) {
        const int rb = item & 7, cb = item >> 3;
        const bf16_t* ap = A + f.aoff(cb) + (size_t)(rb * 32 + r32) * lda + hi * 8 + wave * (K >> 3);
        const bf16_t* b0 = Bt + (size_t)(f.brow(cb, 0) + r32) * K + hi * 8 + wave * (K >> 3);
        const bf16_t* b1 = Bt + (size_t)(f.brow(cb, 1) + r32) * K + hi * 8 + wave * (K >> 3);
        const f32x4 pv = f.pre(rb * 32 + (tid >> 4), cb, tid & 15);
        f32x16s acc0, acc1;
#pragma unroll
        for (int r = 0; r < 16; ++r) { acc0[r] = 0.f; acc1[r] = 0.f; }
        const int nks = K >> 7;
        if (nks >= 8) {
            for (int ks = 0; ks < nks; ks += 8) {
                bf16x8 a[8], p[8], qv[8];
#pragma unroll
                for (int j = 0; j < 8; ++j) { a[j] = *(const bf16x8*)(ap + (ks + j) * 16); p[j] = *(const bf16x8*)(b0 + (ks + j) * 16); qv[j] = *(const bf16x8*)(b1 + (ks + j) * 16); }
                __builtin_amdgcn_sched_barrier(0);
#pragma unroll
                for (int j = 0; j < 8; ++j) { acc0 = __builtin_amdgcn_mfma_f32_32x32x16_bf16(a[j], p[j], acc0, 0, 0, 0); acc1 = __builtin_amdgcn_mfma_f32_32x32x16_bf16(a[j], qv[j], acc1, 0, 0, 0); }
                __builtin_amdgcn_sched_barrier(0);
            }
        } else {
            for (int ks = 0; ks < nks; ks += 2) {
                const bf16x8 a0 = *(const bf16x8*)(ap + ks * 16), a1 = *(const bf16x8*)(ap + ks * 16 + 16);
                const bf16x8 p0 = *(const bf16x8*)(b0 + ks * 16), p1 = *(const bf16x8*)(b0 + ks * 16 + 16);
                const bf16x8 q0 = *(const bf16x8*)(b1 + ks * 16), q1 = *(const bf16x8*)(b1 + ks * 16 + 16);
                acc0 = __builtin_amdgcn_mfma_f32_32x32x16_bf16(a0, p0, acc0, 0, 0, 0); acc1 = __builtin_amdgcn_mfma_f32_32x32x16_bf16(a0, q0, acc1, 0, 0, 0);
                acc0 = __builtin_amdgcn_mfma_f32_32x32x16_bf16(a1, p1, acc0, 0, 0, 0); acc1 = __builtin_amdgcn_mfma_f32_32x32x16_bf16(a1, q1, acc1, 0, 0, 0);
            }
        }
        LAS float* pw = part + wave * (32 * 65);
#pragma unroll
        for (int r = 0; r < 16; ++r) { const int row = (r & 3) + 8 * (r >> 2) + 4 * hi; pw[row * 65 + r32] = acc0[r]; pw[row * 65 + 32 + r32] = acc1[r]; }
        asm volatile("s_waitcnt lgkmcnt(0)\n\ts_barrier" ::: "memory");
        const int row = tid >> 4, q = tid & 15;
        float x[4] = {0.f, 0.f, 0.f, 0.f};
#pragma unroll
        for (int w = 0; w < 8; ++w) { const LAS float* p = part + w * (32 * 65) + row * 65 + 4 * q;
#pragma unroll
            for (int i = 0; i < 4; ++i) x[i] += p[i]; }
        asm volatile("s_waitcnt lgkmcnt(0)\n\ts_barrier" ::: "memory");
        f.epi(rb * 32 + row, cb, q, x, pv);
    }
}
__device__ __forceinline__ u32x2 pack4(const float (&x)[4]) { u32x2 w; w.x = cvt_pk_bf16(x[0], x[1]); w.y = cvt_pk_bf16(x[2], x[3]); return w; }
template <bool ROPE> struct SkQKV {
    bf16_t* Q; size_t qkv_stride; const float *qg, *kg, *rope; float* oks; size_t kvs_stride; const float* SSQ;
    __device__ __forceinline__ size_t aoff(int) const { return 0; }
    __device__ __forceinline__ int brow(int cb, int blk) const { const int kind = cb >> 4, hc = cb & 15, n0 = kind * 1024 + hc * 64; return (n0 & ~255) + (blk * 4 + (hc & 3)) * 32; }
    __device__ __forceinline__ f32x4 pre(int srow, int, int) const { return (f32x4){pg8::row_rstd(SSQ, MP + srow), 0.f, 0.f, 0.f}; }
    __device__ __forceinline__ void epi(int srow, int cb, int q, float (&x)[4], const f32x4& pv) const {
        const int kind = cb >> 4, hc = cb & 15, d0 = 4 * q, col = hc * 64 + d0;
        { const float rr = pv.x;
#pragma unroll
          for (int i = 0; i < 4; ++i) x[i] *= rr; }
        if (kind < 2) {
            float ss = (x[0] * x[0] + x[1] * x[1]) + (x[2] * x[2] + x[3] * x[3]);
            ss += swz_xor<1>(ss); ss += swz_xor<2>(ss); ss += swz_xor<4>(ss); ss += swz_xor<8>(ss);
            const float rs = 1.0f / sqrtf(ss * (1.0f / 64.0f) + EPS);
            const f32x4 g = *(const f32x4*)((kind == 0 ? qg : kg) + d0);
#pragma unroll
            for (int i = 0; i < 4; ++i) x[i] *= rs * g[i];
            if (ROPE) {
                float y[4];
#pragma unroll
                for (int i = 0; i < 4; ++i) y[i] = swz_xor<8>(x[i]);
                const float* rp = rope + (size_t)(SEQ + (srow & (DSEQ - 1))) * 64 + (d0 & 31);
                const f32x4 c = *(const f32x4*)rp, sn = *(const f32x4*)(rp + 32);
                const float sg = d0 < 32 ? -1.0f : 1.0f;
#pragma unroll
                for (int i = 0; i < 4; ++i) x[i] = x[i] * c[i] + sg * y[i] * sn[i];
            }
        }
        if (kind >= 1) *(f32x4*)(oks + (size_t)(kind - 1) * kvs_stride + (size_t)srow * D + col) = (f32x4){x[0], x[1], x[2], x[3]};
        if (kind == 0) {
#pragma unroll
            for (int i = 0; i < 4; ++i) x[i] *= QSCALE; }
        *(u32x2*)(Q + (size_t)kind * qkv_stride + (size_t)(MP + srow) * D + col) = pack4(x);
    }
};
struct SkResAdd {
    bf16_t* Xb; const float* Xrs32; float* X32s; float* SSQ;
    __device__ __forceinline__ size_t aoff(int) const { return 0; }
    __device__ __forceinline__ int brow(int cb, int blk) const { return cb * 64 + blk * 32; }
    __device__ __forceinline__ f32x4 pre(int srow, int cb, int q) const { const int col = cb * 64 + 4 * q;
        if (Xrs32) return *(const f32x4*)(Xrs32 + (size_t)srow * D + col);
        const u32x2 w = *(const u32x2*)(Xb + (size_t)(MP + srow) * D + col); return (f32x4){bf2f(w.x & 0xffff), bf2f(w.x >> 16), bf2f(w.y & 0xffff), bf2f(w.y >> 16)}; }
    __device__ __forceinline__ void epi(int srow, int cb, int q, float (&x)[4], const f32x4& pv) const { const int col = cb * 64 + 4 * q;
        const f32x4 v = pv + (f32x4){x[0], x[1], x[2], x[3]};
        if (X32s) *(f32x4*)(X32s + (size_t)srow * D + col) = v;
        else { float ss = (v.x * v.x + v.y * v.y) + (v.z * v.z + v.w * v.w); ss += swz_xor<1>(ss); ss += swz_xor<2>(ss); ss += swz_xor<4>(ss); ss += swz_xor<8>(ss);
            if (q == 0) SSQ[(size_t)(MP + srow) * 16 + cb] = ss;
            u32x2 w; w.x = cvt_pk_bf16(v.x, v.y); w.y = cvt_pk_bf16(v.z, v.w); *(u32x2*)(Xb + (size_t)(MP + srow) * D + col) = w; } }
};
struct SkRelu2 {
    bf16_t* O; const float* SSQ;
    __device__ __forceinline__ size_t aoff(int) const { return 0; }
    __device__ __forceinline__ int brow(int cb, int blk) const { return cb * 64 + blk * 32; }
    __device__ __forceinline__ f32x4 pre(int srow, int, int) const { return (f32x4){pg8::row_rstd(SSQ, MP + srow), 0.f, 0.f, 0.f}; }
    __device__ __forceinline__ void epi(int srow, int cb, int q, float (&x)[4], const f32x4& pv) const { const float rr = pv.x;
#pragma unroll
        for (int i = 0; i < 4; ++i) { const float v = fmaxf(x[i] * rr, 0.f); x[i] = v * v; }
        *(u32x2*)(O + (size_t)(MP + srow) * FF + cb * 64 + 4 * q) = pack4(x); }
};
struct SkBin {
    bf16_t *G, *U; const float* bias; float* ocs; const float* SSQ;
    __device__ __forceinline__ size_t aoff(int) const { return 0; }
    __device__ __forceinline__ int brow(int cb, int blk) const { return cb * 64 + blk * 32; }
    __device__ __forceinline__ f32x4 pre(int srow, int, int) const { return (f32x4){pg8::row_rstd(SSQ, MP + srow), 0.f, 0.f, 0.f}; }
    __device__ __forceinline__ void epi(int srow, int cb, int q, float (&x)[4], const f32x4& pv) const {
        const int col = cb * 64 + 4 * q; const f32x4 bv = *(const f32x4*)(bias + col); const float rr = pv.x;
#pragma unroll
        for (int i = 0; i < 4; ++i) x[i] = x[i] * rr + bv[i];
        if (col < D) {
#pragma unroll
            for (int i = 0; i < 4; ++i) x[i] = pg8::gelu_tanh(x[i]);
            *(u32x2*)(G + (size_t)(MP + srow) * D + col) = pack4(x);
        } else {
            const int uc = col - D; *(u32x2*)(U + (size_t)(MP + srow) * D + uc) = pack4(x);
            const int t = srow & (DSEQ - 1), b = srow >> 4;
            if (t >= DSEQ - 3) *(f32x4*)(ocs + (size_t)(b * 3 + (t - (DSEQ - 3))) * D + uc) = (f32x4){x[0], x[1], x[2], x[3]};
        }
    }
};
struct SkGates {
    const bf16_t* XCB; const float *gab, *gxb, *sp8; bf16_t *AA, *BB;
    __device__ __forceinline__ size_t aoff(int cb) const { return (size_t)(cb >> 3) * MT * 256; }
    __device__ __forceinline__ int brow(int cb, int blk) const { const int nb = cb >> 3, cg = cb & 7; return (nb * 2 + (cg >> 2)) * 256 + blk * 128 + (cg & 3) * 32; }
    __device__ __forceinline__ f32x4 pre(int, int, int) const { return (f32x4){0.f, 0.f, 0.f, 0.f}; }
    __device__ __forceinline__ void epi(int srow, int cb, int q, float (&x)[4], const f32x4&) const {
        float y[4];
#pragma unroll
        for (int i = 0; i < 4; ++i) y[i] = swz_xor<8>(x[i]);
        if (q < 8) {
            const int nb = cb >> 3, cg = cb & 7, cin = cg * 32 + 4 * q, ch = nb * 256 + cin;
            const f32x4 ba = *(const f32x4*)(gab + ch), bx = *(const f32x4*)(gxb + ch), sp = *(const f32x4*)(sp8 + ch);
            const u32x2 xw = *(const u32x2*)(XCB + ((size_t)nb * MT + MP + srow) * 256 + cin);
            f32x4 a, b;
#pragma unroll
            for (int i = 0; i < 4; ++i) {
                const unsigned w = i < 2 ? xw.x : xw.y; const float xc = bf2f((unsigned short)((i & 1) ? (w >> 16) : (w & 0xffffu)));
                const float r = 1.0f / (1.0f + __expf(-(x[i] + ba[i]))), ig = 1.0f / (1.0f + __expf(-(y[i] + bx[i])));
                const float la = -r * sp[i], t2 = 2.0f * la;
                a[i] = la;
                const float poly = -t2 * (1.0f + t2 * (0.5f + t2 * (0.16666667f + t2 * (0.041666668f + t2 * (0.0083333338f + t2 * 0.0013888889f)))));
                const float em = t2 > -0.25f ? poly : 1.0f - __expf(t2);
                b[i] = sqrtf(em) * (ig * xc); }
            { u32x2 wa, wb; wa.x = cvt_pk_bf16(a[0], a[1]); wa.y = cvt_pk_bf16(a[2], a[3]); wb.x = cvt_pk_bf16(b[0], b[1]); wb.y = cvt_pk_bf16(b[2], b[3]);
              *(u32x2*)(AA + (size_t)(MP + srow) * D + ch) = wa; *(u32x2*)(BB + (size_t)(MP + srow) * D + ch) = wb; }
        }
    }
};

struct Args;
struct Args { const GAS float* in[N_IN]; GAS float* out; GAS unsigned char* ws;     int ph_lo, ph_hi, single, dupmask; float lam_init[2]; float rope_inv[32]; };

typedef const __attribute__((address_space(4))) Args* KArgs;
__device__ __forceinline__ KArgs kargs() { KArgs p = (KArgs)__builtin_amdgcn_kernarg_segment_ptr(); asm volatile("" : "+s"(p)); return p; }
__global__ void __launch_bounds__(NWAVES * 64, 2) fwd_kernel(Args args) {
    extern __shared__ __attribute__((aligned(16))) unsigned char lds[];
    LAS unsigned char* const ldsp = (LAS unsigned char*)lds;
    volatile LAS unsigned* const MISC = (volatile LAS unsigned*)(ldsp + MISC_OFF);
    const int tid = threadIdx.x; const int wave = __builtin_amdgcn_readfirstlane(tid >> 6);
    const int G = gridDim.x; const int bx = blockIdx.x; const int vcu = (G % 8 == 0) ? (bx % 8) * (G / 8) + bx / 8 : bx;
    const int gw = vcu * NWAVES + wave, NGW = G * NWAVES;
    const int NGT = NGW * 64;
    gu32* const ctl = (gu32*)((unsigned char*)args.ws + WS_CTL);
    for (int u = tid; u < (LDS_BYTES - LDSCTL_OFF) / 4; u += NWAVES * 64) ((LAS unsigned*)(ldsp + LDSCTL_OFF))[u] = 0u;
    __syncthreads();
    XcdBarrier bar; bar.bar = (unsigned*)(ctl + CW_BAR); bar.x = 0; bar.st = nullptr;
    if (args.single) bar = xcd_barrier_post((unsigned*)(ctl + CW_BAR), MISC + 8);
    const int lo = args.ph_lo, hi = args.ph_hi;
#ifndef PHM
#define PHM 0xFFFFFFFFu
#endif
#define EN(b) (((PHM) >> (b)) & 1u)
#define RUN(k) (lo <= (k) && (k) < hi)
#define SEAM() do { if (args.single) xcd_barrier(bar); } while (0)

#if PROBE_DUP
#define REP_BEGIN(k) for (int rep_ = 0, nrep_ = (args.dupmask >> (k)) & 1; rep_ <= nrep_; ++rep_) {
#define REP_END }
#define REP_DUMMY (rep_ < nrep_)
#else
#define REP_BEGIN(k) {
#define REP_END }
#define REP_DUMMY false
#endif
#define INP(i) ((const float*)ap->in[i])
#define PHASE_PTRS \
    unsigned ones_ = ~0u; asm volatile("" : "+s"(ones_)); int lane = (int)__builtin_amdgcn_mbcnt_hi(ones_, __builtin_amdgcn_mbcnt_lo(ones_, 0u)); asm volatile("" : "+v"(lane)); const int gt = gw * 64 + lane; (void)gt; const int ptid = wave * 64 + lane; (void)ptid; int pG = G, pbx = bx; asm volatile("" : "+s"(pG), "+s"(pbx));   \
    const KArgs ap = kargs(); unsigned char* const ws = (unsigned char*)ap->ws; float* const out = (float*)ap->out; (void)out; \
    float* const X = (float*)(ws + WS_X); (void)X; bf16_t* const XN = (bf16_t*)(ws + WS_XN); (void)XN; \
    bf16_t* const Qb = (bf16_t*)(ws + WS_Q); (void)Qb; bf16_t* const Kb = (bf16_t*)(ws + WS_K); (void)Kb; bf16_t* const Vb = (bf16_t*)(ws + WS_V); (void)Vb; bf16_t* const ON = (bf16_t*)(ws + WS_ON); (void)ON; \
    bf16_t* const Hb = (bf16_t*)(ws + WS_H); (void)Hb; float* const AA = (float*)(ws + WS_AA); (void)AA; float* const BB = (float*)(ws + WS_BB); (void)BB; \
    float* const ROPE = (float*)(ws + WS_ROPE); (void)ROPE; float* const SP8 = (float*)(ws + WS_SP8); (void)SP8; float* const SSQ0 = (float*)(ws + WS_SSQ); (void)SSQ0; float* const SSQ1 = SSQ0 + (size_t)MT * 16; (void)SSQ1; \
    float* const CP = (float*)(ws + WS_CP); (void)CP; float* const CH = (float*)(ws + WS_CH); (void)CH; \
    float* const PO = (float*)(ws + WS_PO); (void)PO; float* const PML = (float*)(ws + WS_PML); (void)PML; \
    bf16_t* const Wb = (bf16_t*)(ws + WS_W); (void)Wb; \
    bf16_t* const Gb = Qb; (void)Gb; bf16_t* const Ub = Kb; (void)Ub; bf16_t* const XCB = Vb; (void)XCB; bf16_t* const HG = ON; (void)HG;

    if (EN(0) && RUN(0)) {
            REP_BEGIN(0)
            PHASE_PTRS
        LAS float* scr = (LAS float*)(ldsp + RING_OFF + wave * 16384);
        constexpr int I_AIN = 16 * 96, I_SQ = 16 * 32, I_BIN = 16 * 64, I_G = 4 * 8, I_1 = 16 * 128, I_2 = 64 * 32;
        constexpr int NITEMS = 2 * I_AIN + 2 * I_SQ + I_BIN + 8 * I_G + I_SQ + I_AIN + I_SQ + 4 * I_1 + 4 * I_2;
        for (int it = gw; it < NITEMS; it += NGW) {
            int r = it;
            if (r < 2 * I_AIN) { const int li = r / I_AIN, q = r % I_AIN, kb = q / 96, nb = q % 96;
                tr_item(INP(IN_AWIN) + (size_t)li * 1024 * 3072, 3072, 64 * kb, 32 * nb, Wb + W_AIN + (size_t)li * 3072 * 1024, 1024, qkv_phys_row(32 * nb), scr, lane, INP(IN_GMIX) + 3 * li * D); continue; } r -= 2 * I_AIN;
            if (r < 2 * I_SQ) { const int li = r / I_SQ, q = r % I_SQ, kb = q / 32, nb = q % 32;
                tr_item(INP(IN_AWOUT) + (size_t)li * 1024 * 1024, 1024, 64 * kb, 32 * nb, Wb + W_AOUT + (size_t)li * 1024 * 1024, 1024, 32 * nb, scr, lane); continue; } r -= 2 * I_SQ;
            if (r < I_BIN) { const int kb = r / 64, nb = r % 64;
                tr_item(INP(IN_BWIN), 2048, 64 * kb, 32 * nb, Wb + W_BIN, 1024, 32 * nb, scr, lane, INP(IN_GMIX) + 1 * D); continue; } r -= I_BIN;
            if (r < 8 * I_G) { const int mi = r / I_G, q = r % I_G, gk = mi >> 2, blk = mi & 3, kb = q / 8, d0 = q % 8;
                const float* src = (gk == 0 ? INP(IN_BGAW) : INP(IN_BGXW)) + (size_t)blk * 256 * 256;
                tr_item(src, 256, 64 * kb, 32 * d0, Wb + W_BG, 256, (blk * 2 + (d0 >> 2)) * 256 + gk * 128 + (d0 & 3) * 32, scr, lane); continue; } r -= 8 * I_G;
            if (r < I_SQ) { const int kb = r / 32, nb = r % 32; tr_item(INP(IN_BWOUT), 1024, 64 * kb, 32 * nb, Wb + W_BOUT, 1024, 32 * nb, scr, lane); continue; } r -= I_SQ;
            if (r < I_AIN) { const int kb = r / 96, nb = r % 96; tr_item(INP(IN_CWIN), 3072, 64 * kb, 32 * nb, Wb + W_CIN, 1024, qkv_phys_row(32 * nb), scr, lane, INP(IN_GMIX) + 2 * D); continue; } r -= I_AIN;
            if (r < I_SQ) { const int kb = r / 32, nb = r % 32; tr_item(INP(IN_CWOUT), 1024, 64 * kb, 32 * nb, Wb + W_COUT, 1024, 32 * nb, scr, lane); continue; } r -= I_SQ;
            if (r < 4 * I_1) { const int li = r / I_1, q = r % I_1, kb = q / 128, nb = q % 128;
                tr_item(INP(IN_W1) + (size_t)li * 1024 * 4096, 4096, 64 * kb, 32 * nb, Wb + W_1 + (size_t)li * 4096 * 1024, 1024, 32 * nb, scr, lane, INP(IN_GMLP) + li * D); continue; } r -= 4 * I_1;
            { const int li = r / I_2, q = r % I_2, kb = q / 32, nb = q % 32;
                tr_item(INP(IN_W2) + (size_t)li * 4096 * 1024, 1024, 64 * kb, 32 * nb, Wb + W_2 + (size_t)li * 1024 * 4096, 4096, 32 * nb, scr, lane); }
        }
        for (int i = gt; i < (SEQ + DSEQ) * 32; i += NGT) { const int tp = i >> 5, d = i & 31; const int pos = tp < SEQ ? tp : PAST + (tp - SEQ);
            const float ang = (float)pos * ap->rope_inv[d];
            ROPE[(size_t)tp * 64 + d] = cosf(ang); ROPE[(size_t)tp * 64 + 32 + d] = sinf(ang); }
        for (int i = gt; i < D; i += NGT) { const float lm = INP(IN_BLAM)[i]; SP8[i] = 8.0f * (fmaxf(-lm, 0.f) + log1pf(expf(-fabsf(lm)))); }
        for (int m0 = gw; m0 < MT; m0 += 2 * NGW) {
            f32x4 v[2][4];
#pragma unroll
            for (int k = 0; k < 2; ++k) { const int mrow = m0 + k * NGW;
                if (mrow < MT) { const float* src = mrow < MP ? INP(IN_XP) + (size_t)mrow * D : INP(IN_XS) + (size_t)(mrow - MP) * D;
#pragma unroll
                    for (int j = 0; j < 4; ++j) v[k][j] = ((const f32x4*)src + lane)[64 * j]; } }
#pragma unroll
            for (int k = 0; k < 2; ++k) { const int mrow = m0 + k * NGW;
                if (mrow < MT) { float s = 0.f;
#pragma unroll
                    for (int j = 0; j < 4; ++j) s += (v[k][j].x * v[k][j].x + v[k][j].y * v[k][j].y) + (v[k][j].z * v[k][j].z + v[k][j].w * v[k][j].w);
                    const float tot = wave_sum(s);
                    if (lane < 16) SSQ1[(size_t)mrow * 16 + lane] = lane == 0 ? tot : 0.f;
                    unsigned long long* o8 = (unsigned long long*)(XN + (size_t)mrow * D) + lane;
#pragma unroll
                    for (int j = 0; j < 4; ++j) o8[64 * j] = (unsigned long long)cvt_pk_bf16(v[k][j].x, v[k][j].y) | ((unsigned long long)cvt_pk_bf16(v[k][j].z, v[k][j].w) << 32); } }
        }
        SEAM();
            REP_END
    }

    for (int L = 0; L < 4; ++L) {
        const int kind = L % 3, idx = L / 3, base = 1 + 16 * L;
        if (kind == 0) {
            if (EN(1) && RUN(base + 0)) {
            REP_BEGIN(1)
            PHASE_PTRS
                pg8::Gemm g{XN, Wb + W_AIN + (size_t)idx * 3072 * 1024, MP, 3072, 1024, 0, 0}; pg8::StaticOrder S; S.init(MP, 3072, pG, pbx);
                pg8::EpiQKV<true> E{Qb, ACT_BF / 2, INP(IN_AQG) + idx * 64, INP(IN_AKG) + idx * 64, ROPE,
                    out + OUT_AKP + (size_t)idx * MP * D, out + OUT_AKS + (size_t)idx * MS * D, OUT_AVP - OUT_AKP, OUT_AVS - OUT_AKS, 0, (const LAS float*)(ldsp + RS_OFF)};
                fill_row_factors(ldsp, S, SSQ1, ptid);
                pg8::gemm_phase<pg8::EpiQKV<true>, pg8::StaticOrder, true, true>(ldsp + RING_OFF, g, S, E, ptid);
                { SkQKV<true> F{Qb, ACT_BF / 2, INP(IN_AQG) + idx * 64, INP(IN_AKG) + idx * 64, ROPE, out + OUT_AKS + (size_t)idx * MS * D, OUT_AVS - OUT_AKS, SSQ1};
                  skinny_gemm(ldsp + RING_OFF, XN + (size_t)MP * D, D, Wb + W_AIN + (size_t)idx * 3072 * 1024, 1024, 48, F, vcu, pG, wave, lane); }
                SEAM();
            REP_END
            }
            if (EN(2) && RUN(base + 1)) {
            REP_BEGIN(2)
            PHASE_PTRS
                const float* lp = INP(IN_ALAM) + idx * 256;
                const float s1 = wave_sum(lp[lane] * lp[64 + lane]), s2 = wave_sum(lp[128 + lane] * lp[192 + lane]);
                const float lam_init = ap->lam_init[idx], lam = expf(s1) - expf(s2) + lam_init;
                {
                    asm volatile("s_waitcnt vmcnt(0) lgkmcnt(0)" ::: "memory"); __syncthreads();
                    int ptid2 = ptid; asm volatile("" : "+v"(ptid2));
                    const attn_body::bf16* Qa = (const attn_body::bf16*)Qb; const attn_body::bf16* Ka = (const attn_body::bf16*)Kb; const attn_body::bf16* Va = (const attn_body::bf16*)Vb;
                    attn_body::bf16* O4 = (attn_body::bf16*)(ws + WS_H);
                    const float* sg = INP(IN_ASUB) + idx * 128;
                    const int ngrp = NB * 8 * 8, nper = (ngrp + pG - 1) / pG;
                    const int lane2 = ptid2 & 63;
                    const int dslot = vcu % (nper + 1);
                    for (int gj = 0; gj <= nper; ++gj) {
                        if (gj == dslot) {
                            int dl = lane2; asm volatile("" : "+v"(dl));
                            const int g4 = dl >> 4, c16 = dl & 15;
                            for (int item = gw; item < 128 * NSPLIT; item += NGW) {
                                const int bh = item / NSPLIT, sp = item % NSPLIT, b = bh >> 3, h = bh & 7;
                                AttnItem it; it.q = Qb + (size_t)(MP + b * 16) * D + h * 128;
                                it.kc = INP(IN_CAK) + ((size_t)(idx * NB + b) * PAST) * D + h * 128; it.vc = INP(IN_CAV) + ((size_t)(idx * NB + b) * PAST) * D + h * 128;
                                it.kn = Kb + (size_t)(MP + b * 16) * D + h * 128; it.vn = Vb + (size_t)(MP + b * 16) * D + h * 128; it.btab = nullptr;
                                it.cstride = D; it.n_cache = PAST; it.k_lo = sp * 256; it.k_hi = (sp == NSPLIT - 1) ? PAST + 32 : (sp + 1) * 256; it.n_total = PAST + DSEQ; it.rel0 = 0; it.head = 0;
                                float m[2], l[2]; f32x4 o[2][8];
                                attn16_core<2, 128>(it, dl, m, l, o);
#pragma unroll
                                for (int c = 0; c < 2; ++c) { float* po = PO + (((size_t)item * 2 + c) * 16 + c16) * 128 + 4 * g4;
#pragma unroll
                                    for (int e = 0; e < 8; ++e) *(f32x4*)(po + e * 16) = o[c][e];
                                    if (g4 == 0) { float* pm = PML + (((size_t)item * 2 + c) * 16 + c16) * 2; pm[0] = m[c]; pm[1] = l[c]; } }
                            }
                            asm volatile("s_waitcnt vmcnt(0) lgkmcnt(0)" ::: "memory"); __syncthreads();
                        }
                        const int gid = vcu * nper + gj; if (gj >= nper || gid >= ngrp) continue;
                        int ln3 = lane2; asm volatile("" : "+v"(ln3));
                        const int ptid3 = wave * 64 + ln3, csub = ln3 & 7, cvh = csub >> 2, cd0 = (csub & 3) * 16, crr = ln3 >> 3;
                        const int bh = gid >> 3, sel = (gid >> 2) & 1, jq = gid & 3, b = bh >> 3, h = bh & 7;
                        const int qb = sel == 0 ? (jq == 0 ? 0 : (jq == 1 ? 7 : (jq == 2 ? 2 : 5))) : (jq == 0 ? 1 : (jq == 1 ? 6 : (jq == 2 ? 3 : 4)));
                        for (int c = 0; c < 2; ++c)
                            attn_body::attn_unit<8, 63, 2048, 0, 1>(b, h * 2 + c, h * 2, h * 4 + c * 2, qb, Qa, Ka, Va, O4, (char*)lds + RING_OFF, ptid3, nullptr);
                        asm volatile("s_waitcnt vmcnt(0)" ::: "memory");
                        const bf16_t* O4r = (const bf16_t*)O4;
                        float gg[16];
#pragma unroll
                        for (int i = 0; i < 16; ++i) gg[i] = sg[cvh * 64 + cd0 + i] * (1.0f - lam_init);
                        u32x4 ra[4][4];
#pragma unroll
                        for (int ps = 0; ps < 4; ++ps) {
                            const int row = b * SEQ + qb * 256 + wave * 32 + ps * 8 + crr;
                            const bf16_t* p0 = O4r + (size_t)row * 2048 + (h * 4 + cvh) * 64 + cd0; const bf16_t* p1 = p0 + 128;
                            ra[ps][0] = *(const u32x4*)p0; ra[ps][1] = *(const u32x4*)(p0 + 8); ra[ps][2] = *(const u32x4*)p1; ra[ps][3] = *(const u32x4*)(p1 + 8); }
#pragma unroll
                        for (int ps = 0; ps < 4; ++ps) {
                            const int row = b * SEQ + qb * 256 + wave * 32 + ps * 8 + crr;
                            const u32x4 a0 = ra[ps][0], a1 = ra[ps][1], b0 = ra[ps][2], b1 = ra[ps][3];
                            float o[16]; float ss = 0.f;
#pragma unroll
                            for (int i = 0; i < 16; ++i) { const unsigned wa = i < 8 ? a0[(i >> 1) & 3] : a1[(i >> 1) & 3], wb = i < 8 ? b0[(i >> 1) & 3] : b1[(i >> 1) & 3];
                                const float fa = bf2f((unsigned short)((i & 1) ? (wa >> 16) : (wa & 0xffffu))), fb = bf2f((unsigned short)((i & 1) ? (wb >> 16) : (wb & 0xffffu)));
                                o[i] = fa - lam * fb; ss += o[i] * o[i]; }
                            ss += swz_xor<1>(ss); ss += swz_xor<2>(ss); ss += swz_xor<4>(ss);
                            const float rs = 1.0f / sqrtf(ss * (1.0f / 128.0f) + EPS);
                            float y0[8], y1[8];
#pragma unroll
                            for (int i = 0; i < 8; ++i) { y0[i] = o[i] * rs * gg[i]; y1[i] = o[8 + i] * rs * gg[8 + i]; }
                            bf16_t* op = ON + (size_t)row * D + h * 128 + cvh * 64 + cd0;
                            *(u32x4*)op = pg8::pack8(y0); *(u32x4*)(op + 8) = pg8::pack8(y1);
                        }
                    }
                }
                SEAM();
            REP_END
            }
            if (EN(3) && RUN(base + 2)) {
            REP_BEGIN(3)
            PHASE_PTRS
                const float* lp = INP(IN_ALAM) + idx * 256;
                const float s1 = wave_sum(lp[lane] * lp[64 + lane]), s2 = wave_sum(lp[128 + lane] * lp[192 + lane]);
                const float lam_init = ap->lam_init[idx], lam = expf(s1) - expf(s2) + lam_init;
                const float* sg = INP(IN_ASUB) + idx * 128;
                for (int id = gw; id < MS * 8; id += NGW) {
                    const int s = id >> 3, h = id & 7, b = s >> 4, q = s & 15, bh = b * 8 + h;
                    f32x2 oc[2];
#pragma unroll
                    for (int c = 0; c < 2; ++c) {
                        f32x2 ml[NSPLIT], pv[NSPLIT];
#pragma unroll
                        for (int sp = 0; sp < NSPLIT; ++sp) { const size_t pi = (((size_t)bh * NSPLIT + sp) * 2 + c) * 16 + q; ml[sp] = *(const f32x2*)(PML + pi * 2); pv[sp] = *(const f32x2*)(PO + pi * 128 + 2 * lane); }
                        __builtin_amdgcn_sched_barrier(0);
                        float mx = -1e30f;
#pragma unroll
                        for (int sp = 0; sp < NSPLIT; ++sp) mx = fmaxf(mx, ml[sp].x);
                        float lt = 0.f; f32x2 acc = (f32x2){0.f, 0.f};
#pragma unroll
                        for (int sp = 0; sp < NSPLIT; ++sp) { const float w = __builtin_amdgcn_exp2f(ml[sp].x - mx); lt += ml[sp].y * w; acc = acc + pv[sp] * w; }
                        oc[c] = acc * (1.0f / lt);
                    }
                    const f32x2 ov = oc[0] - oc[1] * lam;
                    const float ss = wave_sum(ov.x * ov.x + ov.y * ov.y);
                    const float rs = (1.0f - lam_init) / sqrtf(ss * (1.0f / 128.0f) + EPS);
                    const f32x2 gg = *(const f32x2*)(sg + 2 * lane);
                    *(unsigned*)(ON + (size_t)(MP + s) * D + h * 128 + 2 * lane) = cvt_pk_bf16(ov.x * rs * gg.x, ov.y * rs * gg.y);
                }
                SEAM();
            REP_END
            }
            if (EN(4) && RUN(base + 3)) {
            REP_BEGIN(4)
            PHASE_PTRS
                pg8::Gemm g{ON, Wb + W_AOUT + (size_t)idx * 1024 * 1024, MP, 1024, 1024, 0, 0}; const bf16_t* skA = ON + (size_t)MP * D; const bf16_t* skB = Wb + W_AOUT + (size_t)idx * 1024 * 1024; const int skK = 1024; pg8::StaticOrder S; S.init(MP, 1024, pG, pbx);
                pg8::EpiResAdd E{XN, nullptr, nullptr, SSQ0};
                pg8::gemm_phase<pg8::EpiResAdd, pg8::StaticOrder, true, true>(ldsp + RING_OFF, g, S, E, ptid);
                { SkResAdd F{XN, nullptr, nullptr, SSQ0}; skinny_gemm(ldsp + RING_OFF, skA, skK, skB, skK, 16, F, vcu, pG, wave, lane); }
                SEAM();
            REP_END
            }
        } else if (kind == 1) {
            if (EN(5) && RUN(base + 0)) {
            REP_BEGIN(5)
            PHASE_PTRS
                pg8::Gemm g{XN, Wb + W_BIN, MP, 2048, 1024, 0, 0}; pg8::StaticOrder S; S.init(MP, 2048, pG, pbx);
                pg8::EpiBin E{Gb, Ub, INP(IN_BBIN), out + OUT_BCP, out + OUT_BCS, (const LAS float*)(ldsp + RS_OFF)};
                fill_row_factors(ldsp, S, SSQ1, ptid);
                pg8::gemm_phase<pg8::EpiBin, pg8::StaticOrder, true, true>(ldsp + RING_OFF, g, S, E, ptid);
                { SkBin F{Gb, Ub, INP(IN_BBIN), out + OUT_BCS, SSQ1}; skinny_gemm(ldsp + RING_OFF, XN + (size_t)MP * D, D, Wb + W_BIN, 1024, 32, F, vcu, pG, wave, lane); }
                SEAM();
            REP_END
            }
            if (EN(6) && RUN(base + 1)) {
            REP_BEGIN(6)
            PHASE_PTRS
                const float* cw = INP(IN_BCW); const float* cb = INP(IN_BCB); const float* hist = INP(IN_SBC);
                const int ch0 = (gt & 127) * 8;
                float wj[4][8], bs[8];
#pragma unroll
                for (int c = 0; c < 8; ++c) { bs[c] = cb[ch0 + c];
#pragma unroll
                    for (int jj = 0; jj < 4; ++jj) wj[jj][c] = cw[jj * D + ch0 + c]; }
                for (int rbk = gt >> 7; rbk < MT / 16; rbk += NGT >> 7) {
                    const int row0 = rbk * 16; const bool pr = row0 < MP; const int t0 = pr ? (row0 & (SEQ - 1)) : 0; const int b = pr ? (row0 >> 11) : ((row0 - MP) >> 4);
                    u32x4 wr_[19];
#pragma unroll
                    for (int r = 0; r < 16; ++r) wr_[3 + r] = *(const u32x4*)(Ub + (size_t)(row0 + r) * D + ch0);
                    float um[3][8];
                    if (t0 > 0) {
#pragma unroll
                        for (int k = 0; k < 3; ++k) { const u32x4 w = *(const u32x4*)(Ub + (size_t)(row0 - 3 + k) * D + ch0);
                            um[k][0] = bf2f(w.x & 0xffff); um[k][1] = bf2f(w.x >> 16); um[k][2] = bf2f(w.y & 0xffff); um[k][3] = bf2f(w.y >> 16); um[k][4] = bf2f(w.z & 0xffff); um[k][5] = bf2f(w.z >> 16); um[k][6] = bf2f(w.w & 0xffff); um[k][7] = bf2f(w.w >> 16); }
                    } else if (!pr) {
#pragma unroll
                        for (int k = 0; k < 3; ++k) { const float* hp = hist + (size_t)(b * 3 + k) * D + ch0;
#pragma unroll
                            for (int c = 0; c < 8; ++c) um[k][c] = hp[c]; }
                    } else {
#pragma unroll
                        for (int k = 0; k < 3; ++k)
#pragma unroll
                            for (int c = 0; c < 8; ++c) um[k][c] = 0.f;
                    }
#pragma unroll
                    for (int r = 0; r < 16; ++r) { const u32x4 w = wr_[3 + r]; float u0[8], acc[8];
                        u0[0] = bf2f(w.x & 0xffff); u0[1] = bf2f(w.x >> 16); u0[2] = bf2f(w.y & 0xffff); u0[3] = bf2f(w.y >> 16); u0[4] = bf2f(w.z & 0xffff); u0[5] = bf2f(w.z >> 16); u0[6] = bf2f(w.w & 0xffff); u0[7] = bf2f(w.w >> 16);
#pragma unroll
                        for (int c = 0; c < 8; ++c) { acc[c] = bs[c] + um[0][c] * wj[0][c] + um[1][c] * wj[1][c] + um[2][c] * wj[2][c] + u0[c] * wj[3][c]; um[0][c] = um[1][c]; um[1][c] = um[2][c]; um[2][c] = u0[c]; }
                        *(u32x4*)(XCB + ((size_t)(ch0 >> 8) * MT + row0 + r) * 256 + (ch0 & 255)) = pg8::pack8(acc); }
                }
                SEAM();
            REP_END
            }
            if (EN(7) && RUN(base + 2)) {
            REP_BEGIN(7)
            PHASE_PTRS
                pg8::Gemm g{XCB, Wb + W_BG, MP, 2048, 256, 1, (size_t)MT * 256 * 2}; pg8::StaticOrder S; S.init(MP, 2048, pG, pbx);
                pg8::EpiGates E{XCB, INP(IN_BGAB), INP(IN_BGXB), SP8, (bf16_t*)AA, (bf16_t*)BB};
                pg8::gemm_phase<pg8::EpiGates, pg8::StaticOrder, true, true>(ldsp + RING_OFF, g, S, E, ptid);
                { SkGates F{XCB, INP(IN_BGAB), INP(IN_BGXB), SP8, (bf16_t*)AA, (bf16_t*)BB}; skinny_gemm(ldsp + RING_OFF, XCB + (size_t)MP * 256, 256, Wb + W_BG, 256, 32, F, vcu, pG, wave, lane); }
                SEAM();
            REP_END
            }
            if (EN(8) && RUN(base + 3)) {
            REP_BEGIN(8)
            PHASE_PTRS
            const bf16_t* const LAq = (const bf16_t*)AA; const bf16_t* const BQq = (const bf16_t*)BB;
                for (int id = gw; id < NB * 32 * 4; id += NGW) {
                    const int cq = id & 3, ck = (id >> 2) & 31, b = id >> 7, ch = cq * 256 + lane * 4; const size_t r0 = (size_t)(b * SEQ + ck * 64) * D + ch;
                    f32x4 P = (f32x4){1.f, 1.f, 1.f, 1.f}, Hc = (f32x4){0.f, 0.f, 0.f, 0.f};
                    for (int t0 = 0; t0 < 64; t0 += 16) { u32x2 a[16], bb[16];
#pragma unroll
                        for (int j = 0; j < 16; ++j) { a[j] = *(const u32x2*)(LAq + r0 + (size_t)(t0 + j) * D); bb[j] = *(const u32x2*)(BQq + r0 + (size_t)(t0 + j) * D); }
                        __builtin_amdgcn_sched_barrier(0);
#pragma unroll
                        for (int j = 0; j < 16; ++j) {
                            const f32x4 la = (f32x4){bf2f(a[j].x & 0xffff), bf2f(a[j].x >> 16), bf2f(a[j].y & 0xffff), bf2f(a[j].y >> 16)};
                            const f32x4 bv = (f32x4){bf2f(bb[j].x & 0xffff), bf2f(bb[j].x >> 16), bf2f(bb[j].y & 0xffff), bf2f(bb[j].y >> 16)};
                            const f32x4 av = (f32x4){__expf(la.x), __expf(la.y), __expf(la.z), __expf(la.w)};
                            P = P * av; Hc = av * Hc + bv; }
                        __builtin_amdgcn_sched_barrier(0); }
                    *(f32x4*)(CP + (size_t)(b * 32 + ck) * D + ch) = P; *(f32x4*)(CH + (size_t)(b * 32 + ck) * D + ch) = Hc;
                }
                SEAM();
            REP_END
            }
            if (EN(9) && RUN(base + 4)) {
            REP_BEGIN(9)
            PHASE_PTRS
            const bf16_t* const LAq = (const bf16_t*)AA; const bf16_t* const BQq = (const bf16_t*)BB;
                for (int id = gw; id < NB * 32 * 4; id += NGW) {
                    const int cq = id & 3, ck = (id >> 2) & 31, b = id >> 7, ch = cq * 256 + lane * 4; const size_t r0 = (size_t)(b * SEQ + ck * 64) * D + ch;
                    f32x4 h = (f32x4){0.f, 0.f, 0.f, 0.f};
                    for (int k0 = 0; k0 < ck; k0 += 8) {
                        f32x4 cp[8], chh[8];
#pragma unroll
                        for (int j = 0; j < 8; ++j) { const int kk = (k0 + j) < 32 ? (k0 + j) : 31; cp[j] = *(const f32x4*)(CP + (size_t)(b * 32 + kk) * D + ch); chh[j] = *(const f32x4*)(CH + (size_t)(b * 32 + kk) * D + ch); }
                        __builtin_amdgcn_sched_barrier(0);
#pragma unroll
                        for (int j = 0; j < 8; ++j) if (k0 + j < ck) h = cp[j] * h + chh[j];
                        __builtin_amdgcn_sched_barrier(0); }
                    for (int t0 = 0; t0 < 64; t0 += 8) { u32x2 a[8], bb[8], gg[8];
#pragma unroll
                        for (int j = 0; j < 8; ++j) { a[j] = *(const u32x2*)(LAq + r0 + (size_t)(t0 + j) * D); bb[j] = *(const u32x2*)(BQq + r0 + (size_t)(t0 + j) * D); gg[j] = *(const u32x2*)(Gb + r0 + (size_t)(t0 + j) * D); }
                        __builtin_amdgcn_sched_barrier(0);
#pragma unroll
                        for (int j = 0; j < 8; ++j) {
                            const f32x4 la = (f32x4){bf2f(a[j].x & 0xffff), bf2f(a[j].x >> 16), bf2f(a[j].y & 0xffff), bf2f(a[j].y >> 16)};
                            const f32x4 bv = (f32x4){bf2f(bb[j].x & 0xffff), bf2f(bb[j].x >> 16), bf2f(bb[j].y & 0xffff), bf2f(bb[j].y >> 16)};
                            const f32x4 gv = (f32x4){bf2f(gg[j].x & 0xffff), bf2f(gg[j].x >> 16), bf2f(gg[j].y & 0xffff), bf2f(gg[j].y >> 16)};
                            const f32x4 av = (f32x4){__expf(la.x), __expf(la.y), __expf(la.z), __expf(la.w)};
                            h = av * h + bv; const f32x4 y = h * gv;
                            u32x2 w; w.x = cvt_pk_bf16(y.x, y.y); w.y = cvt_pk_bf16(y.z, y.w); *(u32x2*)(HG + r0 + (size_t)(t0 + j) * D) = w; } }
                    if (ck == 31) *(f32x4*)(out + OUT_BHP + (size_t)b * D + ch) = h;
                }
                for (int id = gw; id < NB * 4; id += NGW) {
                    const int cq = id & 3, b = id >> 2, ch = cq * 256 + lane * 4; const size_t r0 = (size_t)(MP + b * DSEQ) * D + ch;
                    f32x4 h = *(const f32x4*)(INP(IN_SBH) + (size_t)b * D + ch);
                    u32x2 sa[DSEQ], sb[DSEQ], sg[DSEQ];
#pragma unroll
                    for (int j = 0; j < DSEQ; ++j) { sa[j] = *(const u32x2*)(LAq + r0 + (size_t)j * D); sb[j] = *(const u32x2*)(BQq + r0 + (size_t)j * D); sg[j] = *(const u32x2*)(Gb + r0 + (size_t)j * D); }
                    __builtin_amdgcn_sched_barrier(0);
#pragma unroll
                    for (int j = 0; j < DSEQ; ++j) { const u32x2 a = sa[j], bb = sb[j], gg = sg[j];
                        const f32x4 av = (f32x4){__expf(bf2f(a.x & 0xffff)), __expf(bf2f(a.x >> 16)), __expf(bf2f(a.y & 0xffff)), __expf(bf2f(a.y >> 16))};
                        const f32x4 bv = (f32x4){bf2f(bb.x & 0xffff), bf2f(bb.x >> 16), bf2f(bb.y & 0xffff), bf2f(bb.y >> 16)};
                        const f32x4 gv = (f32x4){bf2f(gg.x & 0xffff), bf2f(gg.x >> 16), bf2f(gg.y & 0xffff), bf2f(gg.y >> 16)};
                        h = av * h + bv; const f32x4 y = h * gv; u32x2 w; w.x = cvt_pk_bf16(y.x, y.y); w.y = cvt_pk_bf16(y.z, y.w); *(u32x2*)(HG + r0 + (size_t)j * D) = w; }
                    *(f32x4*)(out + OUT_BHS + (size_t)b * D + ch) = h;
                }
                SEAM();
            REP_END
            }
            if (EN(10) && RUN(base + 5)) {
            REP_BEGIN(10)
            PHASE_PTRS
                pg8::Gemm g{HG, Wb + W_BOUT, MP, 1024, 1024, 0, 0}; const bf16_t* skA = HG + (size_t)MP * D; const bf16_t* skB = Wb + W_BOUT; const int skK = 1024; pg8::StaticOrder S; S.init(MP, 1024, pG, pbx);
                pg8::EpiResAdd E{XN, nullptr, nullptr, SSQ0};
                pg8::gemm_phase<pg8::EpiResAdd, pg8::StaticOrder, true, true>(ldsp + RING_OFF, g, S, E, ptid);
                { SkResAdd F{XN, nullptr, nullptr, SSQ0}; skinny_gemm(ldsp + RING_OFF, skA, skK, skB, skK, 16, F, vcu, pG, wave, lane); }
                SEAM();
            REP_END
            }
        } else {
            if (EN(11) && RUN(base + 0)) {
            REP_BEGIN(11)
            PHASE_PTRS
                pg8::Gemm g{XN, Wb + W_CIN, MP, 3072, 1024, 0, 0}; pg8::StaticOrder S; S.init(MP, 3072, pG, pbx);
                pg8::EpiQKV<false> E{Qb, ACT_BF / 2, INP(IN_CQG), INP(IN_CKG), ROPE, out + OUT_CKP, out + OUT_CKS, OUT_CVP - OUT_CKP, OUT_CVS - OUT_CKS, SEQ - CWIN, (const LAS float*)(ldsp + RS_OFF)};
                fill_row_factors(ldsp, S, SSQ1, ptid);
                pg8::gemm_phase<pg8::EpiQKV<false>, pg8::StaticOrder, true, true>(ldsp + RING_OFF, g, S, E, ptid);
                { SkQKV<false> F{Qb, ACT_BF / 2, INP(IN_CQG), INP(IN_CKG), ROPE, out + OUT_CKS, OUT_CVS - OUT_CKS, SSQ1};
                  skinny_gemm(ldsp + RING_OFF, XN + (size_t)MP * D, D, Wb + W_CIN, 1024, 48, F, vcu, pG, wave, lane); }
                SEAM();
            REP_END
            }
            if (EN(12) && RUN(base + 1)) {
            REP_BEGIN(12)
            PHASE_PTRS
                const int g4 = lane >> 4, c16 = lane & 15; const float* tab = INP(IN_CBIAS);
                if (vcu < NB * 16) {
                    const int b = vcu >> 4, h = vcu & 15;
                    AttnItem it; it.q = Qb + (size_t)(MP + b * 16) * D + h * 64;
                    it.kc = INP(IN_CCK) + ((size_t)b * CWIN) * D + h * 64; it.vc = INP(IN_CCV) + ((size_t)b * CWIN) * D + h * 64;
                    it.kn = Kb + (size_t)(MP + b * 16) * D + h * 64; it.vn = Vb + (size_t)(MP + b * 16) * D + h * 64; it.btab = tab;
                    it.cstride = D; it.n_cache = CWIN; it.k_lo = 64 * wave; it.k_hi = 64 * (wave + 1) + (wave == NWAVES - 1 ? 32 : 0); it.n_total = CWIN + DSEQ; it.rel0 = CWIN; it.head = h;
                    float m[1], l[1]; f32x4 o[1][4];
                    attn16_core<1, 64>(it, lane, m, l, o);
                    LAS float* px = (LAS float*)(ldsp + RING_OFF); LAS float* pml = px + NWAVES * 1024;
#pragma unroll
                    for (int e = 0; e < 4; ++e) *(LAS f32x4*)(px + wave * 1024 + lane * 16 + e * 4) = o[0][e];
                    if (g4 == 0) { pml[(wave * 16 + c16) * 2] = m[0]; pml[(wave * 16 + c16) * 2 + 1] = l[0]; }
                    asm volatile("s_waitcnt lgkmcnt(0)" ::: "memory"); __syncthreads();
                    if (wave == 0) {
                        float mx = -1e30f;
#pragma unroll
                        for (int w = 0; w < NWAVES; ++w) mx = fmaxf(mx, pml[(w * 16 + c16) * 2]);
                        float lt = 0.f; f32x4 acc[4];
#pragma unroll
                        for (int e = 0; e < 4; ++e) acc[e] = (f32x4){0.f, 0.f, 0.f, 0.f};
#pragma unroll
                        for (int w = 0; w < NWAVES; ++w) { const float sc = __builtin_amdgcn_exp2f(pml[(w * 16 + c16) * 2] - mx); lt += pml[(w * 16 + c16) * 2 + 1] * sc;
#pragma unroll
                            for (int e = 0; e < 4; ++e) acc[e] = acc[e] + *(const LAS f32x4*)(px + w * 1024 + lane * 16 + e * 4) * sc; }
                        const float il = 1.0f / lt; bf16_t* orow = ON + (size_t)(MP + b * 16 + c16) * D + h * 64 + 4 * g4;
#pragma unroll
                        for (int e = 0; e < 4; ++e) { const f32x4 v = acc[e] * il; u32x2 w; w.x = cvt_pk_bf16(v.x, v.y); w.y = cvt_pk_bf16(v.z, v.w); *(u32x2*)(orow + e * 16) = w; }
                    }
                }
                {
                    asm volatile("s_waitcnt vmcnt(0) lgkmcnt(0)" ::: "memory"); __syncthreads();
                    int ptid2 = ptid; asm volatile("" : "+v"(ptid2));
                    LAS float* tb = (LAS float*)(ldsp + RING_OFF + attn_body::ATTN_LDS_BYTES);
                    for (int i = ptid2; i < 16 * NTAB; i += NWAVES * 64) { const int hh = i / NTAB, r = i % NTAB; tb[hh * 260 + r] = (tab[r * 16 + hh] - tab[256 * 16 + hh]) * LOG2E; }
                    asm volatile("s_waitcnt vmcnt(0) lgkmcnt(0)" ::: "memory"); __syncthreads();
                    const attn_body::bf16* Qa = (const attn_body::bf16*)Qb; const attn_body::bf16* Ka = (const attn_body::bf16*)Kb; const attn_body::bf16* Va = (const attn_body::bf16*)Vb;
                    const int nper = (NB * 16 * 8 + pG - 1) / pG;
                    for (int ui = vcu * nper; ui < (vcu + 1) * nper && ui < NB * 16 * 8; ++ui) {
                        const int bh = ui >> 3, qb = 7 - (ui & 7), b = bh >> 4, h = bh & 15;
                        attn_body::attn_unit<8, 63, 1024, 1, 0>(b, h, h, h, qb, Qa, Ka, Va, (attn_body::bf16*)ON, (char*)lds + RING_OFF, ptid2, tb + h * 260);
                    }
                }
                SEAM();
            REP_END
            }
            if (EN(13) && RUN(base + 2)) {
            REP_BEGIN(13)
            PHASE_PTRS
                pg8::Gemm g{ON, Wb + W_COUT, MP, 1024, 1024, 0, 0}; const bf16_t* skA = ON + (size_t)MP * D; const bf16_t* skB = Wb + W_COUT; const int skK = 1024; pg8::StaticOrder S; S.init(MP, 1024, pG, pbx);
                pg8::EpiResAdd E{XN, nullptr, nullptr, SSQ0};
                pg8::gemm_phase<pg8::EpiResAdd, pg8::StaticOrder, true, true>(ldsp + RING_OFF, g, S, E, ptid);
                { SkResAdd F{XN, nullptr, nullptr, SSQ0}; skinny_gemm(ldsp + RING_OFF, skA, skK, skB, skK, 16, F, vcu, pG, wave, lane); }
                SEAM();
            REP_END
            }
        }
        if (EN(15) && RUN(base + 9)) {
            REP_BEGIN(15)
            PHASE_PTRS
            pg8::Gemm g{XN, Wb + W_1 + (size_t)L * 4096 * 1024, MP, FF, 1024, 0, 0}; pg8::StaticOrder S; S.init(MP, FF, pG, pbx);
            pg8::EpiRelu2 E{Hb, FF, (const LAS float*)(ldsp + RS_OFF)};
            fill_row_factors(ldsp, S, SSQ0, ptid);
            pg8::gemm_phase<pg8::EpiRelu2, pg8::StaticOrder, true, true>(ldsp + RING_OFF, g, S, E, ptid);
            { SkRelu2 F{Hb, SSQ0}; skinny_gemm(ldsp + RING_OFF, XN + (size_t)MP * D, D, Wb + W_1 + (size_t)L * 4096 * 1024, 1024, 64, F, vcu, pG, wave, lane); }
            SEAM();
            REP_END
        }
        if (EN(16) && RUN(base + 10)) {
            REP_BEGIN(16)
            PHASE_PTRS
            pg8::Gemm g{Hb, Wb + W_2 + (size_t)L * 1024 * 4096, MP, 1024, FF, 0, 0}; const bf16_t* skA = Hb + (size_t)MP * FF; const bf16_t* skB = Wb + W_2 + (size_t)L * 1024 * 4096; const int skK = FF; pg8::StaticOrder S; S.init(MP, 1024, pG, pbx);
            pg8::EpiResAdd E{XN, nullptr, nullptr, SSQ1};
            pg8::gemm_phase<pg8::EpiResAdd, pg8::StaticOrder, true, true>(ldsp + RING_OFF, g, S, E, ptid);
                { SkResAdd F{XN, nullptr, nullptr, SSQ1}; skinny_gemm(ldsp + RING_OFF, skA, skK, skB, skK, 16, F, vcu, pG, wave, lane); }
            SEAM();
            REP_END
        }
        if (EN(17) && RUN(base + 11)) {
            REP_BEGIN(17)
            PHASE_PTRS
            if (L == 3) {
                const float* gf = INP(IN_GFIN);
                f32x4 g0[2], g1[2];
#pragma unroll
                for (int hh = 0; hh < 2; ++hh) { g0[hh] = *(const f32x4*)(gf + hh * 512 + lane * 8); g1[hh] = *(const f32x4*)(gf + hh * 512 + lane * 8 + 4); }
                for (int mrow = gw; mrow < MT; mrow += NGW) {
                    const float rr = pg8::row_rstd(SSQ1, mrow);
                    float* yr = out + (mrow < MP ? OUT_YP + (size_t)mrow * D : OUT_YS + (size_t)(mrow - MP) * D);
#pragma unroll
                    for (int hh = 0; hh < 2; ++hh) { const u32x4 w = *(const u32x4*)(XN + (size_t)mrow * D + hh * 512 + lane * 8);
                        const f32x4 a = (f32x4){bf2f(w.x & 0xffff), bf2f(w.x >> 16), bf2f(w.y & 0xffff), bf2f(w.y >> 16)} * rr * g0[hh];
                        const f32x4 b = (f32x4){bf2f(w.z & 0xffff), bf2f(w.z >> 16), bf2f(w.w & 0xffff), bf2f(w.w >> 16)} * rr * g1[hh];
                        __builtin_nontemporal_store(a, (f32x4*)(yr + hh * 512 + lane * 8)); __builtin_nontemporal_store(b, (f32x4*)(yr + hh * 512 + lane * 8 + 4)); }
                }
            }
            REP_END
        }
    }
#undef RUN
#undef SEAM
}

#ifndef HOSTDUP
#define HOSTDUP 0ull
#endif
#ifndef MK_SINGLE
#define MK_SINGLE 1
#endif
static bool phase_valid(int id) {
    if (id == 0) return true;
    const int L = (id - 1) / 16, sub = (id - 1) % 16, kind = L % 3;
    if (L > 3) return false;
    if (sub >= 8) return sub == 9 || sub == 10 || (sub == 11 && L == 3);
    return sub < (kind == 0 ? 4 : (kind == 1 ? 6 : 3));
}
extern "C" void kernel_launch(void* const* d_in, const int* in_sizes, int n_in, void* d_out, int out_size, void* d_ws, size_t ws_size, hipStream_t stream) {
    static int grid = 0;
    if (grid == 0) {
        if (n_in != N_IN || (size_t)out_size != OUT_TOTAL || ws_size < WS_END || in_sizes[IN_XP] != MP * D || in_sizes[IN_CAK] != 2 * NB * PAST * D) {
            fprintf(stderr, "kernel_launch: unexpected shapes: n_in %d out %d ws %zu (need %zu)\n", n_in, out_size, ws_size, (size_t)WS_END); grid = -1; return; }
        int dev = 0, cus = 0, per_cu = 0;
        if (hipGetDevice(&dev) != hipSuccess || hipDeviceGetAttribute(&cus, hipDeviceAttributeMultiprocessorCount, dev) != hipSuccess) { fprintf(stderr, "kernel_launch: device query failed\n"); grid = -1; return; }
        if (hipFuncSetAttribute((const void*)fwd_kernel, hipFuncAttributeMaxDynamicSharedMemorySize, LDS_BYTES) != hipSuccess) { fprintf(stderr, "kernel_launch: hipFuncSetAttribute failed\n"); grid = -1; return; }
        if (hipOccupancyMaxActiveBlocksPerMultiprocessor(&per_cu, (const void*)fwd_kernel, NWAVES * 64, LDS_BYTES) != hipSuccess || per_cu < 1)
            fprintf(stderr, "kernel_launch: note: occupancy query reports %d workgroups per CU\n", per_cu);
        (void)hipGetLastError();
        grid = cus;
    }
    if (grid < 0) return;
    if (hipMemsetAsync((char*)d_ws + WS_CTL, 0, CTL_ZERO_BYTES, stream) != hipSuccess) { fprintf(stderr, "kernel_launch: memset failed\n"); return; }
    Args a{};
    for (int i = 0; i < N_IN; ++i) a.in[i] = (const GAS float*)d_in[i];
    a.out = (GAS float*)d_out; a.ws = (GAS unsigned char*)d_ws; a.dupmask = PROBE_DUP;
    for (int d = 0; d < 32; ++d) a.rope_inv[d] = (float)pow(10000.0, -(double)d / 32.0);
    a.lam_init[0] = (float)(0.8 - 0.6 * exp(-0.3 * 0.0)); a.lam_init[1] = (float)(0.8 - 0.6 * exp(-0.3 * 3.0));
    if (MK_SINGLE) {
        a.ph_lo = 0; a.ph_hi = 1 << 20; a.single = 1;
        hipLaunchKernelGGL(fwd_kernel, dim3(grid), dim3(NWAVES * 64), LDS_BYTES, stream, a);
    } else {
        for (int id = 0; id < 1 + 16 * 4; ++id) { if (!phase_valid(id)) continue;
            a.ph_lo = id; a.ph_hi = id + 1; a.single = 0;
            hipLaunchKernelGGL(fwd_kernel, dim3(grid), dim3(NWAVES * 64), LDS_BYTES, stream, a);
            if ((HOSTDUP >> id) & 1ull) hipLaunchKernelGGL(fwd_kernel, dim3(grid), dim3(NWAVES * 64), LDS_BYTES, stream, a); }
    }
    const hipError_t le = hipPeekAtLastError();
    if (le != hipSuccess) fprintf(stderr, "kernel_launch: launch failed: %s\n", hipGetErrorName(le));
}
```

```cpp
#include <hip/hip_runtime.h>
#include <cstdio>
#include <cstdint>
#include <cmath>

constexpr int D = 1024, NB = 16, SEQ = 2048, MP = NB * SEQ  , DSEQ = 16, MS = NB * DSEQ  , MT = MP + MS  ;
constexpr int PAST = 4096, FF = 4096, CWIN = 512, NTAB = 257;
constexpr float EPS = 1e-6f;
constexpr float LOG2E = 1.4426950408889634f;
constexpr float QSCALE = 0.125f * LOG2E;

namespace pg8 {
#define PG8_LAS __attribute__((address_space(3)))
typedef unsigned short bf16_t;
typedef short bf16x8 __attribute__((ext_vector_type(8)));
typedef float f32x4 __attribute__((ext_vector_type(4)));
typedef float f32x2 __attribute__((ext_vector_type(2)));
typedef unsigned u32x4 __attribute__((ext_vector_type(4)));
typedef unsigned u32x2 __attribute__((ext_vector_type(2)));
constexpr int BM = 256, BK = 64, HALF = 128, HTB = HALF * BK * 2  , STAGE_BYTES = 8 * HTB, NXCD = 8, WGM = 8;

__host__ __device__ __forceinline__ int lds_byte(int r, int c) { const int st = (r >> 4) * 2 + (c >> 5), rr = r & 15, cc = c & 31, ob = rr * 64 + cc * 2; return st * 1024 + (ob ^ (((ob >> 9) & 1) << 5)); }
__host__ __device__ __forceinline__ void stage_rc(int b, int& R, int& C) { const int st = b / 1024, sb = b % 1024, swz = sb ^ (((sb >> 9) & 1) << 5); R = (st >> 1) * 16 + swz / 64; C = (st & 1) * 32 + (swz % 64) / 2; }
__host__ __device__ __forceinline__ int perm32(int rho) { const int n = rho >> 4, i = rho & 15; return 8 * (i >> 2) + 4 * n + (i & 3); }

struct Unit { int pm, pn, ui; };
struct Gemm { const bf16_t* A; const bf16_t* Bt; int M, N, K; int a_shift; size_t a_blk;
    __device__ __forceinline__ size_t a_off(int pn) const { return (size_t)(pn >> a_shift) * a_blk; } };

struct StaticOrder {
    int nM, nN, nwg, G, c;
    __host__ __device__ void init(int M, int N, int G_, int c_) { nM = M / BM; nN = N / BM; nwg = nM * nN; G = G_; c = c_; }
    __host__ __device__ bool next(int i, Unit& u) const {
        const long L = (long)i * G + c; if (L >= nwg) return false;
        int wgid = (int)L; { const int q = nwg / NXCD, r = nwg % NXCD, xcd = wgid % NXCD, off = wgid / NXCD; wgid = (xcd < r ? xcd * (q + 1) : r * (q + 1) + (xcd - r) * q) + off; }
        const int nig = WGM * nN, gid = wgid / nig, fm = gid * WGM, gsz = (nM - fm) < WGM ? (nM - fm) : WGM;
        u.pm = fm + ((wgid % nig) % gsz); u.pn = (wgid % nig) / gsz; return true;
    }
    __device__ __forceinline__ void a_ready(const Unit&) const {}
    __device__ __forceinline__ void done(const Unit&) const {}
};

__device__ __forceinline__ unsigned cvt_pk_bf16(float lo, float hi) { typedef __bf16 bf2 __attribute__((ext_vector_type(2))); f32x2 v = {lo, hi}; bf2 b = __builtin_convertvector(v, bf2); return __builtin_bit_cast(unsigned, b); }
__device__ __forceinline__ u32x4 pack8(const float (&x)[8]) { u32x4 w; w.x = cvt_pk_bf16(x[0], x[1]); w.y = cvt_pk_bf16(x[2], x[3]); w.z = cvt_pk_bf16(x[4], x[5]); w.w = cvt_pk_bf16(x[6], x[7]); return w; }
template <int X> __device__ __forceinline__ float swz_xor(float v) { return __builtin_bit_cast(float, __builtin_amdgcn_ds_swizzle(__builtin_bit_cast(int, v), (X << 10) | 0x1F)); }
__device__ __forceinline__ float xadd32(float v) { const unsigned u = __builtin_bit_cast(unsigned, v); auto r = __builtin_amdgcn_permlane32_swap(u, u, false, false); return __builtin_bit_cast(float, (unsigned)r[0]) + __builtin_bit_cast(float, (unsigned)r[1]); }
__device__ __forceinline__ float xmax32(float v) { const unsigned u = __builtin_bit_cast(unsigned, v); auto r = __builtin_amdgcn_permlane32_swap(u, u, false, false); return fmaxf(__builtin_bit_cast(float, (unsigned)r[0]), __builtin_bit_cast(float, (unsigned)r[1])); }
__device__ __forceinline__ float bf2f(unsigned short h) { return __builtin_bit_cast(float, (unsigned)h << 16); }

__device__ __forceinline__ float row_rstd(const float* SSQ, int row) {
    const f32x4* p = (const f32x4*)(SSQ + (size_t)row * 16); const f32x4 a = (p[0] + p[1]) + (p[2] + p[3]);
    return 1.0f / sqrtf(((a.x + a.y) + (a.z + a.w)) * (1.0f / 1024.0f) + EPS); }

__device__ __forceinline__ void rows_rstd(const float* SSQ, int row0, int fq, float (&rr)[2][4]) {
    f32x4 t[2][4];
#pragma unroll
    for (int ai = 0; ai < 2; ++ai)
#pragma unroll
        for (int m = 0; m < 4; ++m) t[ai][m] = *(const f32x4*)(SSQ + (size_t)(row0 + ai * HALF + m * 16) * 16 + 4 * fq);
#pragma unroll
    for (int ai = 0; ai < 2; ++ai)
#pragma unroll
        for (int m = 0; m < 4; ++m) { float s = (t[ai][m].x + t[ai][m].y) + (t[ai][m].z + t[ai][m].w); s += swz_xor<16>(s); s = xadd32(s); rr[ai][m] = 1.0f / sqrtf(s * (1.0f / 1024.0f) + EPS); }
}
__device__ __forceinline__ void rows_rstd_lds(const PG8_LAS float* RS, const Unit& u, int rowin  , float (&rr)[2][4]) {
#pragma unroll
    for (int ai = 0; ai < 2; ++ai)
#pragma unroll
        for (int m = 0; m < 4; ++m) rr[ai][m] = RS[u.ui * 256 + ai * HALF + m * 16 + rowin];
}
template <bool ROPE> struct EpiQKV {
    static constexpr bool PERM = true, AFTER_DRAIN = false;
    bf16_t* Q; size_t qkv_stride  ; const float *qg, *kg, *rope; float *okp, *oks; size_t kvp_stride, kvs_stride  ; int t0; const PG8_LAS float* RS;
    __device__ __forceinline__ float* f32_dst(int kind, int row, int colb) const {
        float* p = nullptr;
        if (row < MP) { const int t = row & (SEQ - 1), b = row >> 11; if (t >= t0) p = okp + (size_t)(kind - 1) * kvp_stride + ((size_t)(b * (SEQ - t0) + (t - t0))) * D + colb; }
        else p = oks + (size_t)(kind - 1) * kvs_stride + (size_t)(row - MP) * D + colb;
        return p; }
    __device__ __forceinline__ void operator()(const f32x4 (&acc)[2][2][4][2], const Unit& u, int wr, int wc, int fr, int fq) const {
        const int kind = u.pn >> 2, hc = (u.pn & 3) * 4 + wc, j0 = 8 * fq, colb = hc * 64 + j0;
        bf16_t* dst = Q + (size_t)kind * qkv_stride;
        float rrs[2][4]; rows_rstd_lds(RS, u, wr * 64 + fr, rrs);
        const int rowb = u.pm * BM + wr * 64 + fr;
        if (kind < 2) {
            const float* gp = kind == 0 ? qg : kg; const float qs = kind == 0 ? QSCALE : 1.0f;
            float g1[8], g2[8];
            { const f32x4 a = *(const f32x4*)(gp + j0), b = *(const f32x4*)(gp + j0 + 4), c = *(const f32x4*)(gp + 32 + j0), d = *(const f32x4*)(gp + 36 + j0);
#pragma unroll
              for (int i = 0; i < 4; ++i) { g1[i] = a[i] * qs; g1[4 + i] = b[i] * qs; g2[i] = c[i] * qs; g2[4 + i] = d[i] * qs; } }
            f32x4 rc[2][4];
            if (ROPE) { const int row = rowb; const int tpos = row < MP ? (row & (SEQ - 1)) : SEQ + ((row - MP) & (DSEQ - 1)); const float* rp = rope + (size_t)tpos * 64 + j0;
                rc[0][0] = *(const f32x4*)rp; rc[0][1] = *(const f32x4*)(rp + 4); rc[0][2] = *(const f32x4*)(rp + 32); rc[0][3] = *(const f32x4*)(rp + 36); }
#pragma unroll
            for (int rg = 0; rg < 8; ++rg) {
                const int ai = rg >> 2, m = rg & 3, row = rowb + ai * HALF + m * 16;
                if (ROPE && rg < 7) { const int rown = rowb + ((rg + 1) >> 2) * HALF + ((rg + 1) & 3) * 16; const int tpos = rown < MP ? (rown & (SEQ - 1)) : SEQ + ((rown - MP) & (DSEQ - 1));
                    const float* rp = rope + (size_t)tpos * 64 + j0; f32x4 (&rn)[4] = rc[(rg + 1) & 1];
                    rn[0] = *(const f32x4*)rp; rn[1] = *(const f32x4*)(rp + 4); rn[2] = *(const f32x4*)(rp + 32); rn[3] = *(const f32x4*)(rp + 36); }
                float x1[8], x2[8];
                { const float rr = rrs[ai][m];
#pragma unroll
                  for (int n = 0; n < 2; ++n)
#pragma unroll
                    for (int i = 0; i < 4; ++i) { x1[4 * n + i] = acc[ai][0][m][n][i] * rr; x2[4 * n + i] = acc[ai][1][m][n][i] * rr; } }
                float ss = 0.f;
#pragma unroll
                for (int i = 0; i < 8; ++i) ss += x1[i] * x1[i] + x2[i] * x2[i];
                ss += swz_xor<16>(ss); ss = xadd32(ss);
                const float rs = 1.0f / sqrtf(ss * (1.0f / 64.0f) + EPS);
#pragma unroll
                for (int i = 0; i < 8; ++i) { x1[i] *= rs * g1[i]; x2[i] *= rs * g2[i]; }
                if (ROPE) { const f32x4 (&r)[4] = rc[rg & 1];
#pragma unroll
                    for (int i = 0; i < 8; ++i) { const float c = i < 4 ? r[0][i & 3] : r[1][i & 3], sn = i < 4 ? r[2][i & 3] : r[3][i & 3];
                        const float a = x1[i], b = x2[i]; x1[i] = a * c - b * sn; x2[i] = b * c + a * sn; } }
                if (kind == 1) { float* p = f32_dst(1, row, colb);
                    if (p) { __builtin_nontemporal_store((f32x4){x1[0], x1[1], x1[2], x1[3]}, (f32x4*)p); __builtin_nontemporal_store((f32x4){x1[4], x1[5], x1[6], x1[7]}, (f32x4*)(p + 4));
                             __builtin_nontemporal_store((f32x4){x2[0], x2[1], x2[2], x2[3]}, (f32x4*)(p + 32)); __builtin_nontemporal_store((f32x4){x2[4], x2[5], x2[6], x2[7]}, (f32x4*)(p + 36)); } }
                bf16_t* o = dst + (size_t)row * D + colb;
                *(u32x4*)o = pack8(x1); *(u32x4*)(o + 32) = pack8(x2);
            }
        } else {
#pragma unroll
            for (int rg = 0; rg < 8; ++rg) {
                const int ai = rg >> 2, m = rg & 3, row = rowb + ai * HALF + m * 16;
                float x1[8], x2[8];
                { const float rr = rrs[ai][m];
#pragma unroll
                  for (int n = 0; n < 2; ++n)
#pragma unroll
                    for (int i = 0; i < 4; ++i) { x1[4 * n + i] = acc[ai][0][m][n][i] * rr; x2[4 * n + i] = acc[ai][1][m][n][i] * rr; } }
                float* p = f32_dst(2, row, colb);
                if (p) { __builtin_nontemporal_store((f32x4){x1[0], x1[1], x1[2], x1[3]}, (f32x4*)p); __builtin_nontemporal_store((f32x4){x1[4], x1[5], x1[6], x1[7]}, (f32x4*)(p + 4));
                         __builtin_nontemporal_store((f32x4){x2[0], x2[1], x2[2], x2[3]}, (f32x4*)(p + 32)); __builtin_nontemporal_store((f32x4){x2[4], x2[5], x2[6], x2[7]}, (f32x4*)(p + 36)); }
                bf16_t* o = dst + (size_t)row * D + colb;
                *(u32x4*)o = pack8(x1); *(u32x4*)(o + 32) = pack8(x2);
            }
        }
    }
};

struct EpiResAdd {
    static constexpr bool PERM = true, AFTER_DRAIN = false;
    bf16_t* Xb; const float* Xr32; float* X32out; float* SSQ;
    __device__ __forceinline__ void operator()(const f32x4 (&acc)[2][2][4][2], const Unit& u, int wr, int wc, int fr, int fq) const {
        const int col0 = u.pn * BM + wc * 32 + 8 * fq;
        const unsigned row0 = (unsigned)(u.pm * BM + wr * 64 + fr);
        float ssv[2][4];
#pragma unroll
        for (int ai = 0; ai < 2; ++ai)
#pragma unroll
        for (int mh = 0; mh < 4; mh += 2) {
            f32x4 xo[2][2][2];
            if (Xr32) {
#pragma unroll
                for (int k = 0; k < 2; ++k)
#pragma unroll
                    for (int bj = 0; bj < 2; ++bj)
#pragma unroll
                        for (int n = 0; n < 2; ++n) xo[k][bj][n] = *(const f32x4*)(Xr32 + ((row0 + (unsigned)(ai * HALF + (mh + k) * 16)) * (unsigned)D + (unsigned)(col0 + bj * HALF + 4 * n)));
            } else {
                u32x4 xb[2][2];
#pragma unroll
                for (int k = 0; k < 2; ++k)
#pragma unroll
                    for (int bj = 0; bj < 2; ++bj) xb[k][bj] = *(const u32x4*)(Xb + ((row0 + (unsigned)(ai * HALF + (mh + k) * 16)) * (unsigned)D + (unsigned)(col0 + bj * HALF)));
#pragma unroll
                for (int k = 0; k < 2; ++k)
#pragma unroll
                    for (int bj = 0; bj < 2; ++bj) { const u32x4 w = xb[k][bj];
                        xo[k][bj][0] = (f32x4){bf2f(w.x & 0xffff), bf2f(w.x >> 16), bf2f(w.y & 0xffff), bf2f(w.y >> 16)};
                        xo[k][bj][1] = (f32x4){bf2f(w.z & 0xffff), bf2f(w.z >> 16), bf2f(w.w & 0xffff), bf2f(w.w >> 16)}; }
            }
#pragma unroll
            for (int k = 0; k < 2; ++k) { const int m = mh + k; const unsigned ro = (row0 + (unsigned)(ai * HALF + m * 16)) * (unsigned)D + (unsigned)col0;
                float ss = 0.f;
#pragma unroll
                for (int bj = 0; bj < 2; ++bj) { const f32x4 v0 = xo[k][bj][0] + acc[ai][bj][m][0], v1 = xo[k][bj][1] + acc[ai][bj][m][1];
                    ss += ((v0.x * v0.x + v0.y * v0.y) + (v0.z * v0.z + v0.w * v0.w)) + ((v1.x * v1.x + v1.y * v1.y) + (v1.z * v1.z + v1.w * v1.w));
                    if (X32out) { *(f32x4*)(X32out + (ro + (unsigned)(bj * HALF))) = v0; *(f32x4*)(X32out + (ro + (unsigned)(bj * HALF + 4))) = v1; }
                    else { u32x4 w; w.x = cvt_pk_bf16(v0.x, v0.y); w.y = cvt_pk_bf16(v0.z, v0.w); w.z = cvt_pk_bf16(v1.x, v1.y); w.w = cvt_pk_bf16(v1.z, v1.w);
                        *(u32x4*)(Xb + (ro + (unsigned)(bj * HALF))) = w; } }
                ssv[ai][m] = ss; }
        }
        if (!X32out) {
#pragma unroll
            for (int ai = 0; ai < 2; ++ai)
#pragma unroll
                for (int m = 0; m < 4; ++m) { float ss = ssv[ai][m]; ss += swz_xor<16>(ss); ss = xadd32(ss); if (fq == 0) SSQ[(size_t)(row0 + (unsigned)(ai * HALF + m * 16)) * 16 + u.pn * 4 + wc] = ss; } }
    }
};

struct EpiRelu2 {
    static constexpr bool PERM = true, AFTER_DRAIN = false;
    bf16_t* O; int ldc; const PG8_LAS float* RS;
    __device__ __forceinline__ void operator()(const f32x4 (&acc)[2][2][4][2], const Unit& u, int wr, int wc, int fr, int fq) const {
        const int col0 = u.pn * BM + wc * 32 + 8 * fq;
        float rrs[2][4]; rows_rstd_lds(RS, u, wr * 64 + fr, rrs);
#pragma unroll
        for (int ai = 0; ai < 2; ++ai)
#pragma unroll
            for (int m = 0; m < 4; ++m) { const int row = u.pm * BM + ai * HALF + wr * 64 + m * 16 + fr; bf16_t* rowp = O + (size_t)row * ldc + col0; const float rr = rrs[ai][m];
#pragma unroll
                for (int bj = 0; bj < 2; ++bj) { float x[8];
#pragma unroll
                    for (int n = 0; n < 2; ++n)
#pragma unroll
                        for (int i = 0; i < 4; ++i) { const float v = fmaxf(acc[ai][bj][m][n][i] * rr, 0.f); x[4 * n + i] = v * v; }
                    *(u32x4*)(rowp + bj * HALF) = pack8(x); } }
    }
};

__device__ __forceinline__ float gelu_tanh(float x) {
    const float y = 0.7978845608028654f * (x + 0.044715f * x * x * x);
    const float e = __expf(2.0f * y);
    const float th = 1.0f - 2.0f / (1.0f + e);
    return 0.5f * x * (1.0f + th);
}
struct EpiBin {
    static constexpr bool PERM = true, AFTER_DRAIN = false;
    bf16_t *G, *U; const float* bias; float *ocp, *ocs; const PG8_LAS float* RS;
    __device__ __forceinline__ void operator()(const f32x4 (&acc)[2][2][4][2], const Unit& u, int wr, int wc, int fr, int fq) const {
        const int col0 = u.pn * BM + wc * 32 + 8 * fq; const bool isu = u.pn >= 4;
        float bv[2][8];
#pragma unroll
        for (int bj = 0; bj < 2; ++bj)
#pragma unroll
            for (int i = 0; i < 8; ++i) bv[bj][i] = bias[col0 + bj * HALF + i];
        float rrs[2][4]; rows_rstd_lds(RS, u, wr * 64 + fr, rrs);
#pragma unroll
        for (int ai = 0; ai < 2; ++ai)
#pragma unroll
            for (int m = 0; m < 4; ++m) { const int row = u.pm * BM + ai * HALF + wr * 64 + m * 16 + fr; const float rr = rrs[ai][m];
#pragma unroll
                for (int bj = 0; bj < 2; ++bj) { float x[8];
#pragma unroll
                    for (int n = 0; n < 2; ++n)
#pragma unroll
                        for (int i = 0; i < 4; ++i) x[4 * n + i] = acc[ai][bj][m][n][i] * rr + bv[bj][4 * n + i];
                    if (!isu) {
#pragma unroll
                        for (int i = 0; i < 8; ++i) x[i] = gelu_tanh(x[i]);
                        *(u32x4*)(G + (size_t)row * D + col0 + bj * HALF) = pack8(x);
                    } else {
                        const int uc = col0 + bj * HALF - D;
                        *(u32x4*)(U + (size_t)row * D + uc) = pack8(x);
                        float* p = nullptr;
                        if (row < MP) { const int t = row & (SEQ - 1), b = row >> 11; if (t >= SEQ - 3) p = ocp + (size_t)(b * 3 + (t - (SEQ - 3))) * D + uc; }
                        else { const int s = row - MP, t = s & (DSEQ - 1), b = s >> 4; if (t >= DSEQ - 3) p = ocs + (size_t)(b * 3 + (t - (DSEQ - 3))) * D + uc; }
                        if (p) { *(f32x4*)p = (f32x4){x[0], x[1], x[2], x[3]}; *(f32x4*)(p + 4) = (f32x4){x[4], x[5], x[6], x[7]}; }
                    } } }
    }
};

struct EpiGates {
    static constexpr bool PERM = true, AFTER_DRAIN = false;
    const bf16_t* XCB; const float *gab, *gxb, *sp8  ; bf16_t *AA, *BB;
    __device__ __forceinline__ void operator()(const f32x4 (&acc)[2][2][4][2], const Unit& u, int wr, int wc, int fr, int fq) const {
        const int nb = u.pn >> 1, cin = 128 * (u.pn & 1) + wc * 32 + 8 * fq, ch0 = 256 * nb + cin;
        const unsigned row0 = (unsigned)(u.pm * BM + wr * 64 + fr);
        const unsigned xoff0 = ((unsigned)nb * MT + row0) * 256u + (unsigned)cin, ooff0 = row0 * (unsigned)D + (unsigned)ch0;
        u32x4 xw[2][4];
#pragma unroll
        for (int ai = 0; ai < 2; ++ai)
#pragma unroll
            for (int m = 0; m < 4; ++m) xw[ai][m] = *(const u32x4*)(XCB + (xoff0 + (unsigned)(ai * HALF + m * 16) * 256u));
#pragma unroll
        for (int n = 0; n < 2; ++n) {
            const f32x4 ba = *(const f32x4*)(gab + ch0 + 4 * n), bx = *(const f32x4*)(gxb + ch0 + 4 * n), sp = *(const f32x4*)(sp8 + ch0 + 4 * n);
#pragma unroll
            for (int ai = 0; ai < 2; ++ai)
#pragma unroll
                for (int m = 0; m < 4; ++m) {
                    const unsigned dr = (unsigned)(ai * HALF + m * 16);
                    f32x4 a, b;
#pragma unroll
                    for (int i = 0; i < 4; ++i) {
                        const unsigned w = xw[ai][m][2 * n + (i >> 1)];
                        const float xc = bf2f((unsigned short)((i & 1) ? (w >> 16) : (w & 0xffffu)));
                        const float r = __builtin_amdgcn_rcpf(1.0f + __expf(-(acc[ai][0][m][n][i] + ba[i])));
                        const float ig = __builtin_amdgcn_rcpf(1.0f + __expf(-(acc[ai][1][m][n][i] + bx[i])));
                        const float la = -r * sp[i], t2 = 2.0f * la;
                        a[i] = la;
                        const float poly = -t2 * (1.0f + t2 * (0.5f + t2 * (0.16666667f + t2 * (0.041666668f + t2 * (0.0083333338f + t2 * 0.0013888889f)))));
                        const float em = t2 > -0.25f ? poly : 1.0f - __expf(t2);
                        b[i] = __builtin_amdgcn_sqrtf(em) * (ig * xc); }
                    { u32x2 wa, wb; wa.x = cvt_pk_bf16(a[0], a[1]); wa.y = cvt_pk_bf16(a[2], a[3]); wb.x = cvt_pk_bf16(b[0], b[1]); wb.y = cvt_pk_bf16(b[2], b[3]);
                      *(u32x2*)(AA + (ooff0 + dr * (unsigned)D + 4u * n)) = wa; *(u32x2*)(BB + (ooff0 + dr * (unsigned)D + 4u * n)) = wb; }
                }
        }
    }
};

template <class Epi, class Sched, bool ALIGN_EPI = false, bool SP2 = false>
__device__ __forceinline__ void gemm_phase(PG8_LAS unsigned char* lds, const Gemm g, const Sched& S, const Epi& E, const int tid_in) {
    const int tid = tid_in; const int wid = __builtin_amdgcn_readfirstlane(tid >> 6), lane = tid & 63, wr = wid >> 2, wc = wid & 3, fr = lane & 15, fq = lane >> 4;
    int K = g.K; asm volatile("" : "+s"(K)); const int nt = K / BK;
    unsigned voffA[2], voffB[2];
#pragma unroll
    for (int i = 0; i < 2; ++i) { int R, C; stage_rc(tid * 16 + i * 8192, R, C); const int Rb = Epi::PERM ? ((R & ~31) + perm32(R & 31)) : R;
        voffA[i] = (unsigned)(R * K + C) * 2u; voffB[i] = (unsigned)(Rb * K + C) * 2u; }
    const size_t kstep = (size_t)(BK * 2);
    const size_t hstep = (size_t)HALF * K * 2;
    const size_t tstep = 2 * hstep;
    const unsigned ldsw = (unsigned)wid * 1024u;
    const int aoff = lds_byte(wr * 64 + fr, fq * 8), boff = lds_byte(wc * 32 + fr, fq * 8);
#define PG8_SA(b, h) (((b) * 2 + (h)) * HTB)
#define PG8_SB(b, h) ((4 + (b) * 2 + (h)) * HTB)
#define PG8_STAGE(bufoff, gbase, voff) do { _Pragma("unroll") for (int _i = 0; _i < 2; ++_i) \
        __builtin_amdgcn_global_load_lds((const unsigned*)((const char*)(gbase) + (voff)[_i]), (PG8_LAS unsigned*)(lds + (bufoff) + ldsw + _i * 8192), 16, 0, 0); } while (0)
#define PG8_LDA(dst, b, h) do { _Pragma("unroll") for (int m = 0; m < 4; ++m) _Pragma("unroll") for (int k = 0; k < 2; ++k) dst[m][k] = *(const PG8_LAS bf16x8*)(lds + PG8_SA(b, h) + aoff + m * 2048 + k * 1024); } while (0)
#define PG8_LDB(dst, b, h) do { _Pragma("unroll") for (int n = 0; n < 2; ++n) _Pragma("unroll") for (int k = 0; k < 2; ++k) dst[n][k] = *(const PG8_LAS bf16x8*)(lds + PG8_SB(b, h) + boff + n * 2048 + k * 1024); } while (0)
#define PG8_MMA(ai, bj, At, Bt) do { __builtin_amdgcn_s_setprio(1); _Pragma("unroll") for (int m = 0; m < 4; ++m) _Pragma("unroll") for (int n = 0; n < 2; ++n) _Pragma("unroll") for (int k = 0; k < 2; ++k) \
        acc[ai][bj][m][n] = __builtin_amdgcn_mfma_f32_16x16x32_bf16(Bt[n][k], At[m][k], acc[ai][bj][m][n], 0, 0, 0); __builtin_amdgcn_s_setprio(0); } while (0)
#define PG8_WAIT_V(n) asm volatile("s_waitcnt vmcnt(" #n ")" ::: "memory")
#define PG8_WAIT_L(n) asm volatile("s_waitcnt lgkmcnt(" #n ")" ::: "memory")
#define PG8_BAR __builtin_amdgcn_s_barrier()
#define PG8_SCHED __builtin_amdgcn_sched_barrier(0)
    Unit cur, nxt; int ui = 0;
    if (!S.next(0, cur)) return;
    cur.ui = 0;
    f32x4 acc[2][2][4][2];
#pragma unroll
    for (int a = 0; a < 2; ++a)
#pragma unroll
        for (int b = 0; b < 2; ++b)
#pragma unroll
            for (int m = 0; m < 4; ++m)
#pragma unroll
                for (int n = 0; n < 2; ++n) acc[a][b][m][n] = (f32x4){0.f, 0.f, 0.f, 0.f};
    bf16x8 At[4][2], B0[2][2], B1[2][2];
    const char* cA = (const char*)g.A + (size_t)cur.pm * tstep + g.a_off(cur.pn); const char* cB = (const char*)g.Bt + (size_t)cur.pn * tstep;
    S.a_ready(cur);
    if constexpr (SP2) {
        PG8_STAGE(PG8_SB(0, 0), cB, voffB); PG8_STAGE(PG8_SB(0, 1), cB + hstep, voffB); PG8_STAGE(PG8_SA(0, 0), cA, voffA); PG8_STAGE(PG8_SA(0, 1), cA + hstep, voffA);
        if (wr == 1) PG8_BAR;
        PG8_WAIT_V(2); PG8_BAR;
        PG8_STAGE(PG8_SB(1, 0), cB + kstep, voffB); PG8_STAGE(PG8_SA(1, 0), cA + kstep, voffA); PG8_STAGE(PG8_SB(1, 1), cB + hstep + kstep, voffB);
        PG8_WAIT_V(6); PG8_BAR;
    } else {
        PG8_STAGE(PG8_SB(0, 0), cB, voffB); PG8_STAGE(PG8_SA(0, 0), cA, voffA); PG8_STAGE(PG8_SB(0, 1), cB + hstep, voffB); PG8_STAGE(PG8_SA(0, 1), cA + hstep, voffA);
        if (wr == 1) PG8_BAR;
        PG8_WAIT_V(4); PG8_BAR;
        PG8_STAGE(PG8_SB(1, 0), cB + kstep, voffB); PG8_STAGE(PG8_SA(1, 0), cA + kstep, voffA); PG8_STAGE(PG8_SB(1, 1), cB + hstep + kstep, voffB);
        PG8_WAIT_V(6); PG8_BAR;
    }
    for (;;) {
        const bool has_next = S.next(ui + 1, nxt); nxt.ui = ui + 1;
        const char* nA = has_next ? (const char*)g.A + (size_t)nxt.pm * tstep + g.a_off(nxt.pn) : cA; const char* nB = has_next ? (const char*)g.Bt + (size_t)nxt.pn * tstep : cB;
        for (int t = 0; t < nt; t += 2) {
            const bool last = (t == nt - 2);
            const char* a1 = cA + (size_t)(t + 1) * kstep;
            const char* a2 = last ? nA : cA + (size_t)(t + 2) * kstep; const char* b2 = last ? nB : cB + (size_t)(t + 2) * kstep;
            const char* a3 = a2 + kstep; const char* b3 = b2 + kstep;
            if (last && has_next) S.a_ready(nxt);
            if constexpr (SP2) {
            PG8_LDB(B0, 0, 0); PG8_LDB(B1, 0, 1); PG8_SCHED; PG8_LDA(At, 0, 0); PG8_STAGE(PG8_SA(1, 1), a1 + hstep, voffA);
            PG8_WAIT_V(8); PG8_WAIT_L(0); PG8_BAR; PG8_MMA(0, 0, At, B0); PG8_MMA(0, 1, At, B1); PG8_BAR; PG8_SCHED;
            PG8_LDA(At, 0, 1); PG8_STAGE(PG8_SB(0, 0), b2, voffB); PG8_STAGE(PG8_SB(0, 1), b2 + hstep, voffB); PG8_STAGE(PG8_SA(0, 0), a2, voffA);
            PG8_WAIT_V(8); PG8_WAIT_L(0); PG8_BAR; PG8_MMA(1, 0, At, B0); PG8_MMA(1, 1, At, B1); PG8_BAR; PG8_SCHED;
            PG8_LDB(B0, 1, 0); PG8_LDB(B1, 1, 1); PG8_SCHED; PG8_LDA(At, 1, 0); PG8_STAGE(PG8_SA(0, 1), a2 + hstep, voffA);
            PG8_WAIT_V(8); PG8_WAIT_L(0); PG8_BAR; PG8_MMA(0, 0, At, B0); PG8_MMA(0, 1, At, B1); PG8_BAR; PG8_SCHED;
            PG8_LDA(At, 1, 1); PG8_STAGE(PG8_SB(1, 0), b3, voffB); PG8_STAGE(PG8_SB(1, 1), b3 + hstep, voffB); PG8_STAGE(PG8_SA(1, 0), a3, voffA);
            PG8_WAIT_V(8); PG8_WAIT_L(0); PG8_BAR; PG8_MMA(1, 0, At, B0); PG8_MMA(1, 1, At, B1); PG8_BAR; PG8_SCHED;
            } else {
            PG8_LDB(B0, 0, 0); PG8_SCHED; PG8_LDA(At, 0, 0); PG8_STAGE(PG8_SA(1, 1), a1 + hstep, voffA);
            PG8_WAIT_L(8); PG8_BAR; PG8_WAIT_L(0); PG8_MMA(0, 0, At, B0); PG8_BAR; PG8_SCHED;
            PG8_LDB(B1, 0, 1); PG8_STAGE(PG8_SB(0, 0), b2, voffB);
            PG8_BAR; PG8_WAIT_L(0); PG8_MMA(0, 1, At, B1); PG8_BAR;
            PG8_LDA(At, 0, 1); PG8_STAGE(PG8_SA(0, 0), a2, voffA);
            PG8_BAR; PG8_WAIT_L(0); PG8_MMA(1, 0, At, B0); PG8_BAR; PG8_SCHED;
            PG8_STAGE(PG8_SB(0, 1), b2 + hstep, voffB);
            PG8_WAIT_V(6); PG8_BAR; PG8_MMA(1, 1, At, B1); PG8_BAR;
            PG8_LDB(B0, 1, 0); PG8_SCHED; PG8_LDA(At, 1, 0); PG8_STAGE(PG8_SA(0, 1), a2 + hstep, voffA);
            PG8_WAIT_L(8); PG8_BAR; PG8_WAIT_L(0); PG8_MMA(0, 0, At, B0); PG8_BAR; PG8_SCHED;
            PG8_LDB(B1, 1, 1); PG8_STAGE(PG8_SB(1, 0), b3, voffB);
            PG8_BAR; PG8_WAIT_L(0); PG8_MMA(0, 1, At, B1); PG8_BAR;
            PG8_LDA(At, 1, 1); PG8_STAGE(PG8_SA(1, 0), a3, voffA);
            PG8_BAR; PG8_WAIT_L(0); PG8_MMA(1, 0, At, B0); PG8_BAR; PG8_SCHED;
            PG8_STAGE(PG8_SB(1, 1), b3 + hstep, voffB);
            PG8_WAIT_V(6); PG8_BAR; PG8_MMA(1, 1, At, B1); PG8_BAR;
            }
        }
        if constexpr (ALIGN_EPI) { if (wr == 0) PG8_BAR; }
        if constexpr (!Epi::AFTER_DRAIN) { E(acc, cur, wr, wc, fr, fq); S.done(cur); }
        if (!has_next) break;
#pragma unroll
        for (int a = 0; a < 2; ++a)
#pragma unroll
            for (int b = 0; b < 2; ++b)
#pragma unroll
                for (int m = 0; m < 4; ++m)
#pragma unroll
                    for (int n = 0; n < 2; ++n) acc[a][b][m][n] = (f32x4){0.f, 0.f, 0.f, 0.f};
        cur = nxt; cA = nA; cB = nB; ++ui;
        if constexpr (ALIGN_EPI) { if (wr == 1) PG8_BAR; }
    }
    PG8_WAIT_V(0);
    if constexpr (!ALIGN_EPI) { if (wr == 0) PG8_BAR; }
    PG8_BAR;
    if constexpr (Epi::AFTER_DRAIN) { E.fused(acc, cur, wr, wc, fr, fq, lds, wid, lane); S.done(cur); }
#undef PG8_SA
#undef PG8_SB
#undef PG8_STAGE
#undef PG8_LDA
#undef PG8_LDB
#undef PG8_MMA
#undef PG8_WAIT_V
#undef PG8_WAIT_L
#undef PG8_BAR
#undef PG8_SCHED
}
}

#ifndef PROBE_DUP
#define PROBE_DUP 0
#endif
#include <hip/hip_bf16.h>
#include <cmath>
namespace attn_body {
using bf16=__hip_bfloat16;
using bf16x8=__attribute__((ext_vector_type(8)))short;
using s16x4=__attribute__((ext_vector_type(4)))short;
using f32x16=__attribute__((ext_vector_type(16)))float;
using u32x4=__attribute__((ext_vector_type(4)))unsigned;
constexpr int BATCH=16,NHEAD=16,SEQ=2048,D=64,DM=NHEAD*D;
constexpr int NW=8,QBLK=32,QB=QBLK*NW,KVBLK=64,NQB=SEQ/QB;
constexpr int ATTN_PITCH=DM, ATTN_UNIT_ROWS=QB;
__device__ __forceinline__ int crow(int r,int hi){return (r&3)+8*(r>>2)+4*hi;}
#define SBAR() __builtin_amdgcn_sched_barrier(0)
__device__ __forceinline__ void cmask(f32x16&p0,f32x16&p1,int jb,int qrel,int hi){
  const float NEG=-INFINITY; int kb=64*jb+4*hi;
  #pragma unroll
  for(int r=0;r<16;++r){int kv=kb+(r&3)+8*(r>>2); if(kv>qrel)p0[r]=NEG; if(kv+32>qrel)p1[r]=NEG;}
}

constexpr int NSLOT=3, SLOTB=8192;
constexpr int LDS_K=0, LDS_V=NSLOT*SLOTB, LDS_V2=2*NSLOT*SLOTB  , LDS_WS=3*NSLOT*SLOTB, LDS_OST=LDS_WS+NW*64*4, LDS_BYTES=LDS_OST+NW*4096;
constexpr float C2=0.125f*1.4426950408889634f;
__device__ __forceinline__ void glds16(const void*gsrc,unsigned lds_dst){unsigned keep;
  asm volatile("s_mov_b32 %0, m0\n\ts_mov_b32 m0, %2\n\ts_nop 0\n\tglobal_load_lds_dwordx4 %1, off\n\ts_mov_b32 m0, %0":"=&s"(keep):"v"(gsrc),"s"(lds_dst):"memory");}
__device__ __forceinline__ float max3f(float a,float b,float c){float r;asm("v_max3_f32 %0, %1, %2, %3":"=v"(r):"v"(a),"v"(b),"v"(c));return r;}
__device__ __forceinline__ float max2f(float a,float b){float r;asm("v_max_f32_e32 %0, %1, %2":"=v"(r):"v"(a),"v"(b));return r;}
__device__ __forceinline__ float fadd_s(float a,float b){float r;asm("v_add_f32_e32 %0, %1, %2":"=v"(r):"v"(a),"v"(b));return r;}
__device__ __forceinline__ float fsub_s(float a,float b){float r;asm("v_sub_f32_e32 %0, %1, %2":"=v"(r):"v"(a),"v"(b));return r;}
typedef float f32x2_t __attribute__((ext_vector_type(2))); typedef __bf16 bf16x2_t __attribute__((ext_vector_type(2)));
__device__ __forceinline__ unsigned cvtpk_s(float lo,float hi){f32x2_t v={lo,hi};bf16x2_t b=__builtin_convertvector(v,bf16x2_t);return __builtin_bit_cast(unsigned,b);}
#define WAIT_BAR(N) asm volatile("s_waitcnt vmcnt(" #N ") lgkmcnt(0)\n\ts_barrier":::"memory")

__device__ __forceinline__ void qkt(f32x16&p0,f32x16&p1,const char*Kslot,const bf16x8*qr,const f32x16&negm,int r32,int hi){
  const char*kb=Kslot+hi*1024+r32*16;
  #pragma unroll
  for(int d0=0;d0<4;++d0){
    const bf16x8 b0=*reinterpret_cast<const bf16x8*>(kb+d0*2048);
    const bf16x8 b1=*reinterpret_cast<const bf16x8*>(kb+d0*2048+512);
    if(d0==0){p0=__builtin_amdgcn_mfma_f32_32x32x16_bf16(b0,qr[0],negm,0,0,0);p1=__builtin_amdgcn_mfma_f32_32x32x16_bf16(b1,qr[0],negm,0,0,0);}
    else{p0=__builtin_amdgcn_mfma_f32_32x32x16_bf16(b0,qr[d0],p0,0,0,0);p1=__builtin_amdgcn_mfma_f32_32x32x16_bf16(b1,qr[d0],p1,0,0,0);}}
}
typedef __attribute__((address_space(3))) const char* lds_cptr;
typedef short v4i16_t __attribute__((ext_vector_type(4)));
__device__ __forceinline__ void kload8(bf16x8*kf,lds_cptr kp){
  kf[0]=*(const __attribute__((address_space(3))) bf16x8*)(kp);      kf[1]=*(const __attribute__((address_space(3))) bf16x8*)(kp+512);
  kf[2]=*(const __attribute__((address_space(3))) bf16x8*)(kp+2048); kf[3]=*(const __attribute__((address_space(3))) bf16x8*)(kp+2560);
  kf[4]=*(const __attribute__((address_space(3))) bf16x8*)(kp+4096); kf[5]=*(const __attribute__((address_space(3))) bf16x8*)(kp+4608);
  kf[6]=*(const __attribute__((address_space(3))) bf16x8*)(kp+6144); kf[7]=*(const __attribute__((address_space(3))) bf16x8*)(kp+6656);
}
__device__ __forceinline__ void kload2(bf16x8*kf,lds_cptr kp,int j){ kf[2*j]=*(const __attribute__((address_space(3))) bf16x8*)(kp+j*2048); kf[2*j+1]=*(const __attribute__((address_space(3))) bf16x8*)(kp+j*2048+512); }
__device__ __forceinline__ s16x4 vtr(lds_cptr p){ return __builtin_bit_cast(s16x4,__builtin_amdgcn_ds_read_tr16_b64_v4i16((__attribute__((address_space(3))) v4i16_t*)p)); }
__device__ __forceinline__ float rowmax(const f32x16&p0,const f32x16&p1){
  float a=max3f(p0[0],p0[1],p1[0]),b=max3f(p0[2],p0[3],p1[1]);a=max3f(a,p1[2],p1[3]);
  #pragma unroll
  for(int r=4;r<16;r+=4){a=max3f(a,p0[r],p0[r+1]);b=max3f(b,p0[r+2],p0[r+3]);a=max3f(a,p1[r],p1[r+1]);b=max3f(b,p1[r+2],p1[r+3]);}
  const float m=max2f(a,b);
  auto rr=__builtin_amdgcn_permlane32_swap(__float_as_uint(m),__float_as_uint(m),false,false);
  return max2f(__uint_as_float(rr[0]),__uint_as_float(rr[1]));
}
__device__ __forceinline__ void pv(f32x16*o,int vb,bf16x8 pa0,bf16x8 pa1,bf16x8 pa2,bf16x8 pa3){
  #pragma unroll
  for(int d0=0;d0<2;++d0){s16x4 lo[4],hi[4];
    #pragma unroll
    for(int ks=0;ks<4;++ks){
      asm volatile("ds_read_b64_tr_b16 %0,%1 offset:%c2":"=&v"(lo[ks]):"v"(vb),"i"(d0*4096+ks*1024):"memory");
      asm volatile("ds_read_b64_tr_b16 %0,%1 offset:%c2":"=&v"(hi[ks]):"v"(vb),"i"(d0*4096+ks*1024+512):"memory");}
    asm volatile("s_waitcnt lgkmcnt(0)":::"memory");SBAR();
    #define PK(k) (bf16x8){lo[k][0],lo[k][1],lo[k][2],lo[k][3],hi[k][0],hi[k][1],hi[k][2],hi[k][3]}
    o[d0]=__builtin_amdgcn_mfma_f32_32x32x16_bf16(pa0,PK(0),o[d0],0,0,0);
    o[d0]=__builtin_amdgcn_mfma_f32_32x32x16_bf16(pa1,PK(1),o[d0],0,0,0);
    o[d0]=__builtin_amdgcn_mfma_f32_32x32x16_bf16(pa2,PK(2),o[d0],0,0,0);
    o[d0]=__builtin_amdgcn_mfma_f32_32x32x16_bf16(pa3,PK(3),o[d0],0,0,0);
    #undef PK
  }
}

#ifndef ATTN_STORE16
#define ATTN_STORE16(p,v) (*(u32x4*)(p)=(v))
#endif
__device__ __forceinline__ void band_fix(f32x16&p0,f32x16&p1,int ct,int wid,int r32,int hi,const __attribute__((address_space(3))) float*tbl,float mhat){
  const int dist=(wid>>1)-ct;
  if(dist<0||dist>8){
    #pragma unroll
    for(int r=0;r<16;++r){p0[r]=-INFINITY;p1[r]=-INFINITY;}
  } else if(dist<=2){
    const int A=64*dist+32*(wid&1)+r32-4*hi+128;
    #pragma unroll
    for(int r=0;r<16;++r){ const int kc=(r&3)+8*(r>>2); int i0=A-kc,i1=A-32-kc; i0=i0<0?0:(i0>256?256:i0); i1=i1<0?0:(i1>256?256:i1); p0[r]+=tbl[i0]-mhat; p1[r]+=tbl[i1]-mhat; }
  } else {
    #pragma unroll
    for(int r=0;r<16;++r){p0[r]-=mhat;p1[r]-=mhat;}
  }
}
template<int BAND> __device__ __forceinline__ f32x16 cinit(const f32x16&negm){ if constexpr(BAND!=0){ return f32x16{}; } else { return negm; } }
template<int THRL,int QOR,int OPITCH,int BAND,int DV2> __device__ __forceinline__ void attn_unit(int b,int hq,int hv,int ho,int qb,const bf16*Q,const bf16*__restrict__ K,const bf16*__restrict__ V,bf16*O,char*shm,int tid_in,const __attribute__((address_space(3))) float*tbl){
  const int tid=tid_in,lane=tid&63,r32=lane&31,hi=lane>>5; const int wid=__builtin_amdgcn_readfirstlane(tid>>6);
  const long rowbase=(long)b*SEQ; const int q0=qb*QB;
  const int t_lo=BAND?(qb>=2?4*qb-8:0):0; const int NT=BAND?(4*qb+4-t_lo):(q0+QB)/KVBLK; const int rot=BAND?NT-4:0;
  #define TMAP(s) (BAND?(((s)+rot>=NT)?(s)+rot-NT:(s)+rot):(s))
  const bf16*Qw=Q+(rowbase+q0+wid*QBLK)*DM+hq*D;
  const bf16*Kh=K+(rowbase+(long)t_lo*KVBLK)*DM+hq*D,*Vh=V+(rowbase+(long)t_lo*KVBLK)*DM+hv*D;
  const unsigned lds0=(unsigned)(uintptr_t)shm;
  float*wsf=(float*)(shm+LDS_WS)+wid*64;
  const bf16*ksrc=Kh+(long)lane*DM+wid*8;
  const bf16*vsrc=Vh+(long)(16*(wid&3)+(lane>>2))*DM+(wid>>2)*32+(lane&3)*8;
  const unsigned kdst=lds0+LDS_K+wid*1024, vdst=lds0+LDS_V+wid*1024, vdst2=lds0+LDS_V2+wid*1024;
  #define DMA_K(t,slot) glds16(ksrc+(long)TMAP(t)*KVBLK*DM,(unsigned)__builtin_amdgcn_readfirstlane(kdst+(slot)))
  #define DMA_V(t,slot) do{ glds16(vsrc+(long)TMAP(t)*KVBLK*DM,(unsigned)__builtin_amdgcn_readfirstlane(vdst+(slot))); if constexpr(DV2!=0){ glds16(vsrc+64+(long)TMAP(t)*KVBLK*DM,(unsigned)__builtin_amdgcn_readfirstlane(vdst2+(slot))); } }while(0)
  const int vb0=(int)(lds0+LDS_V)+((lane>>4)&1)*32+(lane&3)*8+(4*hi+((lane&15)>>2))*64;
  const char*Kbase=shm+LDS_K; bf16x8 kf[8];
  const lds_cptr shm3=(lds_cptr)shm; const lds_cptr kp0=shm3+LDS_K+hi*1024+r32*16; const lds_cptr vp0=shm3+LDS_V+((lane>>4)&1)*32+(lane&3)*8+(4*hi+((lane&15)>>2))*64;
  DMA_K(0,0);DMA_V(0,0);DMA_K(1,SLOTB);
  bf16x8 qr[4];
  #pragma unroll
  for(int d0=0;d0<4;++d0)qr[d0]=*reinterpret_cast<const bf16x8*>(&Qw[(long)r32*DM+d0*16+hi*8]);
  float zz_=0.f;asm volatile("":"+v"(zz_));
  float mhat=0.f,l_reg=0.f;f32x16 o[2];f32x16 o2[2];f32x16 negm;
  _Pragma("unroll") for(int r=0;r<16;++r){o[0][r]=zz_;o[1][r]=zz_;o2[0][r]=zz_;o2[1][r]=zz_;negm[r]=zz_;} if constexpr(BAND==0&&DV2==0){ asm volatile("":"+v"(negm)); }
  const int qrel=(wid*QBLK+r32)|QOR;
  #define CMASK(P0,P1,t) do{ if constexpr(BAND!=0){ band_fix(P0,P1,TMAP(t)-(NT-4),wid,r32,hi,tbl,mhat); } else { if constexpr(DV2!=0){ if(__any(mhat!=0.f)){ _Pragma("unroll") for(int r_=0;r_<16;++r_){P0[r_]-=mhat;P1[r_]-=mhat;} } } int jb_=(t)-(NT-4); if(jb_>=0)cmask(P0,P1,jb_,qrel,hi);} }while(0)
  bool resc=false;
  #define START(P0,P1) do{ const float rm=rowmax(P0,P1); resc=false; \
    if(DV2==0 || __any(__builtin_fabsf(rm)>(float)THRL)) { const float dl=rm; mhat=fadd_s(mhat,dl);     \
      _Pragma("unroll") for(int r=0;r<16;++r){P0[r]=fsub_s(P0[r],dl);P1[r]=fsub_s(P1[r],dl);} \
      if constexpr(BAND==0&&DV2==0){ _Pragma("unroll") for(int r=0;r<16;++r)negm[r]=-mhat; asm volatile("":"+v"(negm)); } } \
    _Pragma("unroll") for(int r=0;r<16;++r)P0[r]=__builtin_amdgcn_exp2f(P0[r]); }while(0)
  #define RESC() do{ if(resc){ asm volatile("s_waitcnt lgkmcnt(0)":::"memory"); \
      _Pragma("unroll") for(int d_=0;d_<2;++d_) _Pragma("unroll") for(int r=0;r<16;++r){ const float f_=wsf[crow(r,hi)]; o[d_][r]*=f_; if constexpr(DV2!=0){ o2[d_][r]*=f_; } } } }while(0)
  f32x16 pA0,pA1,pB0,pB1;
  int sl_prev=0,sl_cur=0,sl_next=SLOTB;
  #define ROT() do{sl_prev=sl_cur;sl_cur=sl_next;sl_next=(sl_next==(NSLOT-1)*SLOTB)?0:sl_next+SLOTB;}while(0)
  DMA_K(2,2*SLOTB);
  if constexpr(DV2!=0){WAIT_BAR(4);}else{WAIT_BAR(3);}
  qkt(pA0,pA1,Kbase,qr,cinit<(BAND|DV2)>(negm),r32,hi);asm volatile("s_nop 15\n\ts_nop 7":"+v"(pA0),"+v"(pA1));CMASK(pA0,pA1,0);
  START(pA0,pA1);
  _Pragma("unroll") for(int r=0;r<16;++r)pA1[r]=__builtin_amdgcn_exp2f(pA1[r]);
  WAIT_BAR(0);
  DMA_K(3,0);DMA_V(1,SLOTB);
  ROT();
  kload8(kf,kp0+sl_cur);
  if constexpr(DV2!=0){WAIT_BAR(3);}else{WAIT_BAR(2);}
  s16x4 vlo[8],vhi[8]; u32x4 pw0,pw1,pw2,pw3;
  #define PKW(P,B) cvtpk_s(P[B],P[B+1])
  #define PAF(k) __builtin_bit_cast(bf16x8,pw##k)
  #define VFR(i) (bf16x8){vlo[i][0],vlo[i][1],vlo[i][2],vlo[i][3],vhi[i][0],vhi[i][1],vhi[i][2],vhi[i][3]}
  #define PIN(x) asm volatile("":"+v"(x))
  #define MX3(a,b,c) __builtin_fmaxf(__builtin_fmaxf((a),(b)),(c))
  #define GAPA(MF,A0,A1,A2,A3,W0,W1,PW) do{ MF; sacc+=A0; sacc+=A1; sacc+=A2; sacc+=A3; PIN(sacc); W0; W1; PIN(PW); SBAR(); }while(0)
  #define EX(v) __builtin_amdgcn_exp2f(v)
  #define GAPB(MF,X,B) do{ MF; X[B]=EX(X[B]); X[B+1]=EX(X[B+1]); X[B+2]=EX(X[B+2]); X[B+3]=EX(X[B+3]); PIN(X); SBAR(); }while(0)
  #define GAPB2(MF,X,B,VI) do{ MF; X[B]=EX(X[B]); X[B+1]=EX(X[B+1]); PIN(X); vlo[VI]=vtr(vq_+(((VI)>>2)*4096+((VI)&3)*1024)); vhi[VI]=vtr(vq_+(((VI)>>2)*4096+((VI)&3)*1024+512)); SBAR(); }while(0)
  #define GAPB3(MF,X,B) do{ MF; X[B]=EX(X[B]); X[B+1]=EX(X[B+1]); PIN(X); SBAR(); }while(0)
  #define VRD(i) do{ if constexpr(DV2==0){ vlo[i]=vtr(vp_+(((i)>>2)*4096+((i)&3)*1024)); vhi[i]=vtr(vp_+(((i)>>2)*4096+((i)&3)*1024+512)); } }while(0)
  #define KRD(G,j) do{ if(G){ kload2(kf,kp0+sl_next,j); SBAR(); } }while(0)
  #define STEP(C0,C1,P0,P1,t,GK,GV,GL) do{ SBAR(); \
    const lds_cptr vp_=vp0+sl_prev; \
    VRD(0); SBAR(); float sacc=(P0[0]+P0[1]); \
    GAPA(C0=__builtin_amdgcn_mfma_f32_32x32x16_bf16(kf[0],qr[0],cinit<(BAND|DV2)>(negm),0,0,0), P0[2],P0[3],P0[4],P0[5],     pw0[0]=PKW(P0,0), pw0[1]=PKW(P0,2), pw0); \
    VRD(4); SBAR(); GAPA(C1=__builtin_amdgcn_mfma_f32_32x32x16_bf16(kf[1],qr[0],cinit<(BAND|DV2)>(negm),0,0,0), P0[6],P0[7],P0[8],P0[9],     pw0[2]=PKW(P0,4), pw0[3]=PKW(P0,6), pw0); \
    VRD(1); SBAR(); GAPA(C0=__builtin_amdgcn_mfma_f32_32x32x16_bf16(kf[2],qr[1],C0,0,0,0),   P0[10],P0[11],P0[12],P0[13], pw1[0]=PKW(P0,8), pw1[1]=PKW(P0,10), pw1); \
    VRD(5); SBAR(); GAPA(C1=__builtin_amdgcn_mfma_f32_32x32x16_bf16(kf[3],qr[1],C1,0,0,0),   P0[14],P0[15],P1[0],P1[1],   pw1[2]=PKW(P0,12),pw1[3]=PKW(P0,14), pw1); \
    VRD(2); SBAR(); GAPA(C0=__builtin_amdgcn_mfma_f32_32x32x16_bf16(kf[4],qr[2],C0,0,0,0),   P1[2],P1[3],P1[4],P1[5],     pw2[0]=PKW(P1,0), pw2[1]=PKW(P1,2), pw2); \
    VRD(6); SBAR(); GAPA(C1=__builtin_amdgcn_mfma_f32_32x32x16_bf16(kf[5],qr[2],C1,0,0,0),   P1[6],P1[7],P1[8],P1[9],     pw2[2]=PKW(P1,4), pw2[3]=PKW(P1,6), pw2); \
    VRD(3); SBAR(); GAPA(C0=__builtin_amdgcn_mfma_f32_32x32x16_bf16(kf[6],qr[3],C0,0,0,0),   P1[10],P1[11],P1[12],P1[13], pw3[0]=PKW(P1,8), pw3[1]=PKW(P1,10), pw3); \
    VRD(7); SBAR(); GAPA(C1=__builtin_amdgcn_mfma_f32_32x32x16_bf16(kf[7],qr[3],C1,0,0,0),   P1[14],P1[15],0.f,0.f,       pw3[2]=PKW(P1,12),pw3[3]=PKW(P1,14), pw3); \
    l_reg+=sacc; \
    if(GK){DMA_K((t)+3,sl_cur);} if(GV){DMA_V((t)+1,sl_next);} \
    CMASK(C0,C1,t); \
    { float a=MX3(C0[0],C0[1],C1[0]),b=MX3(C0[2],C0[3],C1[1]); a=MX3(a,C1[2],C1[3]); \
      _Pragma("unroll") for(int r=4;r<16;r+=4){a=MX3(a,C0[r],C0[r+1]);b=MX3(b,C0[r+2],C0[r+3]);a=MX3(a,C1[r],C1[r+1]);b=MX3(b,C1[r+2],C1[r+3]);} \
      float rm=__builtin_fmaxf(a,b); { auto rr=__builtin_amdgcn_permlane32_swap(__float_as_uint(rm),__float_as_uint(rm),false,false); rm=__builtin_fmaxf(__uint_as_float(rr[0]),__uint_as_float(rr[1])); } \
      resc=false; \
      if(__builtin_expect(__any(rm>(float)THRL),0)){ const float dl=__builtin_fmaxf(rm,0.f); mhat+=dl; \
        _Pragma("unroll") for(int r=0;r<16;++r){C0[r]-=dl;C1[r]-=dl;} \
        if constexpr(BAND==0&&DV2==0){ _Pragma("unroll") for(int r=0;r<16;++r)negm[r]=-mhat; asm volatile("":"+v"(negm)); } \
        const float f=__builtin_amdgcn_exp2f(-dl); l_reg*=f; if(hi==0)wsf[r32]=f; resc=true; } } \
    SBAR(); \
    if constexpr(DV2!=0){ _Pragma("unroll") for(int i_=0;i_<8;++i_){ vlo[i_]=vtr(vp_+((i_>>2)*4096+(i_&3)*1024)); vhi[i_]=vtr(vp_+((i_>>2)*4096+(i_&3)*1024+512)); } SBAR(); } \
    if constexpr(DV2==0){ \
    GAPB(o[0]=__builtin_amdgcn_mfma_f32_32x32x16_bf16(PAF(0),VFR(0),o[0],0,0,0), C0,0); \
    GAPB(o[1]=__builtin_amdgcn_mfma_f32_32x32x16_bf16(PAF(0),VFR(4),o[1],0,0,0), C0,4); \
    KRD(GL,0); GAPB(o[0]=__builtin_amdgcn_mfma_f32_32x32x16_bf16(PAF(1),VFR(1),o[0],0,0,0), C0,8); \
    KRD(GL,1); GAPB(o[1]=__builtin_amdgcn_mfma_f32_32x32x16_bf16(PAF(1),VFR(5),o[1],0,0,0), C0,12); \
    KRD(GL,2); GAPB(o[0]=__builtin_amdgcn_mfma_f32_32x32x16_bf16(PAF(2),VFR(2),o[0],0,0,0), C1,0); \
    KRD(GL,3); GAPB(o[1]=__builtin_amdgcn_mfma_f32_32x32x16_bf16(PAF(2),VFR(6),o[1],0,0,0), C1,4); \
    GAPB(o[0]=__builtin_amdgcn_mfma_f32_32x32x16_bf16(PAF(3),VFR(3),o[0],0,0,0), C1,8); \
    GAPB(o[1]=__builtin_amdgcn_mfma_f32_32x32x16_bf16(PAF(3),VFR(7),o[1],0,0,0), C1,12); \
    } else {     \
    const lds_cptr vq_=vp0+(LDS_V2-LDS_V)+sl_prev; \
    GAPB2(o[0]=__builtin_amdgcn_mfma_f32_32x32x16_bf16(PAF(0),VFR(0),o[0],0,0,0), C0,0, 0); \
    GAPB2(o[1]=__builtin_amdgcn_mfma_f32_32x32x16_bf16(PAF(0),VFR(4),o[1],0,0,0), C0,2, 4); \
    KRD(GL,0); GAPB2(o[0]=__builtin_amdgcn_mfma_f32_32x32x16_bf16(PAF(1),VFR(1),o[0],0,0,0), C0,4, 1); \
    KRD(GL,1); GAPB2(o[1]=__builtin_amdgcn_mfma_f32_32x32x16_bf16(PAF(1),VFR(5),o[1],0,0,0), C0,6, 5); \
    KRD(GL,2); GAPB2(o[0]=__builtin_amdgcn_mfma_f32_32x32x16_bf16(PAF(2),VFR(2),o[0],0,0,0), C0,8, 2); \
    KRD(GL,3); GAPB2(o[1]=__builtin_amdgcn_mfma_f32_32x32x16_bf16(PAF(2),VFR(6),o[1],0,0,0), C0,10, 6); \
    GAPB2(o[0]=__builtin_amdgcn_mfma_f32_32x32x16_bf16(PAF(3),VFR(3),o[0],0,0,0), C0,12, 3); \
    GAPB2(o[1]=__builtin_amdgcn_mfma_f32_32x32x16_bf16(PAF(3),VFR(7),o[1],0,0,0), C0,14, 7); \
    GAPB3(o2[0]=__builtin_amdgcn_mfma_f32_32x32x16_bf16(PAF(0),VFR(0),o2[0],0,0,0), C1,0); \
    GAPB3(o2[1]=__builtin_amdgcn_mfma_f32_32x32x16_bf16(PAF(0),VFR(4),o2[1],0,0,0), C1,2); \
    GAPB3(o2[0]=__builtin_amdgcn_mfma_f32_32x32x16_bf16(PAF(1),VFR(1),o2[0],0,0,0), C1,4); \
    GAPB3(o2[1]=__builtin_amdgcn_mfma_f32_32x32x16_bf16(PAF(1),VFR(5),o2[1],0,0,0), C1,6); \
    GAPB3(o2[0]=__builtin_amdgcn_mfma_f32_32x32x16_bf16(PAF(2),VFR(2),o2[0],0,0,0), C1,8); \
    GAPB3(o2[1]=__builtin_amdgcn_mfma_f32_32x32x16_bf16(PAF(2),VFR(6),o2[1],0,0,0), C1,10); \
    GAPB3(o2[0]=__builtin_amdgcn_mfma_f32_32x32x16_bf16(PAF(3),VFR(3),o2[0],0,0,0), C1,12); \
    GAPB3(o2[1]=__builtin_amdgcn_mfma_f32_32x32x16_bf16(PAF(3),VFR(7),o2[1],0,0,0), C1,14); \
    } \
    }while(0)
  int t=1;
  #undef CMASK
  #define CMASK(P0,P1,t) do{ if constexpr(BAND!=0){ band_fix(P0,P1,TMAP(t)-(NT-4),wid,r32,hi,tbl,mhat); } else if constexpr(DV2!=0){ if(__any(mhat!=0.f)){ _Pragma("unroll") for(int r_=0;r_<16;++r_){P0[r_]-=mhat;P1[r_]-=mhat;} } } }while(0)
  for(;t+5<NT;t+=2){
    STEP(pB0,pB1,pA0,pA1,t,true,true,true);     if constexpr(DV2!=0){WAIT_BAR(3);}else{WAIT_BAR(2);} RESC(); ROT();
    STEP(pA0,pA1,pB0,pB1,t+1,true,true,true);   if constexpr(DV2!=0){WAIT_BAR(3);}else{WAIT_BAR(2);} RESC(); ROT();
  }
  #undef CMASK
  #define CMASK(P0,P1,t) do{ if constexpr(BAND!=0){ band_fix(P0,P1,TMAP(t)-(NT-4),wid,r32,hi,tbl,mhat); } else { if constexpr(DV2!=0){ if(__any(mhat!=0.f)){ _Pragma("unroll") for(int r_=0;r_<16;++r_){P0[r_]-=mhat;P1[r_]-=mhat;} } } int jb_=(t)-(NT-4); if(jb_>=0)cmask(P0,P1,jb_,qrel,hi);} }while(0)
  #define ENDW(tt) do{ if constexpr(DV2!=0){ if((tt)+3<NT){WAIT_BAR(3);} else if((tt)+2<NT){WAIT_BAR(2);} else {WAIT_BAR(0);} } else { if((tt)+3<NT){WAIT_BAR(2);} else if((tt)+2<NT){WAIT_BAR(1);} else {WAIT_BAR(0);} } }while(0)
  for(;t+1<NT;t+=2){
    STEP(pB0,pB1,pA0,pA1,t,(t+3<NT),(t+1<NT),(t+1<NT));       ENDW(t);   RESC(); ROT();
    STEP(pA0,pA1,pB0,pB1,t+1,(t+4<NT),(t+2<NT),(t+2<NT));     ENDW(t+1); RESC(); ROT();
  }
  STEP(pB0,pB1,pA0,pA1,NT-1,false,false,false); RESC();
  { float sacc=pB0[0]+pB0[1]; _Pragma("unroll") for(int r=2;r<16;++r)sacc+=pB0[r]; _Pragma("unroll") for(int r=0;r<16;++r)sacc+=pB1[r]; l_reg+=sacc;
    pw0=(u32x4){PKW(pB0,0),PKW(pB0,2),PKW(pB0,4),PKW(pB0,6)};pw1=(u32x4){PKW(pB0,8),PKW(pB0,10),PKW(pB0,12),PKW(pB0,14)};pw2=(u32x4){PKW(pB1,0),PKW(pB1,2),PKW(pB1,4),PKW(pB1,6)};pw3=(u32x4){PKW(pB1,8),PKW(pB1,10),PKW(pB1,12),PKW(pB1,14)};
    SBAR(); pv(o,vb0+sl_cur,PAF(0),PAF(1),PAF(2),PAF(3)); if constexpr(DV2!=0){ SBAR(); pv(o2,vb0+(LDS_V2-LDS_V)+sl_cur,PAF(0),PAF(1),PAF(2),PAF(3)); } }
  #undef PKW
  #undef PAF
  #undef VFR
  #undef PIN
  #undef MX3
  #undef GAPA
  #undef GAPB
  #undef GAPB2
  #undef GAPB3
  #undef EX
  #undef VRD
  #undef KRD
  #undef STEP
  #undef ENDW
  {auto rr=__builtin_amdgcn_permlane32_swap(__float_as_uint(l_reg),__float_as_uint(l_reg),false,false);l_reg=__uint_as_float(rr[0])+__uint_as_float(rr[1]);}
  if(hi==0)wsf[32+r32]=l_reg;asm volatile("s_waitcnt lgkmcnt(0)":::"memory");
  float rli[16];
  #pragma unroll
  for(int r=0;r<16;++r)rli[r]=__builtin_amdgcn_rcpf(wsf[32+crow(r,hi)]);
  bf16*Ow=O+(rowbase+q0+wid*QBLK)*(long)OPITCH+ho*D;
  { bf16*stg=(bf16*)(shm+LDS_OST)+wid*2048;
    #pragma unroll
    for(int r=0;r<16;++r){const int orow=crow(r,hi);
      #pragma unroll
      for(int d0=0;d0<2;++d0)stg[orow*64+d0*32+r32]=__float2bfloat16(o[d0][r]*rli[r]);}
    asm volatile("s_waitcnt lgkmcnt(0)":::"memory");
    #pragma unroll
    for(int i=0;i<4;++i){const int row=i*8+(lane>>3),ch=lane&7; const u32x4 v=*(const u32x4*)(stg+row*64+ch*8); ATTN_STORE16(Ow+(long)row*OPITCH+ch*8,v);}
    if constexpr(DV2!=0){ asm volatile("s_waitcnt lgkmcnt(0)":::"memory");
      #pragma unroll
      for(int r=0;r<16;++r){const int orow=crow(r,hi);
        #pragma unroll
        for(int d0=0;d0<2;++d0)stg[orow*64+d0*32+r32]=__float2bfloat16(o2[d0][r]*rli[r]);}
      asm volatile("s_waitcnt lgkmcnt(0)":::"memory");
      #pragma unroll
      for(int i=0;i<4;++i){const int row=i*8+(lane>>3),ch=lane&7; const u32x4 v=*(const u32x4*)(stg+row*64+ch*8); ATTN_STORE16(Ow+D+(long)row*OPITCH+ch*8,v);} } }
  asm volatile("s_waitcnt lgkmcnt(0)\n\ts_barrier":::"memory");
  #undef DMA_K
  #undef TMAP
  #undef DMA_V
  #undef CMASK
  #undef START
  #undef RESC
  #undef ROT
}
constexpr int ATTN_LDS_BYTES=LDS_BYTES;
#undef SBAR
#undef WAIT_BAR
}

using pg8::bf16_t; using pg8::bf16x8; using pg8::f32x4; using pg8::f32x2; using pg8::u32x4; using pg8::u32x2; using pg8::cvt_pk_bf16; using pg8::bf2f;

enum { IN_XP = 0, IN_XS, IN_CAK, IN_CAV, IN_SBC, IN_SBH, IN_CCK, IN_CCV, IN_GMIX, IN_GMLP, IN_GFIN, IN_AWIN, IN_AQG, IN_AKG, IN_ALAM, IN_ASUB, IN_AWOUT,
       IN_BWIN, IN_BBIN, IN_BCW, IN_BCB, IN_BGAW, IN_BGAB, IN_BGXW, IN_BGXB, IN_BLAM, IN_BWOUT, IN_CWIN, IN_CQG, IN_CKG, IN_CBIAS, IN_CWOUT, IN_W1, IN_W2, N_IN };
constexpr size_t OUT_YP = 0, OUT_YS = OUT_YP + (size_t)MP * D, OUT_AKP = OUT_YS + (size_t)MS * D, OUT_AVP = OUT_AKP + 2 * (size_t)MP * D, OUT_AKS = OUT_AVP + 2 * (size_t)MP * D,
    OUT_AVS = OUT_AKS + 2 * (size_t)MS * D, OUT_BCP = OUT_AVS + 2 * (size_t)MS * D, OUT_BHP = OUT_BCP + (size_t)NB * 3 * D, OUT_BCS = OUT_BHP + (size_t)NB * D, OUT_BHS = OUT_BCS + (size_t)NB * 3 * D,
    OUT_CKP = OUT_BHS + (size_t)NB * D, OUT_CVP = OUT_CKP + (size_t)NB * CWIN * D, OUT_CKS = OUT_CVP + (size_t)NB * CWIN * D, OUT_CVS = OUT_CKS + (size_t)MS * D, OUT_TOTAL = OUT_CVS + (size_t)MS * D;
static_assert(OUT_TOTAL == 186515456ull, "output map");

constexpr size_t MiB = 1u << 20;
constexpr size_t ACT_BF = (size_t)MT * D * 2;
constexpr size_t WS_CTL = 0, CTL_ZERO_BYTES = 32 * 1024;
constexpr size_t WS_ROPE = 1 * MiB;
constexpr size_t WS_SP8 = WS_ROPE + 1 * MiB;
constexpr size_t WS_SSQ = WS_SP8 + 64 * 1024;
constexpr size_t WS_CP = 7 * MiB, WS_CH = 9 * MiB;
constexpr size_t WS_W = 12 * MiB;
constexpr size_t W_AIN = 0, W_AOUT = W_AIN + 2ull * 3072 * 1024, W_BIN = W_AOUT + 2ull * 1024 * 1024, W_BG = W_BIN + 2048ull * 1024, W_BOUT = W_BG + 2048ull * 256,
    W_CIN = W_BOUT + 1024ull * 1024, W_COUT = W_CIN + 3072ull * 1024, W_1 = W_COUT + 1024ull * 1024, W_2 = W_1 + 4ull * 4096 * 1024, W_END = W_2 + 4ull * 4096 * 1024;
constexpr size_t WS_X = WS_W + ((W_END * 2 + MiB - 1) / MiB) * MiB;
constexpr size_t WS_XN = WS_X + (size_t)MT * D * 4;
constexpr size_t WS_Q = WS_XN + ACT_BF, WS_K = WS_Q + ACT_BF, WS_V = WS_K + ACT_BF, WS_ON = WS_V + ACT_BF;
constexpr size_t WS_H = WS_ON + ACT_BF;
constexpr size_t WS_AA = WS_H + (size_t)MT * FF * 2, WS_BB = WS_AA + (size_t)MT * D * 4;
constexpr size_t WS_PO = WS_BB + (size_t)MT * D * 4;
constexpr int NSPLIT = 16;
constexpr size_t WS_PML = WS_PO + 128ull * NSPLIT * 2 * 16 * 128 * 4;
constexpr size_t WS_END = WS_PML + 1 * MiB;

constexpr int RING_OFF = 0, RING_BYTES = 131072;
constexpr int LDSCTL_OFF = RING_BYTES, MISC_OFF = LDSCTL_OFF + 320;
constexpr int LDS_BYTES = 147456;
constexpr int NWAVES = 8;

#define GAS __attribute__((address_space(1)))
#define LAS __attribute__((address_space(3)))
typedef GAS unsigned gu32;
#define RLX_AGENT __ATOMIC_RELAXED, __HIP_MEMORY_SCOPE_AGENT
#define LDS_WAIT() asm volatile("s_waitcnt lgkmcnt(0)" ::: "memory")
#define VM_WAIT() asm volatile("s_waitcnt vmcnt(0)" ::: "memory")

#define XB_TMO      128
#define XB_XCNT(j)  (256  + 64 * (j))
#define XB_XSUB(j)  (1280 + 64 * (j))
#define XB_XGEN(j)  (2304 + 64 * (j))
#define XB_TOP      3328
#define XB_TOPGEN   3392
#define XCD_BAR_WORDS 3456
#define XB_SPIN_CAP (1u << 22)
constexpr int CW_BAR = 4096;

__device__ __forceinline__ unsigned xb_ld(unsigned* p)              { return __hip_atomic_load(p, __ATOMIC_RELAXED, __HIP_MEMORY_SCOPE_AGENT); }
__device__ __forceinline__ unsigned xb_add(unsigned* p, unsigned v) { return __hip_atomic_fetch_add(p, v, __ATOMIC_RELAXED, __HIP_MEMORY_SCOPE_AGENT); }
__device__ __forceinline__ unsigned xb_xcc_id() { return (unsigned)__builtin_amdgcn_s_getreg((3 << 11) | 20) & 0xFu; }
#define XB_SPIN(cond, bar) do { unsigned _sp = 0; while (cond) { __builtin_amdgcn_s_sleep(1); \
    if ((++_sp & 255u) == 0u) { if (xb_ld(&(bar)[XB_TMO])) break; if (_sp > XB_SPIN_CAP) { atomicAdd(&(bar)[XB_TMO], 1u); break; } } } } while (0)

struct XcdBarrier { unsigned* bar; unsigned x; volatile LAS unsigned* st; };

__device__ __forceinline__ XcdBarrier xcd_barrier_post(unsigned* bar, volatile LAS unsigned* st) {
    XcdBarrier b; b.bar = bar; b.x = xb_xcc_id(); b.st = st;
    if (threadIdx.x == 0) (void)xb_add(&bar[XB_XCNT(b.x)], 1u);
    return b;
}
__device__ __forceinline__ void xcd_barrier_complete(unsigned* bar, unsigned x, unsigned& nloc, unsigned& nx) {
    const unsigned G = gridDim.x * gridDim.y * gridDim.z;
    unsigned sum, cnt, mine, sp = 0u;
    for (;;) {
        sum = 0u; cnt = 0u; mine = 0u;
#pragma unroll
        for (unsigned j = 0; j < 16; ++j) { const unsigned c = xb_ld(&bar[XB_XCNT(j)]); sum += c; cnt += (c > 0u) ? 1u : 0u; mine = (j == x) ? c : mine; }
        if (sum == G) break;
        __builtin_amdgcn_s_sleep(1);
        if ((++sp & 255u) == 0u) { if (xb_ld(&bar[XB_TMO])) break; if (sp > XB_SPIN_CAP) { atomicAdd(&bar[XB_TMO], 1u); break; } }
    }
    nloc = mine > 0u ? mine : 1u; nx = cnt > 0u ? cnt : 1u;
}
__device__ __forceinline__ void xcd_barrier(const XcdBarrier& b) {
    asm volatile("s_waitcnt vmcnt(0)" ::: "memory");
    __syncthreads();
    if (threadIdx.x == 0) {
        unsigned* bar = b.bar;
        __builtin_amdgcn_s_waitcnt(0);
        unsigned nloc = b.st[0], nx = b.st[1];
        if (nloc == 0u) { xcd_barrier_complete(bar, b.x, nloc, nx); b.st[0] = nloc; b.st[1] = nx; }
        const unsigned old = xb_add(&bar[XB_XSUB(b.x)], 1u);
        const unsigned gen = old / nloc;
        if (old + 1u == (gen + 1u) * nloc) {
            __builtin_amdgcn_fence(__ATOMIC_RELEASE, "agent");
            asm volatile("s_waitcnt vmcnt(0)" ::: "memory");
            const unsigned og = xb_add(&bar[XB_TOP], 1u);
            const unsigned tg = og / nx;
            if (og + 1u == (tg + 1u) * nx) xb_add(&bar[XB_TOPGEN], 1u);
            else XB_SPIN(xb_ld(&bar[XB_TOPGEN]) == tg, bar);
            __builtin_amdgcn_fence(__ATOMIC_ACQUIRE, "agent");
            xb_add(&bar[XB_XGEN(b.x)], 1u);
            asm volatile("s_waitcnt vmcnt(0)" ::: "memory");
        } else {
            XB_SPIN(xb_ld(&bar[XB_XGEN(b.x)]) == gen, bar);
            __builtin_amdgcn_fence(__ATOMIC_ACQUIRE, "agent");
            asm volatile("s_waitcnt vmcnt(0)" ::: "memory");
        }
    }
    __syncthreads();
}

using pg8::swz_xor; using pg8::xadd32; using pg8::xmax32;
__device__ __forceinline__ float wave_sum(float v) {
    v += swz_xor<1>(v); v += swz_xor<2>(v); v += swz_xor<4>(v); v += swz_xor<8>(v); v += swz_xor<16>(v);
    return xadd32(v);
}
__device__ __forceinline__ unsigned f2bf(float f) { unsigned u = __builtin_bit_cast(unsigned, f); return (u + 0x7fffu + ((u >> 16) & 1u)) >> 16; }
__device__ __forceinline__ unsigned pk2(float lo, float hi) { return f2bf(lo) | (f2bf(hi) << 16); }

__device__ __forceinline__ void tr_item(const float* W, int N, int k0, int n0, bf16_t* WT, int K, int dst_row0, LAS float* scr, int lane, const float* gk = nullptr) {
    float wv[32], gv[32];
#pragma unroll
    for (int i = 0; i < 32; ++i) { const int kk = 2 * i + (lane >> 5); wv[i] = W[(size_t)(k0 + kk) * N + n0 + (lane & 31)]; gv[i] = gk ? gk[k0 + kk] : 1.0f; }
    __builtin_amdgcn_sched_barrier(0);
#pragma unroll
    for (int i = 0; i < 32; ++i) { const int kk = 2 * i + (lane >> 5); scr[kk * 33 + (lane & 31)] = wv[i] * gv[i]; }
    LDS_WAIT(); asm volatile("" ::: "memory");
    const int c = lane & 7;
#pragma unroll
    for (int j = 0; j < 4; ++j) { const int n = (lane >> 3) + 8 * j; const LAS float* s = scr + (8 * c) * 33 + n;
        u32x4 o; o.x = pk2(s[0 * 33], s[1 * 33]); o.y = pk2(s[2 * 33], s[3 * 33]); o.z = pk2(s[4 * 33], s[5 * 33]); o.w = pk2(s[6 * 33], s[7 * 33]);
        *(u32x4*)(WT + (size_t)(dst_row0 + n) * K + k0 + 8 * c) = o; }
    LDS_WAIT(); asm volatile("" ::: "memory");
}
__device__ __forceinline__ int qkv_phys_row(int n0) { const int lb = (n0 & 255) >> 5, wc = lb >> 1, bjh = lb & 1; return (n0 & ~255) + (bjh * 4 + wc) * 32; }

__device__ __forceinline__ void norm_row(const float* xrow, const float* g, bf16_t* orow, float* copyrow, float* f32out, int lane, float* prep = nullptr) {
    const f32x4* xr = (const f32x4*)xrow + lane; const f32x4* gr = (const f32x4*)g + lane;
    f32x4 v[4]; float s = 0.f;
#pragma unroll
    for (int j = 0; j < 4; ++j) { v[j] = xr[64 * j]; s += (v[j].x * v[j].x + v[j].y * v[j].y) + (v[j].z * v[j].z + v[j].w * v[j].w); }
    if (copyrow) {
#pragma unroll
        for (int j = 0; j < 4; ++j) ((f32x4*)copyrow + lane)[64 * j] = v[j]; }
    const float tot = wave_sum(s);
    const float rs = prep ? 1.0f : 1.0f / sqrtf(tot * (1.0f / D) + EPS);
    if (prep && lane < 16) prep[lane] = lane == 0 ? tot : 0.f;
#pragma unroll
    for (int j = 0; j < 4; ++j) { if (!prep) { const f32x4 gg = gr[64 * j]; v[j] = v[j] * rs * gg; } }
    if (orow) { unsigned long long* o8 = (unsigned long long*)orow + lane;
#pragma unroll
        for (int j = 0; j < 4; ++j) o8[64 * j] = (unsigned long long)cvt_pk_bf16(v[j].x, v[j].y) | ((unsigned long long)cvt_pk_bf16(v[j].z, v[j].w) << 32); }
    if (f32out) {
#pragma unroll
        for (int j = 0; j < 4; ++j) ((f32x4*)f32out + lane)[64 * j] = v[j]; }
}

constexpr int RS_OFF = LDSCTL_OFF + 2048;
static_assert(RS_OFF + 8 * 256 * 4 <= LDS_BYTES, "LDS map");
__device__ __forceinline__ void fill_row_factors(LAS unsigned char* ldsp, const pg8::StaticOrder& S, const float* SSQ, int tid) {
    LAS float* RS = (LAS float*)(ldsp + RS_OFF); pg8::Unit u;
    const int r = tid & 255, i0 = tid >> 8;
    f32x4 t[4][4]; bool ok[4];
#pragma unroll
    for (int k = 0; k < 4; ++k) { ok[k] = S.next(i0 + 2 * k, u);
        if (ok[k]) { const f32x4* p = (const f32x4*)(SSQ + (size_t)(u.pm * 256 + r) * 16);
#pragma unroll
            for (int j = 0; j < 4; ++j) t[k][j] = p[j]; } }
#pragma unroll
    for (int k = 0; k < 4; ++k) if (ok[k]) { const f32x4 a = (t[k][0] + t[k][1]) + (t[k][2] + t[k][3]);
        RS[(i0 + 2 * k) * 256 + r] = 1.0f / sqrtf(((a.x + a.y) + (a.z + a.w)) * (1.0f / 1024.0f) + EPS); }
    asm volatile("s_waitcnt vmcnt(0) lgkmcnt(0)" ::: "memory"); __syncthreads();
}

struct AttnItem { const bf16_t* q; const float* kc; const float* vc; const bf16_t* kn; const bf16_t* vn; const float* btab; int cstride, n_cache, k_lo, k_hi, n_total, rel0, head; };

template <int NC, int DV>
__device__ __forceinline__ void attn16_core(const AttnItem& it, int lane, float (&m)[NC], float (&l)[NC], f32x4 (&o)[NC][DV / 16]) {
    const int g = lane >> 4, c16 = lane & 15;
    bf16x8 qop[NC][2];
#pragma unroll
    for (int c = 0; c < NC; ++c)
#pragma unroll
        for (int s = 0; s < 2; ++s) qop[c][s] = *(const bf16x8*)(it.q + (size_t)c16 * D + c * 64 + 32 * s + 8 * g);
#pragma unroll
    for (int c = 0; c < NC; ++c) { m[c] = -1e30f; l[c] = 0.f;
#pragma unroll
        for (int e = 0; e < DV / 16; ++e) o[c][e] = (f32x4){0.f, 0.f, 0.f, 0.f}; }
    for (int k0 = it.k_lo; k0 < it.k_hi; k0 += 32) {
        const bool cache = k0 < it.n_cache;
        int vkey[8];
#pragma unroll
        for (int j = 0; j < 8; ++j) { int key = k0 + 16 * (j >> 2) + 4 * g + (j & 3); vkey[j] = key < it.n_total ? key : it.n_total - 1; }
        f32x4 sacc[NC][2];
        float vv[DV / 16][8];
        if (cache) {
#pragma unroll
            for (int e = 0; e < DV / 32; ++e)
#pragma unroll
                for (int j = 0; j < 8; ++j) vv[e][j] = it.vc[(size_t)vkey[j] * it.cstride + e * 16 + c16];
            f32x4 kv[2][NC][2][2];
#pragma unroll
            for (int t = 0; t < 2; ++t) { const int key = k0 + 16 * t + c16;
#pragma unroll
                for (int c = 0; c < NC; ++c)
#pragma unroll
                    for (int s = 0; s < 2; ++s) { const float* p = it.kc + (size_t)key * it.cstride + c * 64 + 32 * s + 8 * g; kv[t][c][s][0] = *(const f32x4*)p; kv[t][c][s][1] = *(const f32x4*)(p + 4); } }
            __builtin_amdgcn_sched_barrier(0);
#pragma unroll
            for (int t = 0; t < 2; ++t)
#pragma unroll
                for (int c = 0; c < NC; ++c) { f32x4 acc = (f32x4){0.f, 0.f, 0.f, 0.f};
#pragma unroll
                    for (int s = 0; s < 2; ++s) { const f32x4 v0 = kv[t][c][s][0], v1 = kv[t][c][s][1];
                        u32x4 w; w.x = cvt_pk_bf16(v0.x, v0.y); w.y = cvt_pk_bf16(v0.z, v0.w); w.z = cvt_pk_bf16(v1.x, v1.y); w.w = cvt_pk_bf16(v1.z, v1.w);
                        acc = __builtin_amdgcn_mfma_f32_16x16x32_bf16(__builtin_bit_cast(bf16x8, w), qop[c][s], acc, 0, 0, 0); }
                    sacc[c][t] = acc; }
            __builtin_amdgcn_sched_barrier(0);
#pragma unroll
            for (int e = DV / 32; e < DV / 16; ++e)
#pragma unroll
                for (int j = 0; j < 8; ++j) vv[e][j] = it.vc[(size_t)vkey[j] * it.cstride + e * 16 + c16];
            __builtin_amdgcn_sched_barrier(0);
        } else {
#pragma unroll
            for (int t = 0; t < 2; ++t) {
                int key = k0 + 16 * t + c16; key = key < it.n_total ? key : it.n_total - 1;
#pragma unroll
                for (int c = 0; c < NC; ++c) {
                    f32x4 acc = (f32x4){0.f, 0.f, 0.f, 0.f};
#pragma unroll
                    for (int s = 0; s < 2; ++s) {
                        const bf16x8 a = *(const bf16x8*)(it.kn + (size_t)(key - it.n_cache) * D + c * 64 + 32 * s + 8 * g);
                        acc = __builtin_amdgcn_mfma_f32_16x16x32_bf16(a, qop[c][s], acc, 0, 0, 0);
                    }
                    sacc[c][t] = acc;
                }
            }
        }
        if (it.btab) {
            float bvv[2][4];
#pragma unroll
            for (int t = 0; t < 2; ++t)
#pragma unroll
                for (int r = 0; r < 4; ++r) { const int kidx = k0 + 16 * t + 4 * g + r; int rel = it.rel0 + c16 - kidx; rel = rel < -128 ? -128 : (rel > 128 ? 128 : rel); bvv[t][r] = it.btab[(rel + 128) * 16 + it.head]; }
#pragma unroll
            for (int t = 0; t < 2; ++t)
#pragma unroll
                for (int r = 0; r < 4; ++r)
#pragma unroll
                    for (int c = 0; c < NC; ++c) sacc[c][t][r] += bvv[t][r] * LOG2E;
        }
#pragma unroll
        for (int t = 0; t < 2; ++t)
#pragma unroll
            for (int r = 0; r < 4; ++r) { const int kidx = k0 + 16 * t + 4 * g + r;
                if (kidx >= it.n_total) {
#pragma unroll
                    for (int c = 0; c < NC; ++c) sacc[c][t][r] = -1e30f; } }
        bf16x8 pop[NC];
#pragma unroll
        for (int c = 0; c < NC; ++c) {
            float bm = fmaxf(fmaxf(fmaxf(sacc[c][0][0], sacc[c][0][1]), fmaxf(sacc[c][0][2], sacc[c][0][3])), fmaxf(fmaxf(sacc[c][1][0], sacc[c][1][1]), fmaxf(sacc[c][1][2], sacc[c][1][3])));
            bm = fmaxf(bm, swz_xor<16>(bm)); bm = xmax32(bm);
            const float mn = fmaxf(m[c], bm), alpha = __builtin_amdgcn_exp2f(m[c] - mn); m[c] = mn;
            float p[8], ps = 0.f;
#pragma unroll
            for (int t = 0; t < 2; ++t)
#pragma unroll
                for (int r = 0; r < 4; ++r) { p[4 * t + r] = __builtin_amdgcn_exp2f(sacc[c][t][r] - mn); ps += p[4 * t + r]; }
            l[c] = l[c] * alpha + ps;
#pragma unroll
            for (int e = 0; e < DV / 16; ++e) o[c][e] = o[c][e] * alpha;
            u32x4 w; w.x = cvt_pk_bf16(p[0], p[1]); w.y = cvt_pk_bf16(p[2], p[3]); w.z = cvt_pk_bf16(p[4], p[5]); w.w = cvt_pk_bf16(p[6], p[7]); pop[c] = __builtin_bit_cast(bf16x8, w);
        }
#pragma unroll
        for (int e = 0; e < DV / 16; ++e) {
            bf16x8 av;
            if (cache) { u32x4 w; w.x = cvt_pk_bf16(vv[e][0], vv[e][1]); w.y = cvt_pk_bf16(vv[e][2], vv[e][3]); w.z = cvt_pk_bf16(vv[e][4], vv[e][5]); w.w = cvt_pk_bf16(vv[e][6], vv[e][7]); av = __builtin_bit_cast(bf16x8, w); }
            else { unsigned short v[8];
#pragma unroll
                for (int j = 0; j < 8; ++j) v[j] = it.vn[(size_t)(vkey[j] - it.n_cache) * D + e * 16 + c16];
                u32x4 w; w.x = v[0] | ((unsigned)v[1] << 16); w.y = v[2] | ((unsigned)v[3] << 16); w.z = v[4] | ((unsigned)v[5] << 16); w.w = v[6] | ((unsigned)v[7] << 16); av = __builtin_bit_cast(bf16x8, w); }
#pragma unroll
            for (int c = 0; c < NC; ++c) o[c][e] = __builtin_amdgcn_mfma_f32_16x16x32_bf16(av, pop[c], o[c][e], 0, 0, 0);
        }
    }
#pragma unroll
    for (int c = 0; c < NC; ++c) { l[c] += swz_xor<16>(l[c]); l[c] = xadd32(l[c]); }
}


typedef float f32x16s __attribute__((ext_vector_type(16)));
template <class F>
__device__ __forceinline__ void skinny_gemm(LAS unsigned char* lds, const bf16_t* A, int lda, const bf16_t* Bt, int K, int ncb, const F& f, int vcu, int G, int wave, int lane) {
    const int r32 = lane & 31, hi = lane >> 5, tid = wave * 64 + lane;
    LAS float* part = (LAS float*)lds;
    for (int item = vcu; item < 8 * ncb; item += G) {
        const int rb = item & 7, cb = item >> 3;
        const bf16_t* ap = A + f.aoff(cb) + (size_t)(rb * 32 + r32) * lda + hi * 8 + wave * (K >> 3);
        const bf16_t* b0 = Bt + (size_t)(f.brow(cb, 0) + r32) * K + hi * 8 + wave * (K >> 3);
        const bf16_t* b1 = Bt + (size_t)(f.brow(cb, 1) + r32) * K + hi * 8 + wave * (K >> 3);
        const f32x4 pv = f.pre(rb * 32 + (tid >> 4), cb, tid & 15);
        f32x16s acc0, acc1;
#pragma unroll
        for (int r = 0; r < 16; ++r) { acc0[r] = 0.f; acc1[r] = 0.f; }
        const int nks = K >> 7;
        if (nks >= 8) {
            for (int ks = 0; ks < nks; ks += 8) {
                bf16x8 a[8], p[8], qv[8];
#pragma unroll
                for (int j = 0; j < 8; ++j) { a[j] = *(const bf16x8*)(ap + (ks + j) * 16); p[j] = *(const bf16x8*)(b0 + (ks + j) * 16); qv[j] = *(const bf16x8*)(b1 + (ks + j) * 16); }
                __builtin_amdgcn_sched_barrier(0);
#pragma unroll
                for (int j = 0; j < 8; ++j) { acc0 = __builtin_amdgcn_mfma_f32_32x32x16_bf16(a[j], p[j], acc0, 0, 0, 0); acc1 = __builtin_amdgcn_mfma_f32_32x32x16_bf16(a[j], qv[j], acc1, 0, 0, 0); }
                __builtin_amdgcn_sched_barrier(0);
            }
        } else {
            for (int ks = 0; ks < nks; ks += 2) {
                const bf16x8 a0 = *(const bf16x8*)(ap + ks * 16), a1 = *(const bf16x8*)(ap + ks * 16 + 16);
                const bf16x8 p0 = *(const bf16x8*)(b0 + ks * 16), p1 = *(const bf16x8*)(b0 + ks * 16 + 16);
                const bf16x8 q0 = *(const bf16x8*)(b1 + ks * 16), q1 = *(const bf16x8*)(b1 + ks * 16 + 16);
                acc0 = __builtin_amdgcn_mfma_f32_32x32x16_bf16(a0, p0, acc0, 0, 0, 0); acc1 = __builtin_amdgcn_mfma_f32_32x32x16_bf16(a0, q0, acc1, 0, 0, 0);
                acc0 = __builtin_amdgcn_mfma_f32_32x32x16_bf16(a1, p1, acc0, 0, 0, 0); acc1 = __builtin_amdgcn_mfma_f32_32x32x16_bf16(a1, q1, acc1, 0, 0, 0);
            }
        }
        LAS float* pw = part + wave * (32 * 65);
#pragma unroll
        for (int r = 0; r < 16; ++r) { const int row = (r & 3) + 8 * (r >> 2) + 4 * hi; pw[row * 65 + r32] = acc0[r]; pw[row * 65 + 32 + r32] = acc1[r]; }
        asm volatile("s_waitcnt lgkmcnt(0)\n\ts_barrier" ::: "memory");
        const int row = tid >> 4, q = tid & 15;
        float x[4] = {0.f, 0.f, 0.f, 0.f};
#pragma unroll
        for (int w = 0; w < 8; ++w) { const LAS float* p = part + w * (32 * 65) + row * 65 + 4 * q;
#pragma unroll
            for (int i = 0; i < 4; ++i) x[i] += p[i]; }
        asm volatile("s_waitcnt lgkmcnt(0)\n\ts_barrier" ::: "memory");
        f.epi(rb * 32 + row, cb, q, x, pv);
    }
}
template <class F>
__device__ __forceinline__ void sk_reduce_epi(LAS float* part, int wave, int hi, int r32, int tid, const f32x16s& accA, const f32x16s& accB, const F& f, int srow0, int cb, const f32x4& pv) {
    LAS float* pw = part + wave * (32 * 65);
#pragma unroll
    for (int r = 0; r < 16; ++r) { const int row = (r & 3) + 8 * (r >> 2) + 4 * hi; pw[row * 65 + r32] = accA[r]; pw[row * 65 + 32 + r32] = accB[r]; }
    asm volatile("s_waitcnt lgkmcnt(0)\n\ts_barrier" ::: "memory");
    const int row = tid >> 4, q = tid & 15;
    float x[4] = {0.f, 0.f, 0.f, 0.f};
#pragma unroll
    for (int w = 0; w < 8; ++w) { const LAS float* p = part + w * (32 * 65) + row * 65 + 4 * q;
#pragma unroll
        for (int i = 0; i < 4; ++i) x[i] += p[i]; }
    asm volatile("s_waitcnt lgkmcnt(0)\n\ts_barrier" ::: "memory");
    f.epi(srow0 + row, cb, q, x, pv);
}
template <class F>
__device__ __forceinline__ void skinny_gemm2(LAS unsigned char* lds, const bf16_t* A, int lda, const bf16_t* Bt, int ncb, const F& f, int vcu, int G, int wave, int lane) {
    constexpr int K = 1024;
    const int r32 = lane & 31, hi = lane >> 5, tid = wave * 64 + lane;
    LAS float* part = (LAS float*)lds;
    for (int item = vcu; item < 4 * ncb; item += G) {
        const int rb = item & 7, cb = (item >> 3) * 2;
        const bf16_t* ap = A + f.aoff(cb) + (size_t)(rb * 32 + r32) * lda + hi * 8 + wave * (K >> 3);
        const bf16_t* b0 = Bt + (size_t)(f.brow(cb, 0) + r32) * K + hi * 8 + wave * (K >> 3);
        const bf16_t* b1 = Bt + (size_t)(f.brow(cb, 1) + r32) * K + hi * 8 + wave * (K >> 3);
        const bf16_t* b2 = Bt + (size_t)(f.brow(cb + 1, 0) + r32) * K + hi * 8 + wave * (K >> 3);
        const bf16_t* b3 = Bt + (size_t)(f.brow(cb + 1, 1) + r32) * K + hi * 8 + wave * (K >> 3);
        const f32x4 pv = f.pre(rb * 32 + (tid >> 4), cb, tid & 15);
        f32x16s acc0, acc1, acc2, acc3;
#pragma unroll
        for (int r = 0; r < 16; ++r) { acc0[r] = 0.f; acc1[r] = 0.f; acc2[r] = 0.f; acc3[r] = 0.f; }
#pragma unroll
        for (int ks = 0; ks < 8; ks += 4) {
            bf16x8 a[4], p0[4], p1[4], p2[4], p3[4];
#pragma unroll
            for (int j = 0; j < 4; ++j) { a[j] = *(const bf16x8*)(ap + (ks + j) * 16); p0[j] = *(const bf16x8*)(b0 + (ks + j) * 16); p1[j] = *(const bf16x8*)(b1 + (ks + j) * 16);
                p2[j] = *(const bf16x8*)(b2 + (ks + j) * 16); p3[j] = *(const bf16x8*)(b3 + (ks + j) * 16); }
            __builtin_amdgcn_sched_barrier(0);
#pragma unroll
            for (int j = 0; j < 4; ++j) { acc0 = __builtin_amdgcn_mfma_f32_32x32x16_bf16(a[j], p0[j], acc0, 0, 0, 0); acc1 = __builtin_amdgcn_mfma_f32_32x32x16_bf16(a[j], p1[j], acc1, 0, 0, 0);
                acc2 = __builtin_amdgcn_mfma_f32_32x32x16_bf16(a[j], p2[j], acc2, 0, 0, 0); acc3 = __builtin_amdgcn_mfma_f32_32x32x16_bf16(a[j], p3[j], acc3, 0, 0, 0); }
            __builtin_amdgcn_sched_barrier(0);
        }
        sk_reduce_epi(part, wave, hi, r32, tid, acc0, acc1, f, rb * 32, cb, pv);
        sk_reduce_epi(part, wave, hi, r32, tid, acc2, acc3, f, rb * 32, cb + 1, pv);
    }
}
__device__ __forceinline__ u32x2 pack4(const float (&x)[4]) { u32x2 w; w.x = cvt_pk_bf16(x[0], x[1]); w.y = cvt_pk_bf16(x[2], x[3]); return w; }
template <bool ROPE> struct SkQKV {
    bf16_t* Q; size_t qkv_stride; const float *qg, *kg, *rope; float* oks; size_t kvs_stride; const float* SSQ;
    __device__ __forceinline__ size_t aoff(int) const { return 0; }
    __device__ __forceinline__ int brow(int cb, int blk) const { const int kind = cb >> 4, hc = cb & 15, n0 = kind * 1024 + hc * 64; return (n0 & ~255) + (blk * 4 + (hc & 3)) * 32; }
    __device__ __forceinline__ f32x4 pre(int srow, int, int) const { return (f32x4){pg8::row_rstd(SSQ, MP + srow), 0.f, 0.f, 0.f}; }
    __device__ __forceinline__ void epi(int srow, int cb, int q, float (&x)[4], const f32x4& pv) const {
        const int kind = cb >> 4, hc = cb & 15, d0 = 4 * q, col = hc * 64 + d0;
        { const float rr = pv.x;
#pragma unroll
          for (int i = 0; i < 4; ++i) x[i] *= rr; }
        if (kind < 2) {
            float ss = (x[0] * x[0] + x[1] * x[1]) + (x[2] * x[2] + x[3] * x[3]);
            ss += swz_xor<1>(ss); ss += swz_xor<2>(ss); ss += swz_xor<4>(ss); ss += swz_xor<8>(ss);
            const float rs = 1.0f / sqrtf(ss * (1.0f / 64.0f) + EPS);
            const f32x4 g = *(const f32x4*)((kind == 0 ? qg : kg) + d0);
#pragma unroll
            for (int i = 0; i < 4; ++i) x[i] *= rs * g[i];
            if (ROPE) {
                float y[4];
#pragma unroll
                for (int i = 0; i < 4; ++i) y[i] = swz_xor<8>(x[i]);
                const float* rp = rope + (size_t)(SEQ + (srow & (DSEQ - 1))) * 64 + (d0 & 31);
                const f32x4 c = *(const f32x4*)rp, sn = *(const f32x4*)(rp + 32);
                const float sg = d0 < 32 ? -1.0f : 1.0f;
#pragma unroll
                for (int i = 0; i < 4; ++i) x[i] = x[i] * c[i] + sg * y[i] * sn[i];
            }
        }
        if (kind >= 1) *(f32x4*)(oks + (size_t)(kind - 1) * kvs_stride + (size_t)srow * D + col) = (f32x4){x[0], x[1], x[2], x[3]};
        if (kind == 0) {
#pragma unroll
            for (int i = 0; i < 4; ++i) x[i] *= QSCALE; }
        *(u32x2*)(Q + (size_t)kind * qkv_stride + (size_t)(MP + srow) * D + col) = pack4(x);
    }
};
struct SkResAdd {
    bf16_t* Xb; const float* Xrs32; float* X32s; float* SSQ;
    __device__ __forceinline__ size_t aoff(int) const { return 0; }
    __device__ __forceinline__ int brow(int cb, int blk) const { return cb * 64 + blk * 32; }
    __device__ __forceinline__ f32x4 pre(int srow, int cb, int q) const { const int col = cb * 64 + 4 * q;
        if (Xrs32) return *(const f32x4*)(Xrs32 + (size_t)srow * D + col);
        const u32x2 w = *(const u32x2*)(Xb + (size_t)(MP + srow) * D + col); return (f32x4){bf2f(w.x & 0xffff), bf2f(w.x >> 16), bf2f(w.y & 0xffff), bf2f(w.y >> 16)}; }
    __device__ __forceinline__ void epi(int srow, int cb, int q, float (&x)[4], const f32x4& pv) const { const int col = cb * 64 + 4 * q;
        const f32x4 v = pv + (f32x4){x[0], x[1], x[2], x[3]};
        if (X32s) *(f32x4*)(X32s + (size_t)srow * D + col) = v;
        else { float ss = (v.x * v.x + v.y * v.y) + (v.z * v.z + v.w * v.w); ss += swz_xor<1>(ss); ss += swz_xor<2>(ss); ss += swz_xor<4>(ss); ss += swz_xor<8>(ss);
            if (q == 0) SSQ[(size_t)(MP + srow) * 16 + cb] = ss;
            u32x2 w; w.x = cvt_pk_bf16(v.x, v.y); w.y = cvt_pk_bf16(v.z, v.w); *(u32x2*)(Xb + (size_t)(MP + srow) * D + col) = w; } }
};
struct SkRelu2 {
    bf16_t* O; const float* SSQ;
    __device__ __forceinline__ size_t aoff(int) const { return 0; }
    __device__ __forceinline__ int brow(int cb, int blk) const { return cb * 64 + blk * 32; }
    __device__ __forceinline__ f32x4 pre(int srow, int, int) const { return (f32x4){pg8::row_rstd(SSQ, MP + srow), 0.f, 0.f, 0.f}; }
    __device__ __forceinline__ void epi(int srow, int cb, int q, float (&x)[4], const f32x4& pv) const { const float rr = pv.x;
#pragma unroll
        for (int i = 0; i < 4; ++i) { const float v = fmaxf(x[i] * rr, 0.f); x[i] = v * v; }
        *(u32x2*)(O + (size_t)(MP + srow) * FF + cb * 64 + 4 * q) = pack4(x); }
};
struct SkBin {
    bf16_t *G, *U; const float* bias; float* ocs; const float* SSQ;
    __device__ __forceinline__ size_t aoff(int) const { return 0; }
    __device__ __forceinline__ int brow(int cb, int blk) const { return cb * 64 + blk * 32; }
    __device__ __forceinline__ f32x4 pre(int srow, int, int) const { return (f32x4){pg8::row_rstd(SSQ, MP + srow), 0.f, 0.f, 0.f}; }
    __device__ __forceinline__ void epi(int srow, int cb, int q, float (&x)[4], const f32x4& pv) const {
        const int col = cb * 64 + 4 * q; const f32x4 bv = *(const f32x4*)(bias + col); const float rr = pv.x;
#pragma unroll
        for (int i = 0; i < 4; ++i) x[i] = x[i] * rr + bv[i];
        if (col < D) {
#pragma unroll
            for (int i = 0; i < 4; ++i) x[i] = pg8::gelu_tanh(x[i]);
            *(u32x2*)(G + (size_t)(MP + srow) * D + col) = pack4(x);
        } else {
            const int uc = col - D; *(u32x2*)(U + (size_t)(MP + srow) * D + uc) = pack4(x);
            const int t = srow & (DSEQ - 1), b = srow >> 4;
            if (t >= DSEQ - 3) *(f32x4*)(ocs + (size_t)(b * 3 + (t - (DSEQ - 3))) * D + uc) = (f32x4){x[0], x[1], x[2], x[3]};
        }
    }
};
struct SkGates {
    const bf16_t* XCB; const float *gab, *gxb, *sp8; bf16_t *AA, *BB;
    __device__ __forceinline__ size_t aoff(int cb) const { return (size_t)(cb >> 3) * MT * 256; }
    __device__ __forceinline__ int brow(int cb, int blk) const { const int nb = cb >> 3, cg = cb & 7; return (nb * 2 + (cg >> 2)) * 256 + blk * 128 + (cg & 3) * 32; }
    __device__ __forceinline__ f32x4 pre(int, int, int) const { return (f32x4){0.f, 0.f, 0.f, 0.f}; }
    __device__ __forceinline__ void epi(int srow, int cb, int q, float (&x)[4], const f32x4&) const {
        float y[4];
#pragma unroll
        for (int i = 0; i < 4; ++i) y[i] = swz_xor<8>(x[i]);
        if (q < 8) {
            const int nb = cb >> 3, cg = cb & 7, cin = cg * 32 + 4 * q, ch = nb * 256 + cin;
            const f32x4 ba = *(const f32x4*)(gab + ch), bx = *(const f32x4*)(gxb + ch), sp = *(const f32x4*)(sp8 + ch);
            const u32x2 xw = *(const u32x2*)(XCB + ((size_t)nb * MT + MP + srow) * 256 + cin);
            f32x4 a, b;
#pragma unroll
            for (int i = 0; i < 4; ++i) {
                const unsigned w = i < 2 ? xw.x : xw.y; const float xc = bf2f((unsigned short)((i & 1) ? (w >> 16) : (w & 0xffffu)));
                const float r = 1.0f / (1.0f + __expf(-(x[i] + ba[i]))), ig = 1.0f / (1.0f + __expf(-(y[i] + bx[i])));
                const float la = -r * sp[i], t2 = 2.0f * la;
                a[i] = la;
                const float poly = -t2 * (1.0f + t2 * (0.5f + t2 * (0.16666667f + t2 * (0.041666668f + t2 * (0.0083333338f + t2 * 0.0013888889f)))));
                const float em = t2 > -0.25f ? poly : 1.0f - __expf(t2);
                b[i] = sqrtf(em) * (ig * xc); }
            { u32x2 wa, wb; wa.x = cvt_pk_bf16(a[0], a[1]); wa.y = cvt_pk_bf16(a[2], a[3]); wb.x = cvt_pk_bf16(b[0], b[1]); wb.y = cvt_pk_bf16(b[2], b[3]);
              *(u32x2*)(AA + (size_t)(MP + srow) * D + ch) = wa; *(u32x2*)(BB + (size_t)(MP + srow) * D + ch) = wb; }
        }
    }
};

struct Args;
struct Args { const GAS float* in[N_IN]; GAS float* out; GAS unsigned char* ws;     int ph_lo, ph_hi, single, dupmask; float lam_init[2]; float rope_inv[32]; };

typedef const __attribute__((address_space(4))) Args* KArgs;
__device__ __forceinline__ KArgs kargs() { KArgs p = (KArgs)__builtin_amdgcn_kernarg_segment_ptr(); asm volatile("" : "+s"(p)); return p; }
__global__ void __launch_bounds__(NWAVES * 64, 2) fwd_kernel(Args args) {
    extern __shared__ __attribute__((aligned(16))) unsigned char lds[];
    LAS unsigned char* const ldsp = (LAS unsigned char*)lds;
    volatile LAS unsigned* const MISC = (volatile LAS unsigned*)(ldsp + MISC_OFF);
    const int tid = threadIdx.x; const int wave = __builtin_amdgcn_readfirstlane(tid >> 6);
    const int G = gridDim.x; const int bx = blockIdx.x; const int vcu = (G % 8 == 0) ? (bx % 8) * (G / 8) + bx / 8 : bx;
    const int gw = vcu * NWAVES + wave, NGW = G * NWAVES;
    const int NGT = NGW * 64;
    gu32* const ctl = (gu32*)((unsigned char*)args.ws + WS_CTL);
    for (int u = tid; u < (LDS_BYTES - LDSCTL_OFF) / 4; u += NWAVES * 64) ((LAS unsigned*)(ldsp + LDSCTL_OFF))[u] = 0u;
    __syncthreads();
    XcdBarrier bar; bar.bar = (unsigned*)(ctl + CW_BAR); bar.x = 0; bar.st = nullptr;
    if (args.single) bar = xcd_barrier_post((unsigned*)(ctl + CW_BAR), MISC + 8);
    const int lo = args.ph_lo, hi = args.ph_hi;
#ifndef PHM
#define PHM 0xFFFFFFFFu
#endif
#define EN(b) (((PHM) >> (b)) & 1u)
#define RUN(k) (lo <= (k) && (k) < hi)
#define SEAM() do { if (args.single) xcd_barrier(bar); } while (0)

#if PROBE_DUP
#define REP_BEGIN(k) for (int rep_ = 0, nrep_ = (args.dupmask >> (k)) & 1; rep_ <= nrep_; ++rep_) {
#define REP_END }
#define REP_DUMMY (rep_ < nrep_)
#else
#define REP_BEGIN(k) {
#define REP_END }
#define REP_DUMMY false
#endif
#define INP(i) ((const float*)ap->in[i])
#define PHASE_PTRS \
    unsigned ones_ = ~0u; asm volatile("" : "+s"(ones_)); int lane = (int)__builtin_amdgcn_mbcnt_hi(ones_, __builtin_amdgcn_mbcnt_lo(ones_, 0u)); asm volatile("" : "+v"(lane)); const int gt = gw * 64 + lane; (void)gt; const int ptid = wave * 64 + lane; (void)ptid; int pG = G, pbx = bx; asm volatile("" : "+s"(pG), "+s"(pbx));   \
    const KArgs ap = kargs(); unsigned char* const ws = (unsigned char*)ap->ws; float* const out = (float*)ap->out; (void)out; \
    float* const X = (float*)(ws + WS_X); (void)X; bf16_t* const XN = (bf16_t*)(ws + WS_XN); (void)XN; \
    bf16_t* const Qb = (bf16_t*)(ws + WS_Q); (void)Qb; bf16_t* const Kb = (bf16_t*)(ws + WS_K); (void)Kb; bf16_t* const Vb = (bf16_t*)(ws + WS_V); (void)Vb; bf16_t* const ON = (bf16_t*)(ws + WS_ON); (void)ON; \
    bf16_t* const Hb = (bf16_t*)(ws + WS_H); (void)Hb; float* const AA = (float*)(ws + WS_AA); (void)AA; float* const BB = (float*)(ws + WS_BB); (void)BB; \
    float* const ROPE = (float*)(ws + WS_ROPE); (void)ROPE; float* const SP8 = (float*)(ws + WS_SP8); (void)SP8; float* const SSQ0 = (float*)(ws + WS_SSQ); (void)SSQ0; float* const SSQ1 = SSQ0 + (size_t)MT * 16; (void)SSQ1; \
    float* const CP = (float*)(ws + WS_CP); (void)CP; float* const CH = (float*)(ws + WS_CH); (void)CH; \
    float* const PO = (float*)(ws + WS_PO); (void)PO; float* const PML = (float*)(ws + WS_PML); (void)PML; \
    bf16_t* const Wb = (bf16_t*)(ws + WS_W); (void)Wb; \
    bf16_t* const Gb = Qb; (void)Gb; bf16_t* const Ub = Kb; (void)Ub; bf16_t* const XCB = Vb; (void)XCB; bf16_t* const HG = ON; (void)HG;

    if (EN(0) && RUN(0)) {
            REP_BEGIN(0)
            PHASE_PTRS
        LAS float* scr = (LAS float*)(ldsp + RING_OFF + wave * 16384);
        constexpr int I_AIN = 16 * 96, I_SQ = 16 * 32, I_BIN = 16 * 64, I_G = 4 * 8, I_1 = 16 * 128, I_2 = 64 * 32;
        constexpr int NITEMS = 2 * I_AIN + 2 * I_SQ + I_BIN + 8 * I_G + I_SQ + I_AIN + I_SQ + 4 * I_1 + 4 * I_2;
        for (int it = gw; it < NITEMS; it += NGW) {
            int r = it;
            if (r < 2 * I_AIN) { const int li = r / I_AIN, q = r % I_AIN, kb = q / 96, nb = q % 96;
                tr_item(INP(IN_AWIN) + (size_t)li * 1024 * 3072, 3072, 64 * kb, 32 * nb, Wb + W_AIN + (size_t)li * 3072 * 1024, 1024, qkv_phys_row(32 * nb), scr, lane, INP(IN_GMIX) + 3 * li * D); continue; } r -= 2 * I_AIN;
            if (r < 2 * I_SQ) { const int li = r / I_SQ, q = r % I_SQ, kb = q / 32, nb = q % 32;
                tr_item(INP(IN_AWOUT) + (size_t)li * 1024 * 1024, 1024, 64 * kb, 32 * nb, Wb + W_AOUT + (size_t)li * 1024 * 1024, 1024, 32 * nb, scr, lane); continue; } r -= 2 * I_SQ;
            if (r < I_BIN) { const int kb = r / 64, nb = r % 64;
                tr_item(INP(IN_BWIN), 2048, 64 * kb, 32 * nb, Wb + W_BIN, 1024, 32 * nb, scr, lane, INP(IN_GMIX) + 1 * D); continue; } r -= I_BIN;
            if (r < 8 * I_G) { const int mi = r / I_G, q = r % I_G, gk = mi >> 2, blk = mi & 3, kb = q / 8, d0 = q % 8;
                const float* src = (gk == 0 ? INP(IN_BGAW) : INP(IN_BGXW)) + (size_t)blk * 256 * 256;
                tr_item(src, 256, 64 * kb, 32 * d0, Wb + W_BG, 256, (blk * 2 + (d0 >> 2)) * 256 + gk * 128 + (d0 & 3) * 32, scr, lane); continue; } r -= 8 * I_G;
            if (r < I_SQ) { const int kb = r / 32, nb = r % 32; tr_item(INP(IN_BWOUT), 1024, 64 * kb, 32 * nb, Wb + W_BOUT, 1024, 32 * nb, scr, lane); continue; } r -= I_SQ;
            if (r < I_AIN) { const int kb = r / 96, nb = r % 96; tr_item(INP(IN_CWIN), 3072, 64 * kb, 32 * nb, Wb + W_CIN, 1024, qkv_phys_row(32 * nb), scr, lane, INP(IN_GMIX) + 2 * D); continue; } r -= I_AIN;
            if (r < I_SQ) { const int kb = r / 32, nb = r % 32; tr_item(INP(IN_CWOUT), 1024, 64 * kb, 32 * nb, Wb + W_COUT, 1024, 32 * nb, scr, lane); continue; } r -= I_SQ;
            if (r < 4 * I_1) { const int li = r / I_1, q = r % I_1, kb = q / 128, nb = q % 128;
                tr_item(INP(IN_W1) + (size_t)li * 1024 * 4096, 4096, 64 * kb, 32 * nb, Wb + W_1 + (size_t)li * 4096 * 1024, 1024, 32 * nb, scr, lane, INP(IN_GMLP) + li * D); continue; } r -= 4 * I_1;
            { const int li = r / I_2, q = r % I_2, kb = q / 32, nb = q % 32;
                tr_item(INP(IN_W2) + (size_t)li * 4096 * 1024, 1024, 64 * kb, 32 * nb, Wb + W_2 + (size_t)li * 1024 * 4096, 4096, 32 * nb, scr, lane); }
        }
        for (int i = gt; i < (SEQ + DSEQ) * 32; i += NGT) { const int tp = i >> 5, d = i & 31; const int pos = tp < SEQ ? tp : PAST + (tp - SEQ);
            const float ang = (float)pos * ap->rope_inv[d];
            ROPE[(size_t)tp * 64 + d] = cosf(ang); ROPE[(size_t)tp * 64 + 32 + d] = sinf(ang); }
        for (int i = gt; i < D; i += NGT) { const float lm = INP(IN_BLAM)[i]; SP8[i] = 8.0f * (fmaxf(-lm, 0.f) + log1pf(expf(-fabsf(lm)))); }
        for (int m0 = gw; m0 < MT; m0 += 2 * NGW) {
            f32x4 v[2][4];
#pragma unroll
            for (int k = 0; k < 2; ++k) { const int mrow = m0 + k * NGW;
                if (mrow < MT) { const float* src = mrow < MP ? INP(IN_XP) + (size_t)mrow * D : INP(IN_XS) + (size_t)(mrow - MP) * D;
#pragma unroll
                    for (int j = 0; j < 4; ++j) v[k][j] = ((const f32x4*)src + lane)[64 * j]; } }
#pragma unroll
            for (int k = 0; k < 2; ++k) { const int mrow = m0 + k * NGW;
                if (mrow < MT) { float s = 0.f;
#pragma unroll
                    for (int j = 0; j < 4; ++j) s += (v[k][j].x * v[k][j].x + v[k][j].y * v[k][j].y) + (v[k][j].z * v[k][j].z + v[k][j].w * v[k][j].w);
                    const float tot = wave_sum(s);
                    if (lane < 16) SSQ1[(size_t)mrow * 16 + lane] = lane == 0 ? tot : 0.f;
                    unsigned long long* o8 = (unsigned long long*)(XN + (size_t)mrow * D) + lane;
#pragma unroll
                    for (int j = 0; j < 4; ++j) o8[64 * j] = (unsigned long long)cvt_pk_bf16(v[k][j].x, v[k][j].y) | ((unsigned long long)cvt_pk_bf16(v[k][j].z, v[k][j].w) << 32); } }
        }
        SEAM();
            REP_END
    }

    for (int L = 0; L < 4; ++L) {
        const int kind = L % 3, idx = L / 3, base = 1 + 16 * L;
        if (kind == 0) {
            if (EN(1) && RUN(base + 0)) {
            REP_BEGIN(1)
            PHASE_PTRS
                pg8::Gemm g{XN, Wb + W_AIN + (size_t)idx * 3072 * 1024, MP, 3072, 1024, 0, 0}; pg8::StaticOrder S; S.init(MP, 3072, pG, pbx);
                pg8::EpiQKV<true> E{Qb, ACT_BF / 2, INP(IN_AQG) + idx * 64, INP(IN_AKG) + idx * 64, ROPE,
                    out + OUT_AKP + (size_t)idx * MP * D, out + OUT_AKS + (size_t)idx * MS * D, OUT_AVP - OUT_AKP, OUT_AVS - OUT_AKS, 0, (const LAS float*)(ldsp + RS_OFF)};
                fill_row_factors(ldsp, S, SSQ1, ptid);
                pg8::gemm_phase<pg8::EpiQKV<true>, pg8::StaticOrder, true, true>(ldsp + RING_OFF, g, S, E, ptid);
                { SkQKV<true> F{Qb, ACT_BF / 2, INP(IN_AQG) + idx * 64, INP(IN_AKG) + idx * 64, ROPE, out + OUT_AKS + (size_t)idx * MS * D, OUT_AVS - OUT_AKS, SSQ1};
                  skinny_gemm2(ldsp + RING_OFF, XN + (size_t)MP * D, D, Wb + W_AIN + (size_t)idx * 3072 * 1024, 48, F, vcu, pG, wave, lane); }
                SEAM();
            REP_END
            }
            if (EN(2) && RUN(base + 1)) {
            REP_BEGIN(2)
            PHASE_PTRS
                const float* lp = INP(IN_ALAM) + idx * 256;
                const float s1 = wave_sum(lp[lane] * lp[64 + lane]), s2 = wave_sum(lp[128 + lane] * lp[192 + lane]);
                const float lam_init = ap->lam_init[idx], lam = expf(s1) - expf(s2) + lam_init;
                {
                    asm volatile("s_waitcnt vmcnt(0) lgkmcnt(0)" ::: "memory"); __syncthreads();
                    int ptid2 = ptid; asm volatile("" : "+v"(ptid2));
                    const attn_body::bf16* Qa = (const attn_body::bf16*)Qb; const attn_body::bf16* Ka = (const attn_body::bf16*)Kb; const attn_body::bf16* Va = (const attn_body::bf16*)Vb;
                    attn_body::bf16* O4 = (attn_body::bf16*)(ws + WS_H);
                    const float* sg = INP(IN_ASUB) + idx * 128;
                    const int ngrp = NB * 8 * 8, nper = (ngrp + pG - 1) / pG;
                    const int lane2 = ptid2 & 63;
                    const int dslot = vcu % (nper + 1);
                    for (int gj = 0; gj <= nper; ++gj) {
                        if (gj == dslot) {
                            int dl = lane2; asm volatile("" : "+v"(dl));
                            const int g4 = dl >> 4, c16 = dl & 15;
                            for (int item = gw; item < 128 * NSPLIT; item += NGW) {
                                const int bh = item / NSPLIT, sp = item % NSPLIT, b = bh >> 3, h = bh & 7;
                                AttnItem it; it.q = Qb + (size_t)(MP + b * 16) * D + h * 128;
                                it.kc = INP(IN_CAK) + ((size_t)(idx * NB + b) * PAST) * D + h * 128; it.vc = INP(IN_CAV) + ((size_t)(idx * NB + b) * PAST) * D + h * 128;
                                it.kn = Kb + (size_t)(MP + b * 16) * D + h * 128; it.vn = Vb + (size_t)(MP + b * 16) * D + h * 128; it.btab = nullptr;
                                it.cstride = D; it.n_cache = PAST; it.k_lo = sp * 256; it.k_hi = (sp == NSPLIT - 1) ? PAST + 32 : (sp + 1) * 256; it.n_total = PAST + DSEQ; it.rel0 = 0; it.head = 0;
                                float m[2], l[2]; f32x4 o[2][8];
                                attn16_core<2, 128>(it, dl, m, l, o);
#pragma unroll
                                for (int c = 0; c < 2; ++c) { float* po = PO + (((size_t)item * 2 + c) * 16 + c16) * 128 + 4 * g4;
#pragma unroll
                                    for (int e = 0; e < 8; ++e) *(f32x4*)(po + e * 16) = o[c][e];
                                    if (g4 == 0) { float* pm = PML + (((size_t)item * 2 + c) * 16 + c16) * 2; pm[0] = m[c]; pm[1] = l[c]; } }
                            }
                            asm volatile("s_waitcnt vmcnt(0) lgkmcnt(0)" ::: "memory"); __syncthreads();
                        }
                        const int gid = vcu * nper + gj; if (gj >= nper || gid >= ngrp) continue;
                        int ln3 = lane2; asm volatile("" : "+v"(ln3));
                        const int ptid3 = wave * 64 + ln3, csub = ln3 & 7, cvh = csub >> 2, cd0 = (csub & 3) * 16, crr = ln3 >> 3;
                        const int bh = gid >> 3, sel = (gid >> 2) & 1, jq = gid & 3, b = bh >> 3, h = bh & 7;
                        const int qb = sel == 0 ? (jq == 0 ? 0 : (jq == 1 ? 7 : (jq == 2 ? 2 : 5))) : (jq == 0 ? 1 : (jq == 1 ? 6 : (jq == 2 ? 3 : 4)));
                        for (int c = 0; c < 2; ++c)
                            attn_body::attn_unit<8, 63, 2048, 0, 1>(b, h * 2 + c, h * 2, h * 4 + c * 2, qb, Qa, Ka, Va, O4, (char*)lds + RING_OFF, ptid3, nullptr);
                        asm volatile("s_waitcnt vmcnt(0)" ::: "memory");
                        const bf16_t* O4r = (const bf16_t*)O4;
                        float gg[16];
#pragma unroll
                        for (int i = 0; i < 16; ++i) gg[i] = sg[cvh * 64 + cd0 + i] * (1.0f - lam_init);
                        u32x4 ra[4][4];
#pragma unroll
                        for (int ps = 0; ps < 4; ++ps) {
                            const int row = b * SEQ + qb * 256 + wave * 32 + ps * 8 + crr;
                            const bf16_t* p0 = O4r + (size_t)row * 2048 + (h * 4 + cvh) * 64 + cd0; const bf16_t* p1 = p0 + 128;
                            ra[ps][0] = *(const u32x4*)p0; ra[ps][1] = *(const u32x4*)(p0 + 8); ra[ps][2] = *(const u32x4*)p1; ra[ps][3] = *(const u32x4*)(p1 + 8); }
#pragma unroll
                        for (int ps = 0; ps < 4; ++ps) {
                            const int row = b * SEQ + qb * 256 + wave * 32 + ps * 8 + crr;
                            const u32x4 a0 = ra[ps][0], a1 = ra[ps][1], b0 = ra[ps][2], b1 = ra[ps][3];
                            float o[16]; float ss = 0.f;
#pragma unroll
                            for (int i = 0; i < 16; ++i) { const unsigned wa = i < 8 ? a0[(i >> 1) & 3] : a1[(i >> 1) & 3], wb = i < 8 ? b0[(i >> 1) & 3] : b1[(i >> 1) & 3];
                                const float fa = bf2f((unsigned short)((i & 1) ? (wa >> 16) : (wa & 0xffffu))), fb = bf2f((unsigned short)((i & 1) ? (wb >> 16) : (wb & 0xffffu)));
                                o[i] = fa - lam * fb; ss += o[i] * o[i]; }
                            ss += swz_xor<1>(ss); ss += swz_xor<2>(ss); ss += swz_xor<4>(ss);
                            const float rs = 1.0f / sqrtf(ss * (1.0f / 128.0f) + EPS);
                            float y0[8], y1[8];
#pragma unroll
                            for (int i = 0; i < 8; ++i) { y0[i] = o[i] * rs * gg[i]; y1[i] = o[8 + i] * rs * gg[8 + i]; }
                            bf16_t* op = ON + (size_t)row * D + h * 128 + cvh * 64 + cd0;
                            *(u32x4*)op = pg8::pack8(y0); *(u32x4*)(op + 8) = pg8::pack8(y1);
                        }
                    }
                }
                SEAM();
            REP_END
            }
            if (EN(3) && RUN(base + 2)) {
            REP_BEGIN(3)
            PHASE_PTRS
                const float* lp = INP(IN_ALAM) + idx * 256;
                const float s1 = wave_sum(lp[lane] * lp[64 + lane]), s2 = wave_sum(lp[128 + lane] * lp[192 + lane]);
                const float lam_init = ap->lam_init[idx], lam = expf(s1) - expf(s2) + lam_init;
                const float* sg = INP(IN_ASUB) + idx * 128;
                for (int id = gw; id < MS * 8; id += NGW) {
                    const int s = id >> 3, h = id & 7, b = s >> 4, q = s & 15, bh = b * 8 + h;
                    f32x2 oc[2];
#pragma unroll
                    for (int c = 0; c < 2; ++c) {
                        f32x2 ml[NSPLIT], pv[NSPLIT];
#pragma unroll
                        for (int sp = 0; sp < NSPLIT; ++sp) { const size_t pi = (((size_t)bh * NSPLIT + sp) * 2 + c) * 16 + q; ml[sp] = *(const f32x2*)(PML + pi * 2); pv[sp] = *(const f32x2*)(PO + pi * 128 + 2 * lane); }
                        __builtin_amdgcn_sched_barrier(0);
                        float mx = -1e30f;
#pragma unroll
                        for (int sp = 0; sp < NSPLIT; ++sp) mx = fmaxf(mx, ml[sp].x);
                        float lt = 0.f; f32x2 acc = (f32x2){0.f, 0.f};
#pragma unroll
                        for (int sp = 0; sp < NSPLIT; ++sp) { const float w = __builtin_amdgcn_exp2f(ml[sp].x - mx); lt += ml[sp].y * w; acc = acc + pv[sp] * w; }
                        oc[c] = acc * (1.0f / lt);
                    }
                    const f32x2 ov = oc[0] - oc[1] * lam;
                    const float ss = wave_sum(ov.x * ov.x + ov.y * ov.y);
                    const float rs = (1.0f - lam_init) / sqrtf(ss * (1.0f / 128.0f) + EPS);
                    const f32x2 gg = *(const f32x2*)(sg + 2 * lane);
                    *(unsigned*)(ON + (size_t)(MP + s) * D + h * 128 + 2 * lane) = cvt_pk_bf16(ov.x * rs * gg.x, ov.y * rs * gg.y);
                }
                SEAM();
            REP_END
            }
            if (EN(4) && RUN(base + 3)) {
            REP_BEGIN(4)
            PHASE_PTRS
                pg8::Gemm g{ON, Wb + W_AOUT + (size_t)idx * 1024 * 1024, MP, 1024, 1024, 0, 0}; const bf16_t* skA = ON + (size_t)MP * D; const bf16_t* skB = Wb + W_AOUT + (size_t)idx * 1024 * 1024; const int skK = 1024; pg8::StaticOrder S; S.init(MP, 1024, pG, pbx);
                pg8::EpiResAdd E{XN, nullptr, nullptr, SSQ0};
                pg8::gemm_phase<pg8::EpiResAdd, pg8::StaticOrder, true, true>(ldsp + RING_OFF, g, S, E, ptid);
                { SkResAdd F{XN, nullptr, nullptr, SSQ0}; skinny_gemm(ldsp + RING_OFF, skA, skK, skB, skK, 16, F, vcu, pG, wave, lane); }
                SEAM();
            REP_END
            }
        } else if (kind == 1) {
            if (EN(5) && RUN(base + 0)) {
            REP_BEGIN(5)
            PHASE_PTRS
                pg8::Gemm g{XN, Wb + W_BIN, MP, 2048, 1024, 0, 0}; pg8::StaticOrder S; S.init(MP, 2048, pG, pbx);
                pg8::EpiBin E{Gb, Ub, INP(IN_BBIN), out + OUT_BCP, out + OUT_BCS, (const LAS float*)(ldsp + RS_OFF)};
                fill_row_factors(ldsp, S, SSQ1, ptid);
                pg8::gemm_phase<pg8::EpiBin, pg8::StaticOrder, true, true>(ldsp + RING_OFF, g, S, E, ptid);
                { SkBin F{Gb, Ub, INP(IN_BBIN), out + OUT_BCS, SSQ1}; skinny_gemm(ldsp + RING_OFF, XN + (size_t)MP * D, D, Wb + W_BIN, 1024, 32, F, vcu, pG, wave, lane); }
                SEAM();
            REP_END
            }
            if (EN(6) && RUN(base + 1)) {
            REP_BEGIN(6)
            PHASE_PTRS
                const float* cw = INP(IN_BCW); const float* cb = INP(IN_BCB); const float* hist = INP(IN_SBC);
                const int ch0 = (gt & 127) * 8;
                float wj[4][8], bs[8];
#pragma unroll
                for (int c = 0; c < 8; ++c) { bs[c] = cb[ch0 + c];
#pragma unroll
                    for (int jj = 0; jj < 4; ++jj) wj[jj][c] = cw[jj * D + ch0 + c]; }
                for (int rbk = gt >> 7; rbk < MT / 16; rbk += NGT >> 7) {
                    const int row0 = rbk * 16; const bool pr = row0 < MP; const int t0 = pr ? (row0 & (SEQ - 1)) : 0; const int b = pr ? (row0 >> 11) : ((row0 - MP) >> 4);
                    u32x4 wr_[19];
#pragma unroll
                    for (int r = 0; r < 16; ++r) wr_[3 + r] = *(const u32x4*)(Ub + (size_t)(row0 + r) * D + ch0);
                    float um[3][8];
                    if (t0 > 0) {
#pragma unroll
                        for (int k = 0; k < 3; ++k) { const u32x4 w = *(const u32x4*)(Ub + (size_t)(row0 - 3 + k) * D + ch0);
                            um[k][0] = bf2f(w.x & 0xffff); um[k][1] = bf2f(w.x >> 16); um[k][2] = bf2f(w.y & 0xffff); um[k][3] = bf2f(w.y >> 16); um[k][4] = bf2f(w.z & 0xffff); um[k][5] = bf2f(w.z >> 16); um[k][6] = bf2f(w.w & 0xffff); um[k][7] = bf2f(w.w >> 16); }
                    } else if (!pr) {
#pragma unroll
                        for (int k = 0; k < 3; ++k) { const float* hp = hist + (size_t)(b * 3 + k) * D + ch0;
#pragma unroll
                            for (int c = 0; c < 8; ++c) um[k][c] = hp[c]; }
                    } else {
#pragma unroll
                        for (int k = 0; k < 3; ++k)
#pragma unroll
                            for (int c = 0; c < 8; ++c) um[k][c] = 0.f;
                    }
#pragma unroll
                    for (int r = 0; r < 16; ++r) { const u32x4 w = wr_[3 + r]; float u0[8], acc[8];
                        u0[0] = bf2f(w.x & 0xffff); u0[1] = bf2f(w.x >> 16); u0[2] = bf2f(w.y & 0xffff); u0[3] = bf2f(w.y >> 16); u0[4] = bf2f(w.z & 0xffff); u0[5] = bf2f(w.z >> 16); u0[6] = bf2f(w.w & 0xffff); u0[7] = bf2f(w.w >> 16);
#pragma unroll
                        for (int c = 0; c < 8; ++c) { acc[c] = bs[c] + um[0][c] * wj[0][c] + um[1][c] * wj[1][c] + um[2][c] * wj[2][c] + u0[c] * wj[3][c]; um[0][c] = um[1][c]; um[1][c] = um[2][c]; um[2][c] = u0[c]; }
                        *(u32x4*)(XCB + ((size_t)(ch0 >> 8) * MT + row0 + r) * 256 + (ch0 & 255)) = pg8::pack8(acc); }
                }
                SEAM();
            REP_END
            }
            if (EN(7) && RUN(base + 2)) {
            REP_BEGIN(7)
            PHASE_PTRS
                pg8::Gemm g{XCB, Wb + W_BG, MP, 2048, 256, 1, (size_t)MT * 256 * 2}; pg8::StaticOrder S; S.init(MP, 2048, pG, pbx);
                pg8::EpiGates E{XCB, INP(IN_BGAB), INP(IN_BGXB), SP8, (bf16_t*)AA, (bf16_t*)BB};
                pg8::gemm_phase<pg8::EpiGates, pg8::StaticOrder, true, true>(ldsp + RING_OFF, g, S, E, ptid);
                { SkGates F{XCB, INP(IN_BGAB), INP(IN_BGXB), SP8, (bf16_t*)AA, (bf16_t*)BB}; skinny_gemm(ldsp + RING_OFF, XCB + (size_t)MP * 256, 256, Wb + W_BG, 256, 32, F, vcu, pG, wave, lane); }
                SEAM();
            REP_END
            }
            if (EN(8) && RUN(base + 3)) {
            REP_BEGIN(8)
            PHASE_PTRS
            const bf16_t* const LAq = (const bf16_t*)AA; const bf16_t* const BQq = (const bf16_t*)BB;
                for (int id = gw; id < NB * 32 * 4; id += NGW) {
                    const int cq = id & 3, ck = (id >> 2) & 31, b = id >> 7, ch = cq * 256 + lane * 4; const size_t r0 = (size_t)(b * SEQ + ck * 64) * D + ch;
                    f32x4 P = (f32x4){1.f, 1.f, 1.f, 1.f}, Hc = (f32x4){0.f, 0.f, 0.f, 0.f};
                    for (int t0 = 0; t0 < 64; t0 += 16) { u32x2 a[16], bb[16];
#pragma unroll
                        for (int j = 0; j < 16; ++j) { a[j] = *(const u32x2*)(LAq + r0 + (size_t)(t0 + j) * D); bb[j] = *(const u32x2*)(BQq + r0 + (size_t)(t0 + j) * D); }
                        __builtin_amdgcn_sched_barrier(0);
#pragma unroll
                        for (int j = 0; j < 16; ++j) {
                            const f32x4 la = (f32x4){bf2f(a[j].x & 0xffff), bf2f(a[j].x >> 16), bf2f(a[j].y & 0xffff), bf2f(a[j].y >> 16)};
                            const f32x4 bv = (f32x4){bf2f(bb[j].x & 0xffff), bf2f(bb[j].x >> 16), bf2f(bb[j].y & 0xffff), bf2f(bb[j].y >> 16)};
                            const f32x4 av = (f32x4){__expf(la.x), __expf(la.y), __expf(la.z), __expf(la.w)};
                            P = P * av; Hc = av * Hc + bv; }
                        __builtin_amdgcn_sched_barrier(0); }
                    *(f32x4*)(CP + (size_t)(b * 32 + ck) * D + ch) = P; *(f32x4*)(CH + (size_t)(b * 32 + ck) * D + ch) = Hc;
                }
                SEAM();
            REP_END
            }
            if (EN(9) && RUN(base + 4)) {
            REP_BEGIN(9)
            PHASE_PTRS
            const bf16_t* const LAq = (const bf16_t*)AA; const bf16_t* const BQq = (const bf16_t*)BB;
                for (int id = gw; id < NB * 32 * 4; id += NGW) {
                    const int cq = id & 3, ck = (id >> 2) & 31, b = id >> 7, ch = cq * 256 + lane * 4; const size_t r0 = (size_t)(b * SEQ + ck * 64) * D + ch;
                    f32x4 h = (f32x4){0.f, 0.f, 0.f, 0.f};
                    for (int k0 = 0; k0 < ck; k0 += 8) {
                        f32x4 cp[8], chh[8];
#pragma unroll
                        for (int j = 0; j < 8; ++j) { const int kk = (k0 + j) < 32 ? (k0 + j) : 31; cp[j] = *(const f32x4*)(CP + (size_t)(b * 32 + kk) * D + ch); chh[j] = *(const f32x4*)(CH + (size_t)(b * 32 + kk) * D + ch); }
                        __builtin_amdgcn_sched_barrier(0);
#pragma unroll
                        for (int j = 0; j < 8; ++j) if (k0 + j < ck) h = cp[j] * h + chh[j];
                        __builtin_amdgcn_sched_barrier(0); }
                    for (int t0 = 0; t0 < 64; t0 += 8) { u32x2 a[8], bb[8], gg[8];
#pragma unroll
                        for (int j = 0; j < 8; ++j) { a[j] = *(const u32x2*)(LAq + r0 + (size_t)(t0 + j) * D); bb[j] = *(const u32x2*)(BQq + r0 + (size_t)(t0 + j) * D); gg[j] = *(const u32x2*)(Gb + r0 + (size_t)(t0 + j) * D); }
                        __builtin_amdgcn_sched_barrier(0);
#pragma unroll
                        for (int j = 0; j < 8; ++j) {
                            const f32x4 la = (f32x4){bf2f(a[j].x & 0xffff), bf2f(a[j].x >> 16), bf2f(a[j].y & 0xffff), bf2f(a[j].y >> 16)};
                            const f32x4 bv = (f32x4){bf2f(bb[j].x & 0xffff), bf2f(bb[j].x >> 16), bf2f(bb[j].y & 0xffff), bf2f(bb[j].y >> 16)};
                            const f32x4 gv = (f32x4){bf2f(gg[j].x & 0xffff), bf2f(gg[j].x >> 16), bf2f(gg[j].y & 0xffff), bf2f(gg[j].y >> 16)};
                            const f32x4 av = (f32x4){__expf(la.x), __expf(la.y), __expf(la.z), __expf(la.w)};
                            h = av * h + bv; const f32x4 y = h * gv;
                            u32x2 w; w.x = cvt_pk_bf16(y.x, y.y); w.y = cvt_pk_bf16(y.z, y.w); *(u32x2*)(HG + r0 + (size_t)(t0 + j) * D) = w; } }
                    if (ck == 31) *(f32x4*)(out + OUT_BHP + (size_t)b * D + ch) = h;
                }
                for (int id = gw; id < NB * 4; id += NGW) {
                    const int cq = id & 3, b = id >> 2, ch = cq * 256 + lane * 4; const size_t r0 = (size_t)(MP + b * DSEQ) * D + ch;
                    f32x4 h = *(const f32x4*)(INP(IN_SBH) + (size_t)b * D + ch);
                    u32x2 sa[DSEQ], sb[DSEQ], sg[DSEQ];
#pragma unroll
                    for (int j = 0; j < DSEQ; ++j) { sa[j] = *(const u32x2*)(LAq + r0 + (size_t)j * D); sb[j] = *(const u32x2*)(BQq + r0 + (size_t)j * D); sg[j] = *(const u32x2*)(Gb + r0 + (size_t)j * D); }
                    __builtin_amdgcn_sched_barrier(0);
#pragma unroll
                    for (int j = 0; j < DSEQ; ++j) { const u32x2 a = sa[j], bb = sb[j], gg = sg[j];
                        const f32x4 av = (f32x4){__expf(bf2f(a.x & 0xffff)), __expf(bf2f(a.x >> 16)), __expf(bf2f(a.y & 0xffff)), __expf(bf2f(a.y >> 16))};
                        const f32x4 bv = (f32x4){bf2f(bb.x & 0xffff), bf2f(bb.x >> 16), bf2f(bb.y & 0xffff), bf2f(bb.y >> 16)};
                        const f32x4 gv = (f32x4){bf2f(gg.x & 0xffff), bf2f(gg.x >> 16), bf2f(gg.y & 0xffff), bf2f(gg.y >> 16)};
                        h = av * h + bv; const f32x4 y = h * gv; u32x2 w; w.x = cvt_pk_bf16(y.x, y.y); w.y = cvt_pk_bf16(y.z, y.w); *(u32x2*)(HG + r0 + (size_t)j * D) = w; }
                    *(f32x4*)(out + OUT_BHS + (size_t)b * D + ch) = h;
                }
                SEAM();
            REP_END
            }
            if (EN(10) && RUN(base + 5)) {
            REP_BEGIN(10)
            PHASE_PTRS
                pg8::Gemm g{HG, Wb + W_BOUT, MP, 1024, 1024, 0, 0}; const bf16_t* skA = HG + (size_t)MP * D; const bf16_t* skB = Wb + W_BOUT; const int skK = 1024; pg8::StaticOrder S; S.init(MP, 1024, pG, pbx);
                pg8::EpiResAdd E{XN, nullptr, nullptr, SSQ0};
                pg8::gemm_phase<pg8::EpiResAdd, pg8::StaticOrder, true, true>(ldsp + RING_OFF, g, S, E, ptid);
                { SkResAdd F{XN, nullptr, nullptr, SSQ0}; skinny_gemm(ldsp + RING_OFF, skA, skK, skB, skK, 16, F, vcu, pG, wave, lane); }
                SEAM();
            REP_END
            }
        } else {
            if (EN(11) && RUN(base + 0)) {
            REP_BEGIN(11)
            PHASE_PTRS
                pg8::Gemm g{XN, Wb + W_CIN, MP, 3072, 1024, 0, 0}; pg8::StaticOrder S; S.init(MP, 3072, pG, pbx);
                pg8::EpiQKV<false> E{Qb, ACT_BF / 2, INP(IN_CQG), INP(IN_CKG), ROPE, out + OUT_CKP, out + OUT_CKS, OUT_CVP - OUT_CKP, OUT_CVS - OUT_CKS, SEQ - CWIN, (const LAS float*)(ldsp + RS_OFF)};
                fill_row_factors(ldsp, S, SSQ1, ptid);
                pg8::gemm_phase<pg8::EpiQKV<false>, pg8::StaticOrder, true, true>(ldsp + RING_OFF, g, S, E, ptid);
                { SkQKV<false> F{Qb, ACT_BF / 2, INP(IN_CQG), INP(IN_CKG), ROPE, out + OUT_CKS, OUT_CVS - OUT_CKS, SSQ1};
                  skinny_gemm2(ldsp + RING_OFF, XN + (size_t)MP * D, D, Wb + W_CIN, 48, F, vcu, pG, wave, lane); }
                SEAM();
            REP_END
            }
            if (EN(12) && RUN(base + 1)) {
            REP_BEGIN(12)
            PHASE_PTRS
                const int g4 = lane >> 4, c16 = lane & 15; const float* tab = INP(IN_CBIAS);
                if (vcu < NB * 16) {
                    const int b = vcu >> 4, h = vcu & 15;
                    AttnItem it; it.q = Qb + (size_t)(MP + b * 16) * D + h * 64;
                    it.kc = INP(IN_CCK) + ((size_t)b * CWIN) * D + h * 64; it.vc = INP(IN_CCV) + ((size_t)b * CWIN) * D + h * 64;
                    it.kn = Kb + (size_t)(MP + b * 16) * D + h * 64; it.vn = Vb + (size_t)(MP + b * 16) * D + h * 64; it.btab = tab;
                    it.cstride = D; it.n_cache = CWIN; it.k_lo = 64 * wave; it.k_hi = 64 * (wave + 1) + (wave == NWAVES - 1 ? 32 : 0); it.n_total = CWIN + DSEQ; it.rel0 = CWIN; it.head = h;
                    float m[1], l[1]; f32x4 o[1][4];
                    attn16_core<1, 64>(it, lane, m, l, o);
                    LAS float* px = (LAS float*)(ldsp + RING_OFF); LAS float* pml = px + NWAVES * 1024;
#pragma unroll
                    for (int e = 0; e < 4; ++e) *(LAS f32x4*)(px + wave * 1024 + lane * 16 + e * 4) = o[0][e];
                    if (g4 == 0) { pml[(wave * 16 + c16) * 2] = m[0]; pml[(wave * 16 + c16) * 2 + 1] = l[0]; }
                    asm volatile("s_waitcnt lgkmcnt(0)" ::: "memory"); __syncthreads();
                    if (wave == 0) {
                        float mx = -1e30f;
#pragma unroll
                        for (int w = 0; w < NWAVES; ++w) mx = fmaxf(mx, pml[(w * 16 + c16) * 2]);
                        float lt = 0.f; f32x4 acc[4];
#pragma unroll
                        for (int e = 0; e < 4; ++e) acc[e] = (f32x4){0.f, 0.f, 0.f, 0.f};
#pragma unroll
                        for (int w = 0; w < NWAVES; ++w) { const float sc = __builtin_amdgcn_exp2f(pml[(w * 16 + c16) * 2] - mx); lt += pml[(w * 16 + c16) * 2 + 1] * sc;
#pragma unroll
                            for (int e = 0; e < 4; ++e) acc[e] = acc[e] + *(const LAS f32x4*)(px + w * 1024 + lane * 16 + e * 4) * sc; }
                        const float il = 1.0f / lt; bf16_t* orow = ON + (size_t)(MP + b * 16 + c16) * D + h * 64 + 4 * g4;
#pragma unroll
                        for (int e = 0; e < 4; ++e) { const f32x4 v = acc[e] * il; u32x2 w; w.x = cvt_pk_bf16(v.x, v.y); w.y = cvt_pk_bf16(v.z, v.w); *(u32x2*)(orow + e * 16) = w; }
                    }
                }
                {
                    asm volatile("s_waitcnt vmcnt(0) lgkmcnt(0)" ::: "memory"); __syncthreads();
                    int ptid2 = ptid; asm volatile("" : "+v"(ptid2));
                    LAS float* tb = (LAS float*)(ldsp + RING_OFF + attn_body::ATTN_LDS_BYTES);
                    for (int i = ptid2; i < 16 * NTAB; i += NWAVES * 64) { const int hh = i / NTAB, r = i % NTAB; tb[hh * 260 + r] = (tab[r * 16 + hh] - tab[256 * 16 + hh]) * LOG2E; }
                    asm volatile("s_waitcnt vmcnt(0) lgkmcnt(0)" ::: "memory"); __syncthreads();
                    const attn_body::bf16* Qa = (const attn_body::bf16*)Qb; const attn_body::bf16* Ka = (const attn_body::bf16*)Kb; const attn_body::bf16* Va = (const attn_body::bf16*)Vb;
                    const int nper = (NB * 16 * 8 + pG - 1) / pG;
                    for (int ui = vcu * nper; ui < (vcu + 1) * nper && ui < NB * 16 * 8; ++ui) {
                        const int bh = ui >> 3, qb = 7 - (ui & 7), b = bh >> 4, h = bh & 15;
                        attn_body::attn_unit<8, 63, 1024, 1, 0>(b, h, h, h, qb, Qa, Ka, Va, (attn_body::bf16*)ON, (char*)lds + RING_OFF, ptid2, tb + h * 260);
                    }
                }
                SEAM();
            REP_END
            }
            if (EN(13) && RUN(base + 2)) {
            REP_BEGIN(13)
            PHASE_PTRS
                pg8::Gemm g{ON, Wb + W_COUT, MP, 1024, 1024, 0, 0}; const bf16_t* skA = ON + (size_t)MP * D; const bf16_t* skB = Wb + W_COUT; const int skK = 1024; pg8::StaticOrder S; S.init(MP, 1024, pG, pbx);
                pg8::EpiResAdd E{XN, nullptr, nullptr, SSQ0};
                pg8::gemm_phase<pg8::EpiResAdd, pg8::StaticOrder, true, true>(ldsp + RING_OFF, g, S, E, ptid);
                { SkResAdd F{XN, nullptr, nullptr, SSQ0}; skinny_gemm(ldsp + RING_OFF, skA, skK, skB, skK, 16, F, vcu, pG, wave, lane); }
                SEAM();
            REP_END
            }
        }
        if (EN(15) && RUN(base + 9)) {
            REP_BEGIN(15)
            PHASE_PTRS
            pg8::Gemm g{XN, Wb + W_1 + (size_t)L * 4096 * 1024, MP, FF, 1024, 0, 0}; pg8::StaticOrder S; S.init(MP, FF, pG, pbx);
            pg8::EpiRelu2 E{Hb, FF, (const LAS float*)(ldsp + RS_OFF)};
            fill_row_factors(ldsp, S, SSQ0, ptid);
            pg8::gemm_phase<pg8::EpiRelu2, pg8::StaticOrder, true, true>(ldsp + RING_OFF, g, S, E, ptid);
            { SkRelu2 F{Hb, SSQ0}; skinny_gemm2(ldsp + RING_OFF, XN + (size_t)MP * D, D, Wb + W_1 + (size_t)L * 4096 * 1024, 64, F, vcu, pG, wave, lane); }
            SEAM();
            REP_END
        }
        if (EN(16) && RUN(base + 10)) {
            REP_BEGIN(16)
            PHASE_PTRS
            pg8::Gemm g{Hb, Wb + W_2 + (size_t)L * 1024 * 4096, MP, 1024, FF, 0, 0}; const bf16_t* skA = Hb + (size_t)MP * FF; const bf16_t* skB = Wb + W_2 + (size_t)L * 1024 * 4096; const int skK = FF; pg8::StaticOrder S; S.init(MP, 1024, pG, pbx);
            pg8::EpiResAdd E{XN, nullptr, nullptr, SSQ1};
            pg8::gemm_phase<pg8::EpiResAdd, pg8::StaticOrder, true, true>(ldsp + RING_OFF, g, S, E, ptid);
                { SkResAdd F{XN, nullptr, nullptr, SSQ1}; skinny_gemm(ldsp + RING_OFF, skA, skK, skB, skK, 16, F, vcu, pG, wave, lane); }
            SEAM();
            REP_END
        }
        if (EN(17) && RUN(base + 11)) {
            REP_BEGIN(17)
            PHASE_PTRS
            if (L == 3) {
                const float* gf = INP(IN_GFIN);
                f32x4 g0[2], g1[2];
#pragma unroll
                for (int hh = 0; hh < 2; ++hh) { g0[hh] = *(const f32x4*)(gf + hh * 512 + lane * 8); g1[hh] = *(const f32x4*)(gf + hh * 512 + lane * 8 + 4); }
                for (int mrow = gw; mrow < MT; mrow += NGW) {
                    const float rr = pg8::row_rstd(SSQ1, mrow);
                    float* yr = out + (mrow < MP ? OUT_YP + (size_t)mrow * D : OUT_YS + (size_t)(mrow - MP) * D);
#pragma unroll
                    for (int hh = 0; hh < 2; ++hh) { const u32x4 w = *(const u32x4*)(XN + (size_t)mrow * D + hh * 512 + lane * 8);
                        const f32x4 a = (f32x4){bf2f(w.x & 0xffff), bf2f(w.x >> 16), bf2f(w.y & 0xffff), bf2f(w.y >> 16)} * rr * g0[hh];
                        const f32x4 b = (f32x4){bf2f(w.z & 0xffff), bf2f(w.z >> 16), bf2f(w.w & 0xffff), bf2f(w.w >> 16)} * rr * g1[hh];
                        __builtin_nontemporal_store(a, (f32x4*)(yr + hh * 512 + lane * 8)); __builtin_nontemporal_store(b, (f32x4*)(yr + hh * 512 + lane * 8 + 4)); }
                }
            }
            REP_END
        }
    }
#undef RUN
#undef SEAM
}

#ifndef HOSTDUP
#define HOSTDUP 0ull
#endif
#ifndef MK_SINGLE
#define MK_SINGLE 1
#endif
static bool phase_valid(int id) {
    if (id == 0) return true;
    const int L = (id - 1) / 16, sub = (id - 1) % 16, kind = L % 3;
    if (L > 3) return false;
    if (sub >= 8) return sub == 9 || sub == 10 || (sub == 11 && L == 3);
    return sub < (kind == 0 ? 4 : (kind == 1 ? 6 : 3));
}
extern "C" void kernel_launch(void* const* d_in, const int* in_sizes, int n_in, void* d_out, int out_size, void* d_ws, size_t ws_size, hipStream_t stream) {
    static int grid = 0;
    if (grid == 0) {
        if (n_in != N_IN || (size_t)out_size != OUT_TOTAL || ws_size < WS_END || in_sizes[IN_XP] != MP * D || in_sizes[IN_CAK] != 2 * NB * PAST * D) {
            fprintf(stderr, "kernel_launch: unexpected shapes: n_in %d out %d ws %zu (need %zu)\n", n_in, out_size, ws_size, (size_t)WS_END); grid = -1; return; }
        int dev = 0, cus = 0, per_cu = 0;
        if (hipGetDevice(&dev) != hipSuccess || hipDeviceGetAttribute(&cus, hipDeviceAttributeMultiprocessorCount, dev) != hipSuccess) { fprintf(stderr, "kernel_launch: device query failed\n"); grid = -1; return; }
        if (hipFuncSetAttribute((const void*)fwd_kernel, hipFuncAttributeMaxDynamicSharedMemorySize, LDS_BYTES) != hipSuccess) { fprintf(stderr, "kernel_launch: hipFuncSetAttribute failed\n"); grid = -1; return; }
        if (hipOccupancyMaxActiveBlocksPerMultiprocessor(&per_cu, (const void*)fwd_kernel, NWAVES * 64, LDS_BYTES) != hipSuccess || per_cu < 1)
            fprintf(stderr, "kernel_launch: note: occupancy query reports %d workgroups per CU\n", per_cu);
        (void)hipGetLastError();
        grid = cus;
    }
    if (grid < 0) return;
    if (hipMemsetAsync((char*)d_ws + WS_CTL, 0, CTL_ZERO_BYTES, stream) != hipSuccess) { fprintf(stderr, "kernel_launch: memset failed\n"); return; }
    Args a{};
    for (int i = 0; i < N_IN; ++i) a.in[i] = (const GAS float*)d_in[i];
    a.out = (GAS float*)d_out; a.ws = (GAS unsigned char*)d_ws; a.dupmask = PROBE_DUP;
    for (int d = 0; d < 32; ++d) a.rope_inv[d] = (float)pow(10000.0, -(double)d / 32.0);
    a.lam_init[0] = (float)(0.8 - 0.6 * exp(-0.3 * 0.0)); a.lam_init[1] = (float)(0.8 - 0.6 * exp(-0.3 * 3.0));
    if (MK_SINGLE) {
        a.ph_lo = 0; a.ph_hi = 1 << 20; a.single = 1;
        hipLaunchKernelGGL(fwd_kernel, dim3(grid), dim3(NWAVES * 64), LDS_BYTES, stream, a);
    } else {
        for (int id = 0; id < 1 + 16 * 4; ++id) { if (!phase_valid(id)) continue;
            a.ph_lo = id; a.ph_hi = id + 1; a.single = 0;
            hipLaunchKernelGGL(fwd_kernel, dim3(grid), dim3(NWAVES * 64), LDS_BYTES, stream, a);
            if ((HOSTDUP >> id) & 1ull) hipLaunchKernelGGL(fwd_kernel, dim3(grid), dim3(NWAVES * 64), LDS_BYTES, stream, a); }
    }
    const hipError_t le = hipPeekAtLastError();
    if (le != hipSuccess) fprintf(stderr, "kernel_launch: launch failed: %s\n", hipGetErrorName(le));
}
```
